# Optimizing an MI355X kernel written in HIP

```python
import math, functools
import jax, jax.numpy as jnp
from jax import lax
import numpy as np

D_MODEL = 1024
BATCH = 4
SEQ = 8192
DEPTH = 1
DEC_BATCH = 2
DEC_SEQ = 16384
PAST_LEN = 128

HG_HEADS = 4
HG_HEAD_DIM = 128
HG_WIDTH = HG_HEADS * HG_HEAD_DIM
HG_CHUNK = 64
MLA_HEADS = 8
Q_LORA = 256
KV_LORA = 256
QK_NOPE = 64
QK_ROPE = 32
V_HEAD = 64
QK_HEAD = QK_NOPE + QK_ROPE
MLA_WIDTH = MLA_HEADS * V_HEAD
Q_BLOCK = 128
ROPE_THETA = 10000.0
N_BRANCH = 2
BRANCH_WIDTH = 512
D_FF = 2816
EPS = 1e-6
SPLIT_SIZES = (HG_WIDTH, HG_WIDTH, HG_WIDTH, HG_WIDTH, HG_WIDTH,
               Q_LORA, KV_LORA, QK_ROPE,
               N_BRANCH * D_MODEL)
IN_COLS = sum(SPLIT_SIZES)

kernel_name = "hgrn2_mla_parallel_encoder"


def _rmsnorm(x, g):
    xf = x.astype(jnp.float32)
    y = xf * lax.rsqrt(jnp.mean(xf * xf, axis=-1, keepdims=True) + EPS)
    return (y * g.astype(jnp.float32)).astype(x.dtype)


def _rope(x):
    S, d = x.shape[1], x.shape[-1]
    inv = ROPE_THETA ** (-jnp.arange(0, d, 2, dtype=jnp.float32) / d)
    ang = jnp.arange(S, dtype=jnp.float32)[:, None] * inv[None, :]
    cos = jnp.cos(ang)[None, :, None, :]
    sin = jnp.sin(ang)[None, :, None, :]
    xf = x.astype(jnp.float32)
    x1, x2 = xf[..., : d // 2], xf[..., d // 2:]
    out = jnp.concatenate([x1 * cos - x2 * sin, x2 * cos + x1 * sin], axis=-1)
    return out.astype(x.dtype)


def _hgrn2_scan(q, v, g_log):
    B, S, H, D = q.shape
    C = HG_CHUNK
    nc = S // C
    k = -jnp.expm1(g_log)

    def to_chunks(t):
        return t.reshape(B, nc, C, H, D).transpose(1, 0, 3, 2, 4)

    qc, kc, vc, gc = to_chunks(q), to_chunks(k), to_chunks(v), to_chunks(g_log)
    b = jnp.cumsum(gc, axis=-2)
    b_last = b[..., -1:, :]
    ref = b[..., C // 2 - 1: C // 2, :]
    q_in = qc * jnp.exp(b - ref)
    k_in = kc * jnp.exp(ref - b)
    att = jnp.einsum('nbhtd,nbhsd->nbhts', q_in, k_in)
    mask = jnp.tril(jnp.ones((C, C), dtype=bool))
    att = jnp.where(mask, att, 0.0)
    o_intra = jnp.einsum('nbhts,nbhse->nbhte', att, vc)
    q_inter = qc * jnp.exp(b)
    k_state = kc * jnp.exp(b_last - b)
    decay = jnp.exp(b_last[..., 0, :])

    def step(state, xs):
        qi, ks, vs, dec = xs
        o = jnp.einsum('bhtd,bhde->bhte', qi, state)
        state = state * dec[..., None] + jnp.einsum('bhsd,bhse->bhde', ks, vs)
        return state, o

    s0 = jnp.zeros((B, H, D, D), jnp.float32)
    _, o_inter = lax.scan(step, s0, (q_inter, k_state, vc, decay))
    o = o_intra + o_inter
    return o.transpose(1, 0, 3, 2, 4).reshape(B, S, H, D)


def _mla_attention(q, k, v):
    B, S, H, _ = q.shape
    nq = S // Q_BLOCK
    qb = q.reshape(B, nq, Q_BLOCK, H, QK_HEAD).transpose(1, 0, 2, 3, 4)
    scale = QK_HEAD ** -0.5

    def block(qi):
        s = jnp.einsum('bqhd,bkhd->bhqk', qi, k).astype(jnp.float32) * scale
        p = jax.nn.softmax(s, axis=-1).astype(v.dtype)
        return jnp.einsum('bhqk,bkhe->bqhe', p, v)

    o = lax.map(block, qb)
    return o.transpose(1, 0, 2, 3, 4).reshape(B, S, H, V_HEAD)


def _trunk(x, g_mix, w_in, lb_param, g_onorm, g_qa, w_uq, g_kva, w_ukv,
           w_branch, w_out, g_ffn, w_gate_up, w_down, g_final):
    B, S, _ = x.shape
    f32 = jnp.float32
    lower_bounds = jnp.cumsum(jax.nn.softmax(lb_param.astype(f32), axis=0), axis=0)
    split_pts = [int(v) for v in np.cumsum(SPLIT_SIZES)[:-1]]
    for l in range(DEPTH):
        h = _rmsnorm(x, g_mix[l])
        proj = h @ w_in[l]
        p_q, p_i, p_ff, p_fb, p_g, p_qa, p_kva, p_kr, p_gates = jnp.split(proj, split_pts, axis=-1)

        hd = (B, S, HG_HEADS, HG_HEAD_DIM)
        hq = jax.nn.silu(p_q.astype(f32)).reshape(hd)
        hi = p_i.astype(f32).reshape(hd)
        lb = lower_bounds[l]
        g_fw = jnp.log(lb[0] + (1.0 - lb[0]) * jax.nn.sigmoid(p_ff.astype(f32))).reshape(hd)
        g_bw = jnp.log(lb[1] + (1.0 - lb[1]) * jax.nn.sigmoid(p_fb.astype(f32))).reshape(hd)
        o_fw = _hgrn2_scan(hq, hi, g_fw)
        o_bw = jnp.flip(_hgrn2_scan(jnp.flip(hq, 1), jnp.flip(hi, 1), jnp.flip(g_bw, 1)), 1)
        o_h = _rmsnorm(o_fw + o_bw, g_onorm[l].reshape(HG_HEADS, HG_HEAD_DIM))
        o_h = (o_h * jax.nn.silu(p_g.astype(f32)).reshape(hd)).reshape(B, S, HG_WIDTH).astype(x.dtype)

        cq = _rmsnorm(p_qa, g_qa[l])
        q = jnp.einsum('bsr,rhd->bshd', cq, w_uq[l])
        ckv = _rmsnorm(p_kva, g_kva[l])
        kv = jnp.einsum('bsr,rhd->bshd', ckv, w_ukv[l])
        k_nope, v = kv[..., :QK_NOPE], kv[..., QK_NOPE:]
        k_pe = _rope(p_kr[:, :, None, :])
        q_full = jnp.concatenate([q[..., :QK_NOPE], _rope(q[..., QK_NOPE:])], axis=-1)
        k_full = jnp.concatenate(
            [k_nope, jnp.broadcast_to(k_pe, (B, S, MLA_HEADS, QK_ROPE))], axis=-1)
        o_m = _mla_attention(q_full, k_full, v).reshape(B, S, MLA_WIDTH)

        gates = jax.nn.sigmoid(p_gates.astype(f32)).reshape(B, S, N_BRANCH, D_MODEL).astype(x.dtype)
        branches = jnp.stack([o_h, o_m], axis=2)
        bproj = jnp.einsum('bsnk,nkd->bsnd', branches, w_branch[l])
        merged = jnp.sum(gates * bproj, axis=2)
        x = x + merged @ w_out[l]

        h2 = _rmsnorm(x, g_ffn[l])
        gu = h2 @ w_gate_up[l]
        gate, up = gu[..., :D_FF], gu[..., D_FF:]
        x = x + (jax.nn.silu(gate) * up) @ w_down[l]
    return _rmsnorm(x, g_final)


def setup_inputs(seed: int = 0) -> dict:
    key = jax.random.key(seed)
    ks = jax.random.split(key, 20)
    nrm = lambda k, shape, fan: jax.random.normal(k, shape, jnp.float32) * (fan ** -0.5)
    gain = lambda k, shape: 1.0 + 0.02 * jax.random.normal(k, shape, jnp.float32)
    return {
        "x_prompt": jax.random.normal(ks[0], (BATCH, SEQ, D_MODEL), jnp.float32),
        "x_sample": jax.random.normal(ks[1], (DEC_BATCH, DEC_SEQ, D_MODEL), jnp.float32),
        "g_mix": gain(ks[2], (DEPTH, D_MODEL)),
        "w_in": nrm(ks[3], (DEPTH, D_MODEL, IN_COLS), D_MODEL),
        "lb_param": 0.1 * jax.random.normal(ks[4], (DEPTH + 1, 2, HG_WIDTH), jnp.float32),
        "g_onorm": gain(ks[5], (DEPTH, HG_WIDTH)),
        "g_qa": gain(ks[6], (DEPTH, Q_LORA)),
        "w_uq": nrm(ks[7], (DEPTH, Q_LORA, MLA_HEADS, QK_HEAD), Q_LORA),
        "g_kva": gain(ks[8], (DEPTH, KV_LORA)),
        "w_ukv": nrm(ks[9], (DEPTH, KV_LORA, MLA_HEADS, QK_NOPE + V_HEAD), KV_LORA),
        "w_branch": nrm(ks[10], (DEPTH, N_BRANCH, BRANCH_WIDTH, D_MODEL), BRANCH_WIDTH),
        "w_out": nrm(ks[11], (DEPTH, D_MODEL, D_MODEL), D_MODEL),
        "g_ffn": gain(ks[12], (DEPTH, D_MODEL)),
        "w_gate_up": nrm(ks[13], (DEPTH, D_MODEL, 2 * D_FF), D_MODEL),
        "w_down": nrm(ks[14], (DEPTH, D_FF, D_MODEL), D_FF),
        "g_final": gain(ks[15], (D_MODEL,)),
    }


def reference(x_prompt, x_sample, g_mix, w_in, lb_param, g_onorm, g_qa, w_uq, g_kva, w_ukv,
              w_branch, w_out, g_ffn, w_gate_up, w_down, g_final):
    y_prompt = _trunk(x_prompt, g_mix, w_in, lb_param, g_onorm, g_qa, w_uq, g_kva, w_ukv,
                      w_branch, w_out, g_ffn, w_gate_up, w_down, g_final)
    y_sample = _trunk(x_sample, g_mix, w_in, lb_param, g_onorm, g_qa, w_uq, g_kva, w_ukv,
                      w_branch, w_out, g_ffn, w_gate_up, w_down, g_final)
    return (y_prompt, y_sample)
```

```cpp
#include <hip/hip_runtime.h>
#include <hip/hip_cooperative_groups.h>
#include <hip/hip_bf16.h>
#include <cstdio>
#include <cstdint>
#include <cmath>
namespace cg = cooperative_groups;

#define LAS __attribute__((address_space(3)))
typedef unsigned short bf16_t;
typedef short bf16x8 __attribute__((ext_vector_type(8)));
typedef short s16x4 __attribute__((ext_vector_type(4)));
typedef float f32x4 __attribute__((ext_vector_type(4)));
typedef float f32x2 __attribute__((ext_vector_type(2)));
typedef float f32x16 __attribute__((ext_vector_type(16)));
typedef unsigned u32x4 __attribute__((ext_vector_type(4)));
typedef unsigned u32x2 __attribute__((ext_vector_type(2)));
typedef __bf16 bf16x2_t __attribute__((ext_vector_type(2)));
typedef _Float16 h16x8 __attribute__((ext_vector_type(8)));

constexpr int M = 65536, DM = 1024, T0 = 32768;
constexpr int NIN = 5376;
constexpr int DFF = 2816;
constexpr float EPS = 1e-6f;
constexpr float QSCALE = 0.10206207261596575f * 1.4426950408889634f;
constexpr size_t MiB = 1u << 20;
constexpr size_t WS_QUEUE = 0, WS_BAR = 4096;
constexpr size_t WS_RSQ = 1 * MiB, WS_RSKV = WS_RSQ + 262144, WS_RSX1 = WS_RSKV + 262144, WS_RSX2 = WS_RSX1 + 262144;
constexpr size_t CTL_ZERO = 2 * MiB;
constexpr size_t WS_ROPE = 2 * MiB;
constexpr size_t WS_WIN = 4 * MiB, WS_WUQ = 15 * MiB, WS_WUKV = 15 * MiB + 512 * 1024, WS_WB0 = 16 * MiB, WS_WB1 = 17 * MiB, WS_WO = 18 * MiB, WS_WGU = 20 * MiB, WS_WD = 31 * MiB;
constexpr size_t WS_XN = 40 * MiB, WS_OFW = 40 * MiB, WS_OBW = 104 * MiB, WS_X1B = 40 * MiB;
constexpr size_t WS_HQ = 168 * MiB, WS_HI = 232 * MiB, WS_GF = 296 * MiB, WS_GB = 360 * MiB, WS_SG = 424 * MiB, WS_LAT = 488 * MiB;
constexpr size_t WS_Q = 552 * MiB, WS_K = 648 * MiB, WS_V = 744 * MiB, WS_OM = 808 * MiB;
constexpr size_t WS_OH = 168 * MiB, WS_MERGED = 232 * MiB, WS_X1 = 552 * MiB, WS_ACT = 168 * MiB;
constexpr size_t WS_END = 872 * MiB;
constexpr int LDS_BYTES = 155648;
constexpr int LDS_CTL = 155648 - 256;

__device__ __forceinline__ unsigned cvtpk(float lo, float hi) { f32x2 v = {lo, hi}; bf16x2_t b = __builtin_convertvector(v, bf16x2_t); return __builtin_bit_cast(unsigned, b); }
__device__ __forceinline__ float bf2f(unsigned short u) { return __builtin_bit_cast(float, (unsigned)u << 16); }
__device__ __forceinline__ float bflo(unsigned u) { return __builtin_bit_cast(float, u << 16); }
__device__ __forceinline__ float bfhi(unsigned u) { return __builtin_bit_cast(float, u & 0xffff0000u); }
__device__ __forceinline__ float sigmoidf_(float x) { return __builtin_amdgcn_rcpf(1.f + __expf(-x)); }
__device__ __forceinline__ float siluf_(float x) { return x * sigmoidf_(x); }
__device__ __forceinline__ u32x4 pack8(const float* v) { u32x4 w; w.x = cvtpk(v[0], v[1]); w.y = cvtpk(v[2], v[3]); w.z = cvtpk(v[4], v[5]); w.w = cvtpk(v[6], v[7]); return w; }
__device__ __forceinline__ int crow(int r, int hi) { return (r & 3) + 8 * (r >> 2) + 4 * hi; }
__device__ __forceinline__ const float* xrow_ptr(const float* xp, const float* xs, int row) { return row < T0 ? xp + (size_t)row * DM : xs + (size_t)(row - T0) * DM; }
__device__ __forceinline__ int row_pos(int row) { return row < T0 ? (row & 8191) : (row & 16383); }
#define SBAR() __builtin_amdgcn_sched_barrier(0)
__device__ __forceinline__ int lane_id() { return (int)__builtin_amdgcn_mbcnt_hi(~0u, __builtin_amdgcn_mbcnt_lo(~0u, 0u)); }

namespace pg8 {
constexpr int BM = 256, BK = 64, HALF = 128, HTB = HALF * BK * 2, STAGE_BYTES = 8 * HTB, NXCD = 8, WGM = 8;
__device__ __forceinline__ int lds_byte(int r, int c) { const int st = (r >> 4) * 2 + (c >> 5), rr = r & 15, cc = c & 31, ob = rr * 64 + cc * 2; return st * 1024 + (ob ^ (((ob >> 9) & 1) << 5)); }
__device__ __forceinline__ void stage_rc(int b, int& R, int& C) { const int st = b / 1024, sb = b % 1024, swz = sb ^ (((sb >> 9) & 1) << 5); R = (st >> 1) * 16 + swz / 64; C = (st & 1) * 32 + (swz % 64) / 2; }
__device__ __forceinline__ int perm32(int rho) { const int n = rho >> 4, i = rho & 15; return 8 * (i >> 2) + 4 * n + (i & 3); }
struct Unit { int pm, pn, tag; const char* a; const char* b; };
__device__ __forceinline__ void tile_of(int L, int nM, int nN, int& pm, int& pn) {
    const int nwg = nM * nN; int wgid = L;
    { const int q = nwg / NXCD, r = nwg % NXCD, xcd = wgid % NXCD, off = wgid / NXCD; wgid = (xcd < r ? xcd * (q + 1) : r * (q + 1) + (xcd - r) * q) + off; }
    const int nig = WGM * nN, gid = wgid / nig, fm = gid * WGM, gsz = (nM - fm) < WGM ? (nM - fm) : WGM;
    pm = fm + ((wgid % nig) % gsz); pn = (wgid % nig) / gsz;
}
template <class Epi, class Sched>
__device__ __forceinline__ void gemm_phase(const int wv, LAS unsigned char* lds, const int K, const int lda, const Sched& S, const Epi& E) {
    const int lane = lane_id(), wid = wv, tid = wv * 64 + lane, wr = wid >> 2, wc = wid & 3, fr = lane & 15, fq = lane >> 4;
    const int nt = K / BK;
    unsigned voffA[2], voffB[2];
#pragma unroll
    for (int i = 0; i < 2; ++i) { int R, C; stage_rc(tid * 16 + i * 8192, R, C); const int Rb = (R & ~31) + perm32(R & 31);
        voffA[i] = (unsigned)(R * lda + C) * 2u; voffB[i] = (unsigned)(Rb * K + C) * 2u; }
    const size_t kstep = (size_t)(BK * 2);
    const size_t hA = (size_t)HALF * lda * 2, hB = (size_t)HALF * K * 2;
    const unsigned ldsw = (unsigned)wid * 1024u;
    const int aoff = lds_byte(wr * 64 + fr, fq * 8), boff = lds_byte(wc * 32 + fr, fq * 8);
#define PG8_SA(b, h) (((b) * 2 + (h)) * HTB)
#define PG8_SB(b, h) ((4 + (b) * 2 + (h)) * HTB)
#define PG8_STAGE(bufoff, gbase, voff) do { _Pragma("unroll") for (int _i = 0; _i < 2; ++_i) \
        __builtin_amdgcn_global_load_lds((const unsigned*)((const char*)(gbase) + (voff)[_i]), (LAS unsigned*)(lds + (bufoff) + ldsw + _i * 8192), 16, 0, 0); } while (0)
#define PG8_LDA(dst, b, h) do { _Pragma("unroll") for (int m = 0; m < 4; ++m) _Pragma("unroll") for (int k = 0; k < 2; ++k) dst[m][k] = *(const LAS bf16x8*)(lds + PG8_SA(b, h) + aoff + m * 2048 + k * 1024); } while (0)
#define PG8_LDB(dst, b, h) do { _Pragma("unroll") for (int n = 0; n < 2; ++n) _Pragma("unroll") for (int k = 0; k < 2; ++k) dst[n][k] = *(const LAS bf16x8*)(lds + PG8_SB(b, h) + boff + n * 2048 + k * 1024); } while (0)
#define PG8_MMA(ai, bj, At, Bt) do { __builtin_amdgcn_s_setprio(1); _Pragma("unroll") for (int m = 0; m < 4; ++m) _Pragma("unroll") for (int n = 0; n < 2; ++n) _Pragma("unroll") for (int k = 0; k < 2; ++k) \
        acc[ai][bj][m][n] = __builtin_amdgcn_mfma_f32_16x16x32_bf16(Bt[n][k], At[m][k], acc[ai][bj][m][n], 0, 0, 0); __builtin_amdgcn_s_setprio(0); } while (0)
#define PG8_WAIT_V(n) asm volatile("s_waitcnt vmcnt(" #n ")" ::: "memory")
#define PG8_WAIT_L(n) asm volatile("s_waitcnt lgkmcnt(" #n ")" ::: "memory")
#define PG8_BAR __builtin_amdgcn_s_barrier()
#define PG8_SCHED __builtin_amdgcn_sched_barrier(0)
    Unit cur, nxt; int ui = 0;
    if (!S.next(0, cur)) return;
    f32x4 acc[2][2][4][2];
#pragma unroll
    for (int a = 0; a < 2; ++a)
#pragma unroll
        for (int b = 0; b < 2; ++b)
#pragma unroll
            for (int m = 0; m < 4; ++m)
#pragma unroll
                for (int n = 0; n < 2; ++n) acc[a][b][m][n] = (f32x4){0.f, 0.f, 0.f, 0.f};
    bf16x8 At[4][2], B0[2][2], B1[2][2];
    const char* cA = cur.a; const char* cB = cur.b;
    PG8_STAGE(PG8_SB(0, 0), cB, voffB); PG8_STAGE(PG8_SB(0, 1), cB + hB, voffB); PG8_STAGE(PG8_SA(0, 0), cA, voffA); PG8_STAGE(PG8_SA(0, 1), cA + hA, voffA);
    if (wr == 1) PG8_BAR;
    PG8_WAIT_V(2); PG8_BAR;
    PG8_STAGE(PG8_SB(1, 0), cB + kstep, voffB); PG8_STAGE(PG8_SA(1, 0), cA + kstep, voffA); PG8_STAGE(PG8_SB(1, 1), cB + hB + kstep, voffB);
    PG8_WAIT_V(6); PG8_BAR;
    for (;;) {
        const bool has_next = S.next(ui + 1, nxt);
        const char* nA = has_next ? nxt.a : cA; const char* nB = has_next ? nxt.b : cB;
        for (int t = 0; t < nt; t += 2) {
            const bool last = (t == nt - 2);
            const char* a1 = cA + (size_t)(t + 1) * kstep;
            const char* a2 = last ? nA : cA + (size_t)(t + 2) * kstep; const char* b2 = last ? nB : cB + (size_t)(t + 2) * kstep;
            const char* a3 = a2 + kstep; const char* b3 = b2 + kstep;
            PG8_LDB(B0, 0, 0); PG8_LDB(B1, 0, 1); PG8_SCHED; PG8_LDA(At, 0, 0); PG8_STAGE(PG8_SA(1, 1), a1 + hA, voffA);
            PG8_WAIT_V(8); PG8_WAIT_L(0); PG8_BAR; PG8_MMA(0, 0, At, B0); PG8_MMA(0, 1, At, B1); PG8_BAR; PG8_SCHED;
            PG8_LDA(At, 0, 1); PG8_STAGE(PG8_SB(0, 0), b2, voffB); PG8_STAGE(PG8_SB(0, 1), b2 + hB, voffB); PG8_STAGE(PG8_SA(0, 0), a2, voffA);
            PG8_WAIT_V(8); PG8_WAIT_L(0); PG8_BAR; PG8_MMA(1, 0, At, B0); PG8_MMA(1, 1, At, B1); PG8_BAR; PG8_SCHED;
            PG8_LDB(B0, 1, 0); PG8_LDB(B1, 1, 1); PG8_SCHED; PG8_LDA(At, 1, 0); PG8_STAGE(PG8_SA(0, 1), a2 + hA, voffA);
            PG8_WAIT_V(8); PG8_WAIT_L(0); PG8_BAR; PG8_MMA(0, 0, At, B0); PG8_MMA(0, 1, At, B1); PG8_BAR; PG8_SCHED;
            PG8_LDA(At, 1, 1); PG8_STAGE(PG8_SB(1, 0), b3, voffB); PG8_STAGE(PG8_SB(1, 1), b3 + hB, voffB); PG8_STAGE(PG8_SA(1, 0), a3, voffA);
            PG8_WAIT_V(8); PG8_WAIT_L(0); PG8_BAR; PG8_MMA(1, 0, At, B0); PG8_MMA(1, 1, At, B1); PG8_BAR; PG8_SCHED;
        }
        if (wr == 0) PG8_BAR;
        const bool keep = E(acc, cur, wr, wc, fr, fq);
        if (!has_next) break;
        if (!keep) {
#pragma unroll
        for (int a = 0; a < 2; ++a)
#pragma unroll
            for (int b = 0; b < 2; ++b)
#pragma unroll
                for (int m = 0; m < 4; ++m)
#pragma unroll
                    for (int n = 0; n < 2; ++n) acc[a][b][m][n] = (f32x4){0.f, 0.f, 0.f, 0.f};
        }
        cur = nxt; cA = nA; cB = nB; ++ui;
        if (wr == 1) PG8_BAR;
    }
    PG8_WAIT_V(0);
    PG8_BAR;
#undef PG8_SA
#undef PG8_SB
#undef PG8_STAGE
#undef PG8_LDA
#undef PG8_LDB
#undef PG8_MMA
#undef PG8_WAIT_V
#undef PG8_WAIT_L
#undef PG8_BAR
#undef PG8_SCHED
}
}
using pg8::Unit;
typedef f32x4 Acc[2][2][4][2];
#define EPI_ROWS(ai, m, row) _Pragma("unroll") for (int ai = 0; ai < 2; ++ai) _Pragma("unroll") for (int m = 0; m < 4; ++m) { const int row = u.pm * 256 + ai * 128 + wr * 64 + m * 16 + fr;
#define EPI_END asm volatile("" ::: "memory"); }
__device__ __forceinline__ void get8(const Acc& acc, int ai, int bj, int m, float* v) {
    const f32x4 a = acc[ai][bj][m][0], b = acc[ai][bj][m][1]; v[0] = a[0]; v[1] = a[1]; v[2] = a[2]; v[3] = a[3]; v[4] = b[0]; v[5] = b[1]; v[6] = b[2]; v[7] = b[3]; }

struct Args {
    const float *x_prompt, *x_sample, *g_mix, *w_in, *lb_param, *g_onorm, *g_qa, *w_uq, *g_kva, *w_ukv, *w_branch, *w_out, *g_ffn, *w_gate_up, *w_down, *g_final;
    float* out; unsigned char* ws;
    double inv_rev[16];
    int ph_lo, ph_hi;
};

struct SchedSimple {
    const char* A; const char* B; int nM, nN, G, c; size_t tA, tB;
    __device__ __forceinline__ bool next(int i, Unit& u) const { const long L = (long)i * G + c; if (L >= (long)nM * nN) return false; pg8::tile_of((int)L, nM, nN, u.pm, u.pn); u.tag = 0; u.a = A + u.pm * tA; u.b = B + u.pn * tB; return true; }
};
struct SchedUp {
    const char* LAT; const char* Wuq; const char* Wukv; int G, c;
    __device__ __forceinline__ bool next(int i, Unit& u) const { const long L = (long)i * G + c; if (L >= 256L * 7) return false; pg8::tile_of((int)L, 256, 7, u.pm, u.pn); u.tag = 0;
        u.a = LAT + (size_t)u.pm * 256 * 512 * 2 + (u.pn >= 3 ? 512 : 0); u.b = u.pn < 3 ? Wuq + (size_t)u.pn * 256 * 256 * 2 : Wukv + (size_t)(u.pn - 3) * 256 * 256 * 2; return true; }
};
struct SchedBranch {
    const char* OH; const char* OMm; const char* W0; const char* W1; int G, c;
    __device__ __forceinline__ bool next(int i, Unit& u) const { const long L = (long)(i >> 1) * G + c; if (L >= 256L * 4) return false; pg8::tile_of((int)L, 256, 4, u.pm, u.pn); u.tag = i & 1;
        u.a = ((i & 1) ? OMm : OH) + (size_t)u.pm * 256 * 512 * 2; u.b = ((i & 1) ? W1 : W0) + (size_t)u.pn * 256 * 512 * 2; return true; }
};

struct EpiIn {
    unsigned char* ws; bf16_t *GATES; const float* lbp;
    __device__ __forceinline__ bool operator()(const Acc& acc, const Unit& u, int wr, int wc, int fr, int fq) const {
        const int pn = u.pn, cb = wc * 32 + 8 * fq;
        if (pn < 4 || (pn >= 8 && pn < 10)) {
            bf16_t* dst = (bf16_t*)(ws + (pn < 2 ? WS_HQ : (pn < 4 ? WS_HI : WS_SG))); const int c0 = (pn & 1) * 256; const bool act = (pn < 2 || pn >= 8);
            EPI_ROWS(ai, m, row)
#pragma unroll
                for (int bj = 0; bj < 2; ++bj) { float v[8]; get8(acc, ai, bj, m, v);
                    if (act) {
#pragma unroll
                        for (int i = 0; i < 8; ++i) v[i] = siluf_(v[i]); }
                    *(u32x4*)(dst + (size_t)row * 512 + c0 + bj * 128 + cb) = pack8(v); }
            EPI_END
        } else if (pn < 8) {
            const int dir = (pn >= 6); _Float16* dst = (_Float16*)(ws + (dir ? WS_GB : WS_GF)); const int c0 = (pn & 1) * 256;
            float lb[2][8];
#pragma unroll
            for (int bj = 0; bj < 2; ++bj)
#pragma unroll
                for (int i = 0; i < 8; ++i) { const int col = c0 + bj * 128 + cb + i; lb[bj][i] = sigmoidf_(lbp[dir * 512 + col] - lbp[1024 + dir * 512 + col]); }
            EPI_ROWS(ai, m, row)
#pragma unroll
                for (int bj = 0; bj < 2; ++bj) { float v[8]; get8(acc, ai, bj, m, v); h16x8 h;
#pragma unroll
                    for (int i = 0; i < 8; ++i) { const float f = lb[bj][i] + (1.f - lb[bj][i]) * sigmoidf_(v[i]); h[i] = (_Float16)__logf(f); }
                    *(u32x4*)(dst + (size_t)row * 512 + c0 + bj * 128 + cb) = __builtin_bit_cast(u32x4, h); }
            EPI_END
        } else if (pn < 12) {
            float* RS = (float*)(ws + (pn == 10 ? WS_RSQ : WS_RSKV)); const int c0 = (pn - 10) * 256; bf16_t* LAT = (bf16_t*)(ws + WS_LAT);
            EPI_ROWS(ai, m, row)
                float ss = 0.f;
#pragma unroll
                for (int bj = 0; bj < 2; ++bj) { float v[8]; get8(acc, ai, bj, m, v);
#pragma unroll
                    for (int i = 0; i < 8; ++i) ss += v[i] * v[i];
                    *(u32x4*)(LAT + (size_t)row * 512 + c0 + bj * 128 + cb) = pack8(v); }
                ss += __shfl_xor(ss, 16); ss += __shfl_xor(ss, 32);
                if (fq == 0) atomicAdd(RS + row, ss);
            EPI_END
        } else if (pn < 20) {
            const int c0 = (pn - 12) * 256;
            EPI_ROWS(ai, m, row)
#pragma unroll
                for (int bj = 0; bj < 2; ++bj) { float v[8]; get8(acc, ai, bj, m, v);
#pragma unroll
                    for (int i = 0; i < 8; ++i) v[i] = sigmoidf_(v[i]);
                    *(u32x4*)(GATES + (size_t)row * 2048 + c0 + bj * 128 + cb) = pack8(v); }
            EPI_END
        } else {
            bf16_t* Kc = (bf16_t*)(ws + WS_K); const f32x2* rope = (const f32x2*)(ws + WS_ROPE);
            EPI_ROWS(ai, m, row)
                float v[8], p[8]; get8(acc, ai, 0, m, v);
#pragma unroll
                for (int i = 0; i < 8; ++i) p[i] = __shfl_xor(v[i], 32);
                if (wc == 0) {
                    const int pos = row_pos(row); const f32x2* cs = rope + pos * 16 + 8 * (fq & 1); float o[8];
#pragma unroll
                    for (int i = 0; i < 8; ++i) { const f32x2 c = cs[i]; o[i] = (fq < 2) ? (v[i] * c.x - p[i] * c.y) : (v[i] * c.x + p[i] * c.y); }
                    const u32x4 w = pack8(o);
#pragma unroll
                    for (int h = 0; h < 8; ++h) *(u32x4*)(Kc + ((size_t)row * 8 + h) * 96 + 64 + 8 * fq) = w;
                }
            EPI_END
        }
        return false;
    }
};
struct EpiUp {
    bf16_t *Q, *Kc, *V; const float *RSQ, *RSKV; const f32x2* rope;
    __device__ __forceinline__ bool operator()(const Acc& acc, const Unit& u, int wr, int wc, int fr, int fq) const {
        const int pn = u.pn, cb = wc * 32 + 8 * fq;
        if (pn < 2) {
            EPI_ROWS(ai, m, row)
                const float sc = __builtin_amdgcn_rsqf(RSQ[row] * (1.f / 256.f) + EPS) * QSCALE;
#pragma unroll
                for (int bj = 0; bj < 2; ++bj) { float v[8]; get8(acc, ai, bj, m, v);
#pragma unroll
                    for (int i = 0; i < 8; ++i) v[i] *= sc;
                    const int cg_ = pn * 256 + bj * 128 + cb, h = cg_ >> 6, d = cg_ & 63;
                    *(u32x4*)(Q + ((size_t)row * 8 + h) * 96 + d) = pack8(v); }
            EPI_END
        } else if (pn == 2) {
            EPI_ROWS(ai, m, row)
                const float sc = __builtin_amdgcn_rsqf(RSQ[row] * (1.f / 256.f) + EPS) * QSCALE;
                const int pos = row_pos(row); const f32x2* cs = rope + pos * 16 + 8 * (fq & 1);
#pragma unroll
                for (int bj = 0; bj < 2; ++bj) { float v[8], p[8], o[8]; get8(acc, ai, bj, m, v);
#pragma unroll
                    for (int i = 0; i < 8; ++i) p[i] = __shfl_xor(v[i], 32);
#pragma unroll
                    for (int i = 0; i < 8; ++i) { const f32x2 c = cs[i]; o[i] = ((fq < 2) ? (v[i] * c.x - p[i] * c.y) : (v[i] * c.x + p[i] * c.y)) * sc; }
                    const int h = bj * 4 + wc;
                    *(u32x4*)(Q + ((size_t)row * 8 + h) * 96 + 64 + 8 * fq) = pack8(o); asm volatile("" ::: "memory"); }
            EPI_END
        } else {
            EPI_ROWS(ai, m, row)
                const float sc = __builtin_amdgcn_rsqf(RSKV[row] * (1.f / 256.f) + EPS);
#pragma unroll
                for (int bj = 0; bj < 2; ++bj) { float v[8]; get8(acc, ai, bj, m, v);
#pragma unroll
                    for (int i = 0; i < 8; ++i) v[i] *= sc;
                    const int cg_ = (pn - 3) * 256 + bj * 128 + cb, h = cg_ >> 7, d = cg_ & 127;
                    if (d < 64) *(u32x4*)(Kc + ((size_t)row * 8 + h) * 96 + d) = pack8(v);
                    else *(u32x4*)(V + ((size_t)row * 8 + h) * 64 + (d - 64)) = pack8(v); }
            EPI_END
        }
        return false;
    }
};
struct EpiBranch {
    const bf16_t* GATES; bf16_t* MERGED;
    __device__ __forceinline__ bool operator()(Acc& acc, const Unit& u, int wr, int wc, int fr, int fq) const {
        const int cb = wc * 32 + 8 * fq;
        EPI_ROWS(ai, m, row)
#pragma unroll
            for (int bj = 0; bj < 2; ++bj) { const int col = u.pn * 256 + bj * 128 + cb;
                const u32x4 g1 = *(const u32x4*)(GATES + (size_t)row * 2048 + 1024 + col); float g1f[8] = {bflo(g1.x), bfhi(g1.x), bflo(g1.y), bfhi(g1.y), bflo(g1.z), bfhi(g1.z), bflo(g1.w), bfhi(g1.w)};
                if (u.tag == 0) {
                    const u32x4 g0 = *(const u32x4*)(GATES + (size_t)row * 2048 + col); float g0f[8] = {bflo(g0.x), bfhi(g0.x), bflo(g0.y), bfhi(g0.y), bflo(g0.z), bfhi(g0.z), bflo(g0.w), bfhi(g0.w)};
#pragma unroll
                    for (int i = 0; i < 4; ++i) { acc[ai][bj][m][0][i] *= g0f[i] * __builtin_amdgcn_rcpf(g1f[i]); acc[ai][bj][m][1][i] *= g0f[4 + i] * __builtin_amdgcn_rcpf(g1f[4 + i]); }
                } else {
                    float v[8]; get8(acc, ai, bj, m, v);
#pragma unroll
                    for (int i = 0; i < 8; ++i) v[i] *= g1f[i];
                    *(u32x4*)(MERGED + (size_t)row * 1024 + col) = pack8(v);
                } }
        EPI_END
        return u.tag == 0;
    }
};
struct EpiOut {
    const float *xp, *xs; float* X1; bf16_t* X1B; float* RS;
    __device__ __forceinline__ bool operator()(const Acc& acc, const Unit& u, int wr, int wc, int fr, int fq) const {
        const int cb = wc * 32 + 8 * fq;
        EPI_ROWS(ai, m, row)
            const float* xr = xrow_ptr(xp, xs, row); float ss = 0.f;
#pragma unroll
            for (int bj = 0; bj < 2; ++bj) { const int col = u.pn * 256 + bj * 128 + cb; float v[8]; get8(acc, ai, bj, m, v);
                const f32x4 x0 = *(const f32x4*)(xr + col), x1 = *(const f32x4*)(xr + col + 4);
                v[0] += x0[0]; v[1] += x0[1]; v[2] += x0[2]; v[3] += x0[3]; v[4] += x1[0]; v[5] += x1[1]; v[6] += x1[2]; v[7] += x1[3];
#pragma unroll
                for (int i = 0; i < 8; ++i) ss += v[i] * v[i];
                *(f32x4*)(X1 + (size_t)row * 1024 + col) = (f32x4){v[0], v[1], v[2], v[3]}; *(f32x4*)(X1 + (size_t)row * 1024 + col + 4) = (f32x4){v[4], v[5], v[6], v[7]};
                *(u32x4*)(X1B + (size_t)row * 1024 + col) = pack8(v); }
            ss += __shfl_xor(ss, 16); ss += __shfl_xor(ss, 32);
            if (fq == 0) atomicAdd(RS + row, ss);
        EPI_END
        return false;
    }
};
struct EpiGU {
    const float* RS; bf16_t* ACT;
    __device__ __forceinline__ bool operator()(const Acc& acc, const Unit& u, int wr, int wc, int fr, int fq) const {
        const int cb = wc * 32 + 8 * fq;
        EPI_ROWS(ai, m, row)
            const float sc = __builtin_amdgcn_rsqf(RS[row] * (1.f / 1024.f) + EPS);
            float g[8], p[8]; get8(acc, ai, 0, m, g); get8(acc, ai, 1, m, p);
#pragma unroll
            for (int i = 0; i < 8; ++i) g[i] = siluf_(g[i] * sc) * (p[i] * sc);
            *(u32x4*)(ACT + (size_t)row * DFF + u.pn * 128 + cb) = pack8(g);
        EPI_END
        return false;
    }
};
struct EpiDown {
    const float* X1; float* X2; float* RS;
    __device__ __forceinline__ bool operator()(const Acc& acc, const Unit& u, int wr, int wc, int fr, int fq) const {
        const int cb = wc * 32 + 8 * fq;
        EPI_ROWS(ai, m, row)
            float ss = 0.f;
#pragma unroll
            for (int bj = 0; bj < 2; ++bj) { const int col = u.pn * 256 + bj * 128 + cb; float v[8]; get8(acc, ai, bj, m, v);
                const f32x4 x0 = *(const f32x4*)(X1 + (size_t)row * 1024 + col), x1 = *(const f32x4*)(X1 + (size_t)row * 1024 + col + 4);
                v[0] += x0[0]; v[1] += x0[1]; v[2] += x0[2]; v[3] += x0[3]; v[4] += x1[0]; v[5] += x1[1]; v[6] += x1[2]; v[7] += x1[3];
#pragma unroll
                for (int i = 0; i < 8; ++i) ss += v[i] * v[i];
                *(f32x4*)(X2 + (size_t)row * 1024 + col) = (f32x4){v[0], v[1], v[2], v[3]}; *(f32x4*)(X2 + (size_t)row * 1024 + col + 4) = (f32x4){v[4], v[5], v[6], v[7]}; }
            ss += __shfl_xor(ss, 16); ss += __shfl_xor(ss, 32);
            if (fq == 0) atomicAdd(RS + row, ss);
        EPI_END
        return false;
    }
};

namespace att {
constexpr int LDQ = 768, LDK = 768, LDV = 512, LDO = 512, KVBLK = 64, QBLK = 32;
constexpr int SHM_K = 64 * 256, SHM_V = 64 * 64 * 2;
constexpr float THR = 8.f;
#define KSWZ(row, colB) ((row) * 256 + ((colB) ^ (((row) & 7) << 4)))
__device__ __forceinline__ void partialSM(f32x16& p0, f32x16& p1, float& m_reg, float& mn, float& alpha) {
    float pmax = p0[0];
#pragma unroll
    for (int r = 1; r < 16; ++r) pmax = fmaxf(pmax, p0[r]);
#pragma unroll
    for (int r = 0; r < 16; ++r) pmax = fmaxf(pmax, p1[r]);
    { auto rr = __builtin_amdgcn_permlane32_swap(__float_as_uint(pmax), __float_as_uint(pmax), false, false); pmax = fmaxf(__uint_as_float(rr[0]), __uint_as_float(rr[1])); }
    if (__builtin_expect(__all(pmax - m_reg <= THR), 1)) { mn = m_reg; alpha = 1.f; }
    else { mn = fmaxf(m_reg, pmax); alpha = __builtin_amdgcn_exp2f(m_reg - mn); m_reg = mn; }
#pragma unroll
    for (int r = 0; r < 16; ++r) p0[r] = p0[r] - mn;
#pragma unroll
    for (int r = 0; r < 16; ++r) p1[r] = p1[r] - mn;
#pragma unroll
    for (int r = 0; r < 16; ++r) p0[r] = __builtin_amdgcn_exp2f(p0[r]);
}
__device__ __forceinline__ void finishSM(f32x16& p0, f32x16& p1, float alpha, float& l_reg, bf16x8& pa0, bf16x8& pa1, bf16x8& pa2, bf16x8& pa3) {
#pragma unroll
    for (int r = 0; r < 16; ++r) p1[r] = __builtin_amdgcn_exp2f(p1[r]);
    float ps = 0;
#pragma unroll
    for (int r = 0; r < 16; ++r) ps += p0[r];
#pragma unroll
    for (int r = 0; r < 16; ++r) ps += p1[r];
    { auto rr = __builtin_amdgcn_permlane32_swap(__float_as_uint(ps), __float_as_uint(ps), false, false); ps = __uint_as_float(rr[0]) + __uint_as_float(rr[1]); }
    l_reg = l_reg * alpha + ps;
#define PK4(P, BASE, OUT) do { unsigned a0 = cvtpk(P[BASE + 0], P[BASE + 1]), a1 = cvtpk(P[BASE + 2], P[BASE + 3]);   \
    unsigned b0 = cvtpk(P[BASE + 4], P[BASE + 5]), b1 = cvtpk(P[BASE + 6], P[BASE + 7]);                              \
    auto r0 = __builtin_amdgcn_permlane32_swap(a0, b0, false, false); auto r1 = __builtin_amdgcn_permlane32_swap(a1, b1, false, false); \
    u32x4 w = {r0[0], r1[0], r0[1], r1[1]}; OUT = *reinterpret_cast<bf16x8*>(&w); } while (0)
    PK4(p0, 0, pa0); PK4(p0, 8, pa1); PK4(p1, 0, pa2); PK4(p1, 8, pa3);
#undef PK4
}
__device__ __forceinline__ void qkt(f32x16& p0, f32x16& p1, const char* Ks, const bf16x8* qr, int r32, int hi) {
    p0 = f32x16{}; p1 = f32x16{};
#pragma unroll
    for (int d0 = 0; d0 < 6; ++d0) { const int cb = (d0 * 16 + hi * 8) * 2;
        bf16x8 b0 = *reinterpret_cast<const bf16x8*>(Ks + KSWZ(r32, cb));
        bf16x8 b1 = *reinterpret_cast<const bf16x8*>(Ks + KSWZ(32 + r32, cb));
        p0 = __builtin_amdgcn_mfma_f32_32x32x16_bf16(b0, qr[d0], p0, 0, 0, 0);
        p1 = __builtin_amdgcn_mfma_f32_32x32x16_bf16(b1, qr[d0], p1, 0, 0, 0); }
}
__device__ __forceinline__ int v_st(int k, int c) { const int kk = (k & ~0xC) | ((k & 4) << 1) | ((k & 8) >> 1); return ((kk >> 3) * 2 + (c >> 5)) * 512 + ((kk & 7) * 32 + (c & 31)) * 2; }
__device__ __forceinline__ int v_rd_base(int lane) { return ((lane & 3) << 3) | (((lane >> 2) & 3) << 6) | (((lane >> 4) & 1) << 5) | (((lane >> 5) & 1) << 8); }
constexpr int v_rd_off(int d0, int ks, int half) { return d0 * 512 + ks * 2048 + half * 1024; }
template <int OFF> __device__ __forceinline__ s16x4 tr_read(int vb) { s16x4 r; asm volatile("ds_read_b64_tr_b16 %0, %1 offset:%2" : "=&v"(r) : "v"(vb), "i"(OFF) : "memory"); return r; }
template <int D0> __device__ __forceinline__ void pv_one(f32x16& od, int vb, bf16x8 pa0, bf16x8 pa1, bf16x8 pa2, bf16x8 pa3) {
    const s16x4 l0 = tr_read<v_rd_off(D0, 0, 0)>(vb), h0 = tr_read<v_rd_off(D0, 0, 1)>(vb), l1 = tr_read<v_rd_off(D0, 1, 0)>(vb), h1 = tr_read<v_rd_off(D0, 1, 1)>(vb);
    const s16x4 l2 = tr_read<v_rd_off(D0, 2, 0)>(vb), h2 = tr_read<v_rd_off(D0, 2, 1)>(vb), l3 = tr_read<v_rd_off(D0, 3, 0)>(vb), h3 = tr_read<v_rd_off(D0, 3, 1)>(vb);
    asm volatile("s_waitcnt lgkmcnt(0)" ::: "memory"); SBAR();
#define PK(L, H) (bf16x8){L[0], L[1], L[2], L[3], H[0], H[1], H[2], H[3]}
    od = __builtin_amdgcn_mfma_f32_32x32x16_bf16(pa0, PK(l0, h0), od, 0, 0, 0);
    od = __builtin_amdgcn_mfma_f32_32x32x16_bf16(pa1, PK(l1, h1), od, 0, 0, 0);
    od = __builtin_amdgcn_mfma_f32_32x32x16_bf16(pa2, PK(l2, h2), od, 0, 0, 0);
    od = __builtin_amdgcn_mfma_f32_32x32x16_bf16(pa3, PK(l3, h3), od, 0, 0, 0);
#undef PK
}
__device__ __forceinline__ void pv_d0(f32x16* o, int vb, bf16x8 pa0, bf16x8 pa1, bf16x8 pa2, bf16x8 pa3) { pv_one<0>(o[0], vb, pa0, pa1, pa2, pa3); pv_one<1>(o[1], vb, pa0, pa1, pa2, pa3); }

__device__ __forceinline__ void attn_unit(const bf16_t* __restrict__ Qb, const bf16_t* __restrict__ Kh, const bf16_t* __restrict__ Vh, bf16_t* __restrict__ Ob, int seq, char* lds, const int wv) {
    const int lane = lane_id(), wid = wv, tid = wv * 64 + lane, r32 = lane & 31, hi = lane >> 5;
    char* V_lds = lds; char* K_lds = lds + 2 * SHM_V;
    float* ws = (float*)(lds + 2 * SHM_V + 2 * SHM_K) + wid * 64; float* li_l = ws; float* al_l = ws + 32;
    float m_reg = -1e30f, l_reg = 0; f32x16 o[2] = {}; bf16x8 qr[6];
    const bf16_t* Qw = Qb + (long)(wid * QBLK + r32) * LDQ + hi * 8;
#pragma unroll
    for (int d0 = 0; d0 < 6; ++d0) qr[d0] = *reinterpret_cast<const bf16x8*>(Qw + d0 * 16);
    const int kc1 = tid, kc2 = 512 + (tid & 255); const int kr1 = kc1 / 12, kp1 = kc1 % 12, kr2 = kc2 / 12, kp2 = kc2 % 12; const int vr = tid >> 3, vp = tid & 7;
    const int kst1 = KSWZ(kr1, kp1 * 16), kst2 = KSWZ(kr2, kp2 * 16), vst = v_st(vr, vp * 8);
    const int vb0 = (int)(uintptr_t)V_lds + v_rd_base(lane);
    struct { bf16x8 k1, k2, v; } sr_[2];
#define SLOAD(i, k0) do { sr_[i].k1 = *reinterpret_cast<const bf16x8*>(&Kh[(long)((k0) + kr1) * LDK + kp1 * 8]); sr_[i].k2 = *reinterpret_cast<const bf16x8*>(&Kh[(long)((k0) + kr2) * LDK + kp2 * 8]); \
    sr_[i].v = *reinterpret_cast<const bf16x8*>(&Vh[(long)((k0) + vr) * LDV + vp * 8]); } while (0)
#define SWRITE(b, i) do { *(bf16x8*)(K_lds + (b) * SHM_K + kst1) = sr_[i].k1; *(bf16x8*)(K_lds + (b) * SHM_K + kst2) = sr_[i].k2; *(bf16x8*)(V_lds + (b) * SHM_V + vst) = sr_[i].v; } while (0)
#define SWAIT() asm volatile("s_waitcnt vmcnt(3)" ::: "memory")
#define RESC(a) do { if (__any((a) < 1.f)) { if (hi == 0) al_l[r32] = (a); asm volatile("s_waitcnt lgkmcnt(0)" ::: "memory"); \
    _Pragma("unroll") for (int d = 0; d < 2; ++d) _Pragma("unroll") for (int r = 0; r < 16; ++r) o[d][r] *= al_l[crow(r, hi)]; } } while (0)
    f32x16 pA0, pA1, pB0, pB1; float mnA, mnB, alA, alB; bf16x8 pa0, pa1, pa2, pa3; const int NT = seq / KVBLK;
    constexpr int SE = 0, SO = 1;
    SLOAD(SE, 0); asm volatile("s_waitcnt vmcnt(0)" ::: "memory"); SWRITE(0, SE); __syncthreads();
    qkt(pA0, pA1, K_lds, qr, r32, hi); partialSM(pA0, pA1, m_reg, mnA, alA);
    SLOAD(SO, KVBLK); if (2 < NT) SLOAD(SE, 2 * KVBLK);
    SWAIT(); SWRITE(1, SO); __syncthreads();
    for (int j = 1; j + 1 < NT; j += 2) {
        SBAR(); qkt(pB0, pB1, K_lds + SHM_K, qr, r32, hi);
        finishSM(pA0, pA1, alA, l_reg, pa0, pa1, pa2, pa3); SBAR();
        SLOAD(SO, (j + 2) * KVBLK); SBAR();
        pv_d0(o, vb0, pa0, pa1, pa2, pa3); partialSM(pB0, pB1, m_reg, mnB, alB);
        __syncthreads(); SWAIT(); SWRITE(0, SE);
        RESC(alB); __syncthreads();
        SBAR(); qkt(pA0, pA1, K_lds, qr, r32, hi);
        finishSM(pB0, pB1, alB, l_reg, pa0, pa1, pa2, pa3); SBAR();
        if (j + 3 < NT) SLOAD(SE, (j + 3) * KVBLK); SBAR();
        pv_d0(o, vb0 + SHM_V, pa0, pa1, pa2, pa3); partialSM(pA0, pA1, m_reg, mnA, alA);
        __syncthreads(); if (j + 3 < NT) SWAIT(); else asm volatile("s_waitcnt vmcnt(0)" ::: "memory"); SWRITE(1, SO);
        RESC(alA); __syncthreads();
    }
    SBAR(); qkt(pB0, pB1, K_lds + SHM_K, qr, r32, hi);
    finishSM(pA0, pA1, alA, l_reg, pa0, pa1, pa2, pa3); SBAR();
    pv_d0(o, vb0, pa0, pa1, pa2, pa3); partialSM(pB0, pB1, m_reg, mnB, alB);
    __syncthreads(); RESC(alB);
    finishSM(pB0, pB1, alB, l_reg, pa0, pa1, pa2, pa3); SBAR();
    pv_d0(o, vb0 + SHM_V, pa0, pa1, pa2, pa3);
    if (hi == 0) li_l[r32] = l_reg; asm volatile("s_waitcnt lgkmcnt(0)" ::: "memory");
    float rli[16];
#pragma unroll
    for (int r = 0; r < 16; ++r) rli[r] = __builtin_amdgcn_rcpf(li_l[crow(r, hi)]);
    bf16_t* Ow = Ob + (long)(wid * QBLK) * LDO;
#pragma unroll
    for (int r = 0; r < 16; ++r) { const int orow = crow(r, hi);
#pragma unroll
        for (int d0 = 0; d0 < 2; ++d0) Ow[(long)orow * LDO + d0 * 32 + r32] = (bf16_t)(cvtpk(o[d0][r] * rli[r], 0.f) & 0xffffu); }
    __syncthreads();
#undef SLOAD
#undef SWRITE
#undef SWAIT
#undef RESC
}
}

namespace hg {
constexpr int QP = 136, TP = 72;
constexpr int OFF_QIN = 0, OFF_KIN = 64 * QP * 2, OFF_KINT = 2 * 64 * QP * 2, OFF_VT = OFF_KINT + 128 * TP * 2, OFF_TOT1 = OFF_VT + 128 * TP * 2, OFF_FAC = OFF_TOT1 + 1024, HALF_BYTES = OFF_FAC + 512;
static_assert(2 * HALF_BYTES <= LDS_CTL, "HGRN LDS");
__device__ __forceinline__ bf16x8 ld2x4(const char* p0, const char* p1) { const s16x4 a = *(const s16x4*)p0, b = *(const s16x4*)p1; return (bf16x8){a[0], a[1], a[2], a[3], b[0], b[1], b[2], b[3]}; }
__device__ __forceinline__ bf16x8 packf8(const f32x16& a, int base) { u32x4 w; w.x = cvtpk(a[base], a[base + 1]); w.y = cvtpk(a[base + 2], a[base + 3]); w.z = cvtpk(a[base + 4], a[base + 5]); w.w = cvtpk(a[base + 6], a[base + 7]); return __builtin_bit_cast(bf16x8, w); }
__device__ __forceinline__ void unit(char* lds, int seqbase, int S, int h, const bf16_t* __restrict__ HQ, const bf16_t* __restrict__ HI, const _Float16* __restrict__ GF, const _Float16* __restrict__ GB, bf16_t* OFW, bf16_t* OBW, const int wv) {
    const int lane = lane_id(), tid = wv * 64 + lane, bwd = wv >> 2, ht = tid & 255, w = wv & 3, r32 = lane & 31, hi = lane >> 5;
    char* base = lds + bwd * HALF_BYTES;
    char* QIN = base + OFF_QIN; char* KIN = base + OFF_KIN; char* KINT = base + OFF_KINT; char* VT = base + OFF_VT; float* TOT1 = (float*)(base + OFF_TOT1); float* FAC = (float*)(base + OFF_FAC);
    const _Float16* G = bwd ? GB : GF; bf16_t* O = bwd ? OBW : OFW;
    const int nc = S / 64, part = ht >> 7, d = ht & 127, e0 = 32 * w;
    f32x16 Sacc[4] = {};
    if (part == 1) { TOT1[d] = 0.f; TOT1[128 + d] = 0.f; }
    __syncthreads();
    for (int c = 0; c < nc; ++c) {
        const int c0 = seqbase + (bwd ? (nc - 1 - c) * 64 : c * 64);
        {
            const size_t colo = (size_t)h * 128 + d;
            if (part == 0) {
                float a = 0.f, tot = 0.f;
#pragma unroll 8
                for (int tt = 31; tt >= 0; --tt) { const int row = c0 + (bwd ? 63 - tt : tt);
                    const float g = (float)G[(size_t)row * 512 + colo], q = bf2f(HQ[(size_t)row * 512 + colo]);
                    const float e1 = __expf(a), e2 = __expf(-a), kk = 1.f - __expf(g);
                    const unsigned pq = cvtpk(q * e1, kk * e2);
                    *(bf16_t*)(QIN + (tt * QP + d) * 2) = (bf16_t)(pq & 0xffffu); *(bf16_t*)(KIN + (tt * QP + d) * 2) = (bf16_t)(pq >> 16); *(bf16_t*)(KINT + (d * TP + tt) * 2) = (bf16_t)(pq >> 16);
                    a -= g; tot += g; }
                FAC[d] = __expf(tot + TOT1[((c + 1) & 1) * 128 + d]);
            } else {
                float a = 0.f;
#pragma unroll 8
                for (int tt = 32; tt < 64; ++tt) { const int row = c0 + (bwd ? 63 - tt : tt);
                    const float g = (float)G[(size_t)row * 512 + colo], q = bf2f(HQ[(size_t)row * 512 + colo]);
                    a += g;
                    const float e1 = __expf(a), e2 = __expf(-a), kk = 1.f - __expf(g);
                    const unsigned pq = cvtpk(q * e1, kk * e2);
                    *(bf16_t*)(QIN + (tt * QP + d) * 2) = (bf16_t)(pq & 0xffffu); *(bf16_t*)(KIN + (tt * QP + d) * 2) = (bf16_t)(pq >> 16); *(bf16_t*)(KINT + (d * TP + tt) * 2) = (bf16_t)(pq >> 16); }
                TOT1[(c & 1) * 128 + d] = a;
            }
#pragma unroll
            for (int j = 0; j < 4; ++j) { const int id = ht + 256 * j, tt = id & 63, e8 = (id >> 6) * 8; const int row = c0 + (bwd ? 63 - tt : tt);
                const u32x4 v = *(const u32x4*)(HI + (size_t)row * 512 + h * 128 + e8);
                const unsigned vv[4] = {v.x, v.y, v.z, v.w};
#pragma unroll
                for (int i = 0; i < 4; ++i) { *(bf16_t*)(VT + ((e8 + 2 * i) * TP + tt) * 2) = (bf16_t)(vv[i] & 0xffffu); *(bf16_t*)(VT + ((e8 + 2 * i + 1) * TP + tt) * 2) = (bf16_t)(vv[i] >> 16); } }
        }
        __syncthreads();
        {
#pragma unroll
            for (int db = 0; db < 4; ++db)
#pragma unroll
                for (int r = 0; r < 16; ++r) Sacc[db][r] *= FAC[32 * db + crow(r, hi)];
            f32x16 p00 = {}, p01 = {}, p11 = {};
#pragma unroll
            for (int kk = 0; kk < 8; ++kk) { const int co = (16 * kk + 8 * hi) * 2;
                const bf16x8 k0 = *(const bf16x8*)(KIN + r32 * QP * 2 + co), k1 = *(const bf16x8*)(KIN + (32 + r32) * QP * 2 + co);
                const bf16x8 q0 = *(const bf16x8*)(QIN + r32 * QP * 2 + co), q1 = *(const bf16x8*)(QIN + (32 + r32) * QP * 2 + co);
                p00 = __builtin_amdgcn_mfma_f32_32x32x16_bf16(k0, q0, p00, 0, 0, 0);
                p01 = __builtin_amdgcn_mfma_f32_32x32x16_bf16(k0, q1, p01, 0, 0, 0);
                p11 = __builtin_amdgcn_mfma_f32_32x32x16_bf16(k1, q1, p11, 0, 0, 0); }
#pragma unroll
            for (int r = 0; r < 16; ++r) { if (crow(r, hi) > r32) { p00[r] = 0.f; p11[r] = 0.f; } }
            f32x16 o0 = {}, o1 = {};
#pragma unroll
            for (int kk = 0; kk < 8; ++kk) { const bf16x8 sf = packf8(Sacc[kk >> 1], 8 * (kk & 1)); const int co = (16 * kk + 4 * hi) * 2;
                const bf16x8 b0 = ld2x4(QIN + r32 * QP * 2 + co, QIN + r32 * QP * 2 + co + 16), b1 = ld2x4(QIN + (32 + r32) * QP * 2 + co, QIN + (32 + r32) * QP * 2 + co + 16);
                o0 = __builtin_amdgcn_mfma_f32_32x32x16_bf16(sf, b0, o0, 0, 0, 0);
                o1 = __builtin_amdgcn_mfma_f32_32x32x16_bf16(sf, b1, o1, 0, 0, 0); }
            const char* vrow = VT + (e0 + r32) * TP * 2;
#pragma unroll
            for (int k2 = 0; k2 < 2; ++k2) { const int co = (16 * k2 + 4 * hi) * 2;
                const bf16x8 va = ld2x4(vrow + co, vrow + co + 16), vb = ld2x4(vrow + 64 + co, vrow + 64 + co + 16);
                o0 = __builtin_amdgcn_mfma_f32_32x32x16_bf16(va, packf8(p00, 8 * k2), o0, 0, 0, 0);
                o1 = __builtin_amdgcn_mfma_f32_32x32x16_bf16(va, packf8(p01, 8 * k2), o1, 0, 0, 0);
                o1 = __builtin_amdgcn_mfma_f32_32x32x16_bf16(vb, packf8(p11, 8 * k2), o1, 0, 0, 0); }
#pragma unroll
            for (int kk = 0; kk < 4; ++kk) { const int co = (16 * kk + 8 * hi) * 2; const bf16x8 vfr = *(const bf16x8*)(vrow + co);
#pragma unroll
                for (int db = 0; db < 4; ++db) { const bf16x8 kf = *(const bf16x8*)(KINT + (32 * db + r32) * TP * 2 + co); Sacc[db] = __builtin_amdgcn_mfma_f32_32x32x16_bf16(kf, vfr, Sacc[db], 0, 0, 0); } }
#pragma unroll
            for (int tb = 0; tb < 2; ++tb) { const int tt = 32 * tb + r32, row = c0 + (bwd ? 63 - tt : tt); bf16_t* op = O + (size_t)row * 512 + h * 128 + e0 + 4 * hi;
#pragma unroll
                for (int r4 = 0; r4 < 4; ++r4) { const f32x16& oo = tb ? o1 : o0; u32x2 pk; pk.x = cvtpk(oo[4 * r4], oo[4 * r4 + 1]); pk.y = cvtpk(oo[4 * r4 + 2], oo[4 * r4 + 3]); *(u32x2*)(op + 8 * r4) = pk; } }
        }
        __syncthreads();
    }
}
}

__device__ __forceinline__ float wave_sum(float v) {
#pragma unroll
    for (int o = 1; o < 64; o <<= 1) v += __shfl_xor(v, o);
    return v;
}
__device__ __forceinline__ void transpose_item(const float* W, int K, int N, int k0, int n0, bf16_t* WT, int dst0, const float* kscale, LAS float* scr, int lane) {
#pragma unroll 8
    for (int i = 0; i < 32; ++i) { const int kk = 2 * i + (lane >> 5); float v = W[(size_t)(k0 + kk) * N + n0 + (lane & 31)]; if (kscale) v *= kscale[k0 + kk]; scr[kk * 33 + (lane & 31)] = v; }
    asm volatile("s_waitcnt lgkmcnt(0)" ::: "memory");
    const int c = lane & 7;
#pragma unroll
    for (int j = 0; j < 4; ++j) { const int n = (lane >> 3) + 8 * j; const LAS float* s = scr + (8 * c) * 33 + n;
        u32x4 o; o.x = cvtpk(s[0 * 33], s[1 * 33]); o.y = cvtpk(s[2 * 33], s[3 * 33]); o.z = cvtpk(s[4 * 33], s[5 * 33]); o.w = cvtpk(s[6 * 33], s[7 * 33]);
        *(u32x4*)(WT + (size_t)(dst0 + n) * K + k0 + 8 * c) = o; }
    asm volatile("s_waitcnt lgkmcnt(0)" ::: "memory");
}

__device__ __forceinline__ void grid_barrier(unsigned* bar, const int wv) {
    __builtin_amdgcn_fence(__ATOMIC_RELEASE, "agent");
    __syncthreads();
    if (wv == 0 && lane_id() == 0) {
        const unsigned nb = gridDim.x;
        const unsigned old = __hip_atomic_fetch_add(bar, 1u, __ATOMIC_RELAXED, __HIP_MEMORY_SCOPE_AGENT);
        const unsigned target = (old / nb + 1u) * nb;
        while (__hip_atomic_load(bar, __ATOMIC_RELAXED, __HIP_MEMORY_SCOPE_AGENT) < target) __builtin_amdgcn_s_sleep(4);
    }
    __syncthreads();
    __builtin_amdgcn_fence(__ATOMIC_ACQUIRE, "agent");
}
#define WinT ((bf16_t*)(ws + WS_WIN))
#define WuqT ((bf16_t*)(ws + WS_WUQ))
#define WukvT ((bf16_t*)(ws + WS_WUKV))
#define Wb0T ((bf16_t*)(ws + WS_WB0))
#define Wb1T ((bf16_t*)(ws + WS_WB1))
#define WoT ((bf16_t*)(ws + WS_WO))
#define WguT ((bf16_t*)(ws + WS_WGU))
#define WdT ((bf16_t*)(ws + WS_WD))
#define XN ((bf16_t*)(ws + WS_XN))
#define HQ ((bf16_t*)(ws + WS_HQ))
#define HI ((bf16_t*)(ws + WS_HI))
#define GF ((_Float16*)(ws + WS_GF))
#define GB ((_Float16*)(ws + WS_GB))
#define SG ((bf16_t*)(ws + WS_SG))
#define LAT ((bf16_t*)(ws + WS_LAT))
#define Qm ((bf16_t*)(ws + WS_Q))
#define Km ((bf16_t*)(ws + WS_K))
#define Vm ((bf16_t*)(ws + WS_V))
#define OM ((bf16_t*)(ws + WS_OM))
#define OFW ((bf16_t*)(ws + WS_OFW))
#define OBW ((bf16_t*)(ws + WS_OBW))
#define OH ((bf16_t*)(ws + WS_OH))
#define MERGED ((bf16_t*)(ws + WS_MERGED))
#define X1 ((float*)(ws + WS_X1))
#define X1B ((bf16_t*)(ws + WS_X1B))
#define ACT ((bf16_t*)(ws + WS_ACT))
#define GATES ((bf16_t*)a.out)
#define RSQ ((float*)(ws + WS_RSQ))
#define RSKV ((float*)(ws + WS_RSKV))
#define RSX1 ((float*)(ws + WS_RSX1))
#define RSX2 ((float*)(ws + WS_RSX2))
#define ROPE ((f32x2*)(ws + WS_ROPE))
#define QUEUE ((unsigned*)(ws + WS_QUEUE))
__global__ void __launch_bounds__(512, 2) fwd_megakernel(Args a) {
    extern __shared__ __attribute__((aligned(16))) unsigned char lds[];
    const int G = gridDim.x, bx = blockIdx.x;
    const int wv = __builtin_amdgcn_readfirstlane((int)threadIdx.x >> 6);
#define TIDS const int lane = lane_id(), wave = wv, tid = wv * 64 + lane; (void)tid;
    unsigned char* ws = a.ws;
    LAS unsigned char* ldsl = (LAS unsigned char*)lds;
    const int lo = a.ph_lo, hi_ = a.ph_hi;
#ifndef PHMASK
#define PHMASK 0x3ff
#endif
#define IN(k) (((PHMASK >> (k)) & 1) && lo <= (k) && (k) < hi_)
#define SEAM(k) do { if (IN(k) && IN((k) + 1)) { if ((k) == 0) cg::this_grid().sync(); else grid_barrier((unsigned*)(ws + WS_BAR), wv); } } while (0)

    if (IN(0)) { TIDS
        LAS float* scr = (LAS float*)(ldsl + wave * 16384);
        const int gw = bx * 8 + wave, NGW = G * 8;
        constexpr int I_IN = 16 * 161, I_UQ = 4 * 24, I_UKV = 4 * 32, I_B = 8 * 32, I_O = 16 * 32, I_GU = 16 * 176, I_D = 44 * 32;
        constexpr int NITEMS = I_IN + I_UQ + I_UKV + 2 * I_B + I_O + I_GU + I_D;
        for (int it = gw; it < NITEMS; it += NGW) {
            int r = it;
            if (r < I_IN) { const int kb = r / 161, nb = r % 161; const int dst = nb < 96 ? 32 * nb : (nb == 96 ? 5120 : 3072 + 32 * (nb - 97)); transpose_item(a.w_in, 1024, 5152, 64 * kb, 32 * nb, WinT, dst, nullptr, scr, lane); continue; } r -= I_IN;
            if (r < I_UQ) { const int kb = r / 24, nb = r % 24, h = nb / 3, p = nb % 3; const int dst = p < 2 ? h * 64 + 32 * p : 512 + 32 * h; transpose_item(a.w_uq, 256, 768, 64 * kb, 32 * nb, WuqT, dst, a.g_qa, scr, lane); continue; } r -= I_UQ;
            if (r < I_UKV) { const int kb = r / 32, nb = r % 32; transpose_item(a.w_ukv, 256, 1024, 64 * kb, 32 * nb, WukvT, 32 * nb, a.g_kva, scr, lane); continue; } r -= I_UKV;
            if (r < I_B) { const int kb = r / 32, nb = r % 32; transpose_item(a.w_branch, 512, 1024, 64 * kb, 32 * nb, Wb0T, 32 * nb, nullptr, scr, lane); continue; } r -= I_B;
            if (r < I_B) { const int kb = r / 32, nb = r % 32; transpose_item(a.w_branch + 512 * 1024, 512, 1024, 64 * kb, 32 * nb, Wb1T, 32 * nb, nullptr, scr, lane); continue; } r -= I_B;
            if (r < I_O) { const int kb = r / 32, nb = r % 32; transpose_item(a.w_out, 1024, 1024, 64 * kb, 32 * nb, WoT, 32 * nb, nullptr, scr, lane); continue; } r -= I_O;
            if (r < I_GU) { const int kb = r / 176, nb = r % 176; const int col = 32 * nb; const int j = col < DFF ? col : col - DFF; const int dst = 256 * (j / 128) + (col < DFF ? 0 : 128) + (j % 128);
                transpose_item(a.w_gate_up, 1024, 5632, 64 * kb, col, WguT, dst, a.g_ffn, scr, lane); continue; } r -= I_GU;
            { const int kb = r / 32, nb = r % 32; transpose_item(a.w_down, DFF, 1024, 64 * kb, 32 * nb, WdT, 32 * nb, nullptr, scr, lane); }
        }
        for (int m = gw; m < M; m += NGW) {
            const f32x4* xr = (const f32x4*)xrow_ptr(a.x_prompt, a.x_sample, m) + lane; f32x4 v[4]; float s = 0.f;
#pragma unroll
            for (int j = 0; j < 4; ++j) { v[j] = xr[64 * j]; s += (v[j].x * v[j].x + v[j].y * v[j].y) + (v[j].z * v[j].z + v[j].w * v[j].w); }
            const float rstd = __builtin_amdgcn_rsqf(wave_sum(s) * (1.f / 1024.f) + EPS);
            u32x2* o8 = (u32x2*)(XN + (size_t)m * 1024) + lane;
#pragma unroll
            for (int j = 0; j < 4; ++j) { const f32x4 g = ((const f32x4*)a.g_mix)[64 * j + lane]; u32x2 w; w.x = cvtpk(v[j].x * rstd * g.x, v[j].y * rstd * g.y); w.y = cvtpk(v[j].z * rstd * g.z, v[j].w * rstd * g.w); o8[64 * j] = w; }
        }
        for (int i = bx * 512 + tid; i < 16384 * 16; i += G * 512) { const int pos = i >> 4, j = i & 15; const double rev = (double)pos * a.inv_rev[j]; const float fr_ = (float)(rev - floor(rev));
            ROPE[i] = (f32x2){__builtin_amdgcn_cosf(fr_), __builtin_amdgcn_sinf(fr_)}; }
    }
    SEAM(0);
    if (IN(1)) {
        SchedSimple S{(const char*)XN, (const char*)WinT, 256, 21, G, bx, (size_t)256 * 1024 * 2, (size_t)256 * 1024 * 2};
        EpiIn E{ws, GATES, a.lb_param};
        pg8::gemm_phase(wv, ldsl, 1024, 1024, S, E);
    }
    SEAM(1);
    if (IN(2)) {
        SchedUp S{(const char*)LAT, (const char*)WuqT, (const char*)WukvT, G, bx};
        EpiUp E{Qm, Km, Vm, RSQ, RSKV, ROPE};
        pg8::gemm_phase(wv, ldsl, 256, 512, S, E);
    }
    SEAM(2);
    if (IN(3)) { TIDS
        volatile LAS unsigned* ctl = (volatile LAS unsigned*)(ldsl + LDS_CTL);
        for (int qk = 0; qk < 8; ++qk) {
            const int xq = (bx + qk) & 7;
            for (;;) {
                __syncthreads();
                if (tid == 0) ctl[0] = atomicAdd(QUEUE + xq * 64 + 32, 1u);
                __syncthreads();
                const int un = (int)ctl[0];
                if (un >= 3) break;
                int seqbase, S, h;
                if (un == 0) { seqbase = T0 + (xq >> 2) * 16384; S = 16384; h = xq & 3; }
                else { const int idx = 2 * xq + (un - 1); seqbase = (idx >> 2) * 8192; S = 8192; h = idx & 3; }
                hg::unit((char*)lds, seqbase, S, h, HQ, HI, GF, GB, OFW, OBW, wv);
            }
        }
        for (int qk = 0; qk < 8; ++qk) {
            const int xq = (bx + qk) & 7;
            for (;;) {
                __syncthreads();
                if (tid == 0) ctl[0] = atomicAdd(QUEUE + xq * 64, 1u);
                __syncthreads();
                const int un = (int)ctl[0];
                if (un >= 256) break;
                int seqbase, S, h, qb;
                if (un < 128) { const int j = un, pair = 2 * xq + (j >> 6); seqbase = T0 + (pair >> 3) * 16384; S = 16384; h = pair & 7; qb = j & 63; }
                else { const int j = un - 128, pair = 4 * xq + (j >> 5); seqbase = (pair >> 3) * 8192; S = 8192; h = pair & 7; qb = j & 31; }
                att::attn_unit(Qm + ((size_t)(seqbase + qb * 256) * 8 + h) * 96, Km + ((size_t)seqbase * 8 + h) * 96, Vm + ((size_t)seqbase * 8 + h) * 64, OM + (size_t)(seqbase + qb * 256) * 512 + h * 64, S, (char*)lds, wv);
            }
        }
    }
    SEAM(3);
    if (IN(4)) { TIDS
        const int gw = bx * 8 + wave, NGW = G * 8;
        for (int m = gw; m < M; m += NGW) {
            const size_t off = (size_t)m * 512 + lane * 8;
            const u32x4 f = *(const u32x4*)(OFW + off), b = *(const u32x4*)(OBW + off), s = *(const u32x4*)(SG + off);
            const unsigned fu[4] = {f.x, f.y, f.z, f.w}, bu[4] = {b.x, b.y, b.z, b.w}, su[4] = {s.x, s.y, s.z, s.w};
            float o[8]; float ss = 0.f;
#pragma unroll
            for (int i = 0; i < 4; ++i) { o[2 * i] = bflo(fu[i]) + bflo(bu[i]); o[2 * i + 1] = bfhi(fu[i]) + bfhi(bu[i]); ss += o[2 * i] * o[2 * i] + o[2 * i + 1] * o[2 * i + 1]; }
            ss += __shfl_xor(ss, 1); ss += __shfl_xor(ss, 2); ss += __shfl_xor(ss, 4); ss += __shfl_xor(ss, 8);
            const float rstd = __builtin_amdgcn_rsqf(ss * (1.f / 128.f) + EPS);
            const f32x4 g0 = *(const f32x4*)(a.g_onorm + lane * 8), g1 = *(const f32x4*)(a.g_onorm + lane * 8 + 4); const float gg[8] = {g0.x, g0.y, g0.z, g0.w, g1.x, g1.y, g1.z, g1.w};
#pragma unroll
            for (int i = 0; i < 4; ++i) { o[2 * i] *= rstd * gg[2 * i] * bflo(su[i]); o[2 * i + 1] *= rstd * gg[2 * i + 1] * bfhi(su[i]); }
            *(u32x4*)(OH + off) = pack8(o);
        }
    }
    SEAM(4);
    if (IN(5)) {
        SchedBranch S{(const char*)OH, (const char*)OM, (const char*)Wb0T, (const char*)Wb1T, G, bx};
        EpiBranch E{GATES, MERGED};
        pg8::gemm_phase(wv, ldsl, 512, 512, S, E);
    }
    SEAM(5);
    if (IN(6)) {
        SchedSimple S{(const char*)MERGED, (const char*)WoT, 256, 4, G, bx, (size_t)256 * 1024 * 2, (size_t)256 * 1024 * 2};
        EpiOut E{a.x_prompt, a.x_sample, X1, X1B, RSX1};
        pg8::gemm_phase(wv, ldsl, 1024, 1024, S, E);
    }
    SEAM(6);
    if (IN(7)) {
        SchedSimple S{(const char*)X1B, (const char*)WguT, 256, 22, G, bx, (size_t)256 * 1024 * 2, (size_t)256 * 1024 * 2};
        EpiGU E{RSX1, ACT};
        pg8::gemm_phase(wv, ldsl, 1024, 1024, S, E);
    }
    SEAM(7);
    if (IN(8)) {
        SchedSimple S{(const char*)ACT, (const char*)WdT, 256, 4, G, bx, (size_t)256 * DFF * 2, (size_t)256 * DFF * 2};
        EpiDown E{X1, a.out, RSX2};
        pg8::gemm_phase(wv, ldsl, DFF, DFF, S, E);
    }
    SEAM(8);
    if (IN(9)) { TIDS
        const int gw = bx * 8 + wave, NGW = G * 8;
        for (int m = gw; m < M; m += NGW) {
            const float rstd = __builtin_amdgcn_rsqf(RSX2[m] * (1.f / 1024.f) + EPS);
            f32x4* yr = (f32x4*)(a.out + (size_t)m * 1024) + lane;
#pragma unroll
            for (int j = 0; j < 4; ++j) { const f32x4 g = ((const f32x4*)a.g_final)[64 * j + lane]; f32x4 v = yr[64 * j]; v.x *= rstd * g.x; v.y *= rstd * g.y; v.z *= rstd * g.z; v.w *= rstd * g.w; yr[64 * j] = v; }
        }
    }
#undef IN
#undef SEAM
}

extern "C" void kernel_launch(void* const* d_in, const int* in_sizes, int n_in, void* d_out, int out_size, void* d_ws, size_t ws_size, hipStream_t stream) {
    static int grid = 0;
    if (grid == 0) {
        if (n_in != 16 || out_size != M * DM || ws_size < WS_END) { fprintf(stderr, "kernel_launch: unexpected shapes: n_in %d out %d ws %zu (need %zu)\n", n_in, out_size, ws_size, (size_t)WS_END); grid = -1; return; }
        int dev = 0, cus = 0, per_cu = 0;
        if (hipGetDevice(&dev) != hipSuccess || hipDeviceGetAttribute(&cus, hipDeviceAttributeMultiprocessorCount, dev) != hipSuccess) { grid = -1; return; }
        if (hipFuncSetAttribute((const void*)fwd_megakernel, hipFuncAttributeMaxDynamicSharedMemorySize, LDS_BYTES) != hipSuccess) { fprintf(stderr, "kernel_launch: hipFuncSetAttribute failed\n"); grid = -1; return; }
        if (hipOccupancyMaxActiveBlocksPerMultiprocessor(&per_cu, (const void*)fwd_megakernel, 512, LDS_BYTES) != hipSuccess || per_cu < 1) { fprintf(stderr, "kernel_launch: occupancy query says %d\n", per_cu); per_cu = 1; }
        (void)hipGetLastError();
        grid = cus;
    }
    if (grid < 0) return;
    (void)hipMemsetAsync(d_ws, 0, CTL_ZERO, stream);
    Args a{};
    a.x_prompt = (const float*)d_in[0]; a.x_sample = (const float*)d_in[1]; a.g_mix = (const float*)d_in[2]; a.w_in = (const float*)d_in[3]; a.lb_param = (const float*)d_in[4];
    a.g_onorm = (const float*)d_in[5]; a.g_qa = (const float*)d_in[6]; a.w_uq = (const float*)d_in[7]; a.g_kva = (const float*)d_in[8]; a.w_ukv = (const float*)d_in[9];
    a.w_branch = (const float*)d_in[10]; a.w_out = (const float*)d_in[11]; a.g_ffn = (const float*)d_in[12]; a.w_gate_up = (const float*)d_in[13]; a.w_down = (const float*)d_in[14]; a.g_final = (const float*)d_in[15];
    a.out = (float*)d_out; a.ws = (unsigned char*)d_ws;
    for (int i = 0; i < 16; ++i) a.inv_rev[i] = pow(10000.0, -(double)i / 16.0) / 6.283185307179586476925;
    a.ph_lo = 0; a.ph_hi = 10;
    void* args[] = {&a};
    const hipError_t e = hipLaunchCooperativeKernel((const void*)fwd_megakernel, dim3(grid), dim3(512), args, LDS_BYTES, stream);
    if (e != hipSuccess) fprintf(stderr, "kernel_launch: cooperative launch failed: %s (grid %d)\n", hipGetErrorString(e), grid);
}
```

```cpp
#include <hip/hip_runtime.h>
#include <hip/hip_cooperative_groups.h>
#include <hip/hip_bf16.h>
#include <cstdio>
#include <cstdint>
#include <cmath>
namespace cg = cooperative_groups;

#define LAS __attribute__((address_space(3)))
typedef unsigned short bf16_t;
typedef short bf16x8 __attribute__((ext_vector_type(8)));
typedef short s16x4 __attribute__((ext_vector_type(4)));
typedef float f32x4 __attribute__((ext_vector_type(4)));
typedef float f32x2 __attribute__((ext_vector_type(2)));
typedef float f32x16 __attribute__((ext_vector_type(16)));
typedef unsigned u32x4 __attribute__((ext_vector_type(4)));
typedef unsigned u32x2 __attribute__((ext_vector_type(2)));
typedef __bf16 bf16x2_t __attribute__((ext_vector_type(2)));
typedef _Float16 h16x8 __attribute__((ext_vector_type(8)));

constexpr int M = 65536, DM = 1024, T0 = 32768;
constexpr int NIN = 5376;
constexpr int DFF = 2816;
constexpr float EPS = 1e-6f;
constexpr float QSCALE = 0.10206207261596575f * 1.4426950408889634f;
constexpr size_t MiB = 1u << 20;
constexpr size_t WS_XBAR = 32768;
constexpr size_t WS_QUEUE = 0, WS_BAR = 4096, WS_TS = 8192, WS_KMAX = 16384;
#ifndef PROBE_SEL
#define PROBE_SEL 0
#endif
constexpr size_t WS_RSQ = 1 * MiB, WS_RSKV = WS_RSQ + 262144, WS_RSX1 = WS_RSKV + 262144, WS_RSX2 = WS_RSX1 + 262144;
constexpr size_t CTL_ZERO = 2 * MiB;
constexpr size_t WS_ROPE = 2 * MiB;
constexpr size_t WS_WIN = 4 * MiB, WS_WUQ = 15 * MiB, WS_WUKV = 15 * MiB + 512 * 1024, WS_WB0 = 16 * MiB, WS_WB1 = 17 * MiB, WS_WO = 18 * MiB, WS_WGU = 20 * MiB, WS_WD = 31 * MiB;
constexpr size_t WS_XN = 40 * MiB, WS_OFW = 40 * MiB, WS_OBW = 104 * MiB, WS_X1B = 40 * MiB;
constexpr size_t WS_HQ = 168 * MiB, WS_HI = 232 * MiB, WS_GF = 296 * MiB, WS_GB = 360 * MiB, WS_SG = 424 * MiB, WS_LAT = 488 * MiB;
constexpr size_t WS_Q = 552 * MiB, WS_K = 648 * MiB, WS_V = 744 * MiB, WS_OM = 808 * MiB;
constexpr size_t WS_OH = 168 * MiB, WS_MERGED = 232 * MiB, WS_X1 = 552 * MiB, WS_ACT = 168 * MiB;
constexpr size_t WS_END = 872 * MiB;
constexpr int LDS_BYTES = 155648;
constexpr int LDS_CTL = 155648 - 256;

__device__ __forceinline__ unsigned cvtpk(float lo, float hi) { f32x2 v = {lo, hi}; bf16x2_t b = __builtin_convertvector(v, bf16x2_t); return __builtin_bit_cast(unsigned, b); }
__device__ __forceinline__ float bf2f(unsigned short u) { return __builtin_bit_cast(float, (unsigned)u << 16); }
__device__ __forceinline__ float bflo(unsigned u) { return __builtin_bit_cast(float, u << 16); }
__device__ __forceinline__ float bfhi(unsigned u) { return __builtin_bit_cast(float, u & 0xffff0000u); }
__device__ __forceinline__ float sigmoidf_(float x) { return __builtin_amdgcn_rcpf(1.f + __expf(-x)); }
__device__ __forceinline__ float siluf_(float x) { return x * sigmoidf_(x); }
__device__ __forceinline__ u32x4 pack8(const float* v) { u32x4 w; w.x = cvtpk(v[0], v[1]); w.y = cvtpk(v[2], v[3]); w.z = cvtpk(v[4], v[5]); w.w = cvtpk(v[6], v[7]); return w; }
__device__ __forceinline__ int crow(int r, int hi) { return (r & 3) + 8 * (r >> 2) + 4 * hi; }
__device__ __forceinline__ const float* xrow_ptr(const float* xp, const float* xs, int row) { return row < T0 ? xp + (size_t)row * DM : xs + (size_t)(row - T0) * DM; }
__device__ __forceinline__ int row_seq(int row) { return row < T0 ? (row >> 13) : 4 + ((row - T0) >> 14); }
__device__ __forceinline__ int row_pos(int row) { return row < T0 ? (row & 8191) : (row & 16383); }
#define SBAR() __builtin_amdgcn_sched_barrier(0)
__device__ __forceinline__ int lane_id() { int l; asm volatile("v_mbcnt_lo_u32_b32 %0, -1, 0\n\tv_mbcnt_hi_u32_b32 %0, -1, %0" : "=v"(l)); return l; }

namespace pg8 {
constexpr int BM = 256, BK = 64, HALF = 128, HTB = HALF * BK * 2, STAGE_BYTES = 8 * HTB, NXCD = 8, WGM = 8;
__device__ __forceinline__ int lds_byte(int r, int c) { const int st = (r >> 4) * 2 + (c >> 5), rr = r & 15, cc = c & 31, ob = rr * 64 + cc * 2; return st * 1024 + (ob ^ (((ob >> 9) & 1) << 5)); }
__device__ __forceinline__ void stage_rc(int b, int& R, int& C) { const int st = b / 1024, sb = b % 1024, swz = sb ^ (((sb >> 9) & 1) << 5); R = (st >> 1) * 16 + swz / 64; C = (st & 1) * 32 + (swz % 64) / 2; }
__device__ __forceinline__ int perm32(int rho) { const int n = rho >> 4, i = rho & 15; return 8 * (i >> 2) + 4 * n + (i & 3); }
struct Unit { int pm, pn, tag; const char* a; const char* b; };
__device__ __forceinline__ void tile_of(int L, int nM, int nN, int& pm, int& pn) {
    const int nwg = nM * nN; int wgid = L;
    { const int q = nwg / NXCD, r = nwg % NXCD, xcd = wgid % NXCD, off = wgid / NXCD; wgid = (xcd < r ? xcd * (q + 1) : r * (q + 1) + (xcd - r) * q) + off; }
    const int nig = WGM * nN, gid = wgid / nig, fm = gid * WGM, gsz = (nM - fm) < WGM ? (nM - fm) : WGM;
    pm = fm + ((wgid % nig) % gsz); pn = (wgid % nig) / gsz;
}
template <class Epi, class Sched>
__device__ __forceinline__ void gemm_phase(const int wv, LAS unsigned char* lds, const int K, const int lda, const Sched& S, const Epi& E) {
    const int lane = lane_id(), wid = wv, tid = wv * 64 + lane, wr = wid >> 2, wc = wid & 3, fr = lane & 15, fq = lane >> 4;
    const int nt = K / BK;
    unsigned voffA[2], voffB[2];
#pragma unroll
    for (int i = 0; i < 2; ++i) { int R, C; stage_rc(tid * 16 + i * 8192, R, C); const int Rb = (R & ~31) + perm32(R & 31);
        voffA[i] = (unsigned)(R * lda + C) * 2u; voffB[i] = (unsigned)(Rb * K + C) * 2u; }
    const size_t kstep = (size_t)(BK * 2);
    const size_t hA = (size_t)HALF * lda * 2, hB = (size_t)HALF * K * 2;
    const unsigned ldsw = (unsigned)wid * 1024u;
    const int aoff = lds_byte(wr * 64 + fr, fq * 8), boff = lds_byte(wc * 32 + fr, fq * 8);
#define PG8_SA(b, h) (((b) * 2 + (h)) * HTB)
#define PG8_SB(b, h) ((4 + (b) * 2 + (h)) * HTB)
#define PG8_STAGE(bufoff, gbase, voff) do { _Pragma("unroll") for (int _i = 0; _i < 2; ++_i) \
        __builtin_amdgcn_global_load_lds((const unsigned*)((const char*)(gbase) + (voff)[_i]), (LAS unsigned*)(lds + (bufoff) + ldsw + _i * 8192), 16, 0, 0); } while (0)
#define PG8_LDA(dst, b, h) do { _Pragma("unroll") for (int m = 0; m < 4; ++m) _Pragma("unroll") for (int k = 0; k < 2; ++k) dst[m][k] = *(const LAS bf16x8*)(lds + PG8_SA(b, h) + aoff + m * 2048 + k * 1024); } while (0)
#define PG8_LDB(dst, b, h) do { _Pragma("unroll") for (int n = 0; n < 2; ++n) _Pragma("unroll") for (int k = 0; k < 2; ++k) dst[n][k] = *(const LAS bf16x8*)(lds + PG8_SB(b, h) + boff + n * 2048 + k * 1024); } while (0)
#define PG8_MMA(ai, bj, At, Bt) do { __builtin_amdgcn_s_setprio(1); _Pragma("unroll") for (int m = 0; m < 4; ++m) _Pragma("unroll") for (int n = 0; n < 2; ++n) _Pragma("unroll") for (int k = 0; k < 2; ++k) \
        acc[ai][bj][m][n] = __builtin_amdgcn_mfma_f32_16x16x32_bf16(Bt[n][k], At[m][k], acc[ai][bj][m][n], 0, 0, 0); __builtin_amdgcn_s_setprio(0); } while (0)
#define PG8_WAIT_V(n) asm volatile("s_waitcnt vmcnt(" #n ")" ::: "memory")
#define PG8_WAIT_L(n) asm volatile("s_waitcnt lgkmcnt(" #n ")" ::: "memory")
#define PG8_BAR __builtin_amdgcn_s_barrier()
#define PG8_SCHED __builtin_amdgcn_sched_barrier(0)
    Unit cur, nxt; int ui = 0;
    if (!S.next(0, cur)) return;
    f32x4 acc[2][2][4][2];
#pragma unroll
    for (int a = 0; a < 2; ++a)
#pragma unroll
        for (int b = 0; b < 2; ++b)
#pragma unroll
            for (int m = 0; m < 4; ++m)
#pragma unroll
                for (int n = 0; n < 2; ++n) acc[a][b][m][n] = (f32x4){0.f, 0.f, 0.f, 0.f};
    bf16x8 At[4][2], B0[2][2], B1[2][2];
    const char* cA = cur.a; const char* cB = cur.b;
    PG8_STAGE(PG8_SB(0, 0), cB, voffB); PG8_STAGE(PG8_SB(0, 1), cB + hB, voffB); PG8_STAGE(PG8_SA(0, 0), cA, voffA); PG8_STAGE(PG8_SA(0, 1), cA + hA, voffA);
    if (wr == 1) PG8_BAR;
    PG8_WAIT_V(2); PG8_BAR;
    PG8_STAGE(PG8_SB(1, 0), cB + kstep, voffB); PG8_STAGE(PG8_SA(1, 0), cA + kstep, voffA); PG8_STAGE(PG8_SB(1, 1), cB + hB + kstep, voffB);
    PG8_WAIT_V(6); PG8_BAR;
    for (;;) {
        const bool has_next = S.next(ui + 1, nxt);
        const char* nA = has_next ? nxt.a : cA; const char* nB = has_next ? nxt.b : cB;
        for (int t = 0; t < nt; t += 2) {
            const bool last = (t == nt - 2);
            const char* a1 = cA + (size_t)(t + 1) * kstep;
            const char* a2 = last ? nA : cA + (size_t)(t + 2) * kstep; const char* b2 = last ? nB : cB + (size_t)(t + 2) * kstep;
            const char* a3 = a2 + kstep; const char* b3 = b2 + kstep;
            PG8_LDB(B0, 0, 0); PG8_LDB(B1, 0, 1); PG8_SCHED; PG8_LDA(At, 0, 0); PG8_STAGE(PG8_SA(1, 1), a1 + hA, voffA);
            PG8_WAIT_V(8); PG8_WAIT_L(0); PG8_BAR; PG8_MMA(0, 0, At, B0); PG8_MMA(0, 1, At, B1); PG8_BAR; PG8_SCHED;
            PG8_LDA(At, 0, 1); PG8_STAGE(PG8_SB(0, 0), b2, voffB); PG8_STAGE(PG8_SB(0, 1), b2 + hB, voffB); PG8_STAGE(PG8_SA(0, 0), a2, voffA);
            PG8_WAIT_V(8); PG8_WAIT_L(0); PG8_BAR; PG8_MMA(1, 0, At, B0); PG8_MMA(1, 1, At, B1); PG8_BAR; PG8_SCHED;
            PG8_LDB(B0, 1, 0); PG8_LDB(B1, 1, 1); PG8_SCHED; PG8_LDA(At, 1, 0); PG8_STAGE(PG8_SA(0, 1), a2 + hA, voffA);
            PG8_WAIT_V(8); PG8_WAIT_L(0); PG8_BAR; PG8_MMA(0, 0, At, B0); PG8_MMA(0, 1, At, B1); PG8_BAR; PG8_SCHED;
            PG8_LDA(At, 1, 1); PG8_STAGE(PG8_SB(1, 0), b3, voffB); PG8_STAGE(PG8_SB(1, 1), b3 + hB, voffB); PG8_STAGE(PG8_SA(1, 0), a3, voffA);
            PG8_WAIT_V(8); PG8_WAIT_L(0); PG8_BAR; PG8_MMA(1, 0, At, B0); PG8_MMA(1, 1, At, B1); PG8_BAR; PG8_SCHED;
        }
        if (wr == 0) PG8_BAR;
        const int l2_ = lane_id(); const int fr_ = l2_ & 15, fq_ = l2_ >> 4;
        const bool keep = E(acc, cur, wr, wc, fr_, fq_);
        if (!has_next) break;
        if (!keep) {
#pragma unroll
        for (int a = 0; a < 2; ++a)
#pragma unroll
            for (int b = 0; b < 2; ++b)
#pragma unroll
                for (int m = 0; m < 4; ++m)
#pragma unroll
                    for (int n = 0; n < 2; ++n) acc[a][b][m][n] = (f32x4){0.f, 0.f, 0.f, 0.f};
        }
        cur = nxt; cA = nA; cB = nB; ++ui;
        if (wr == 1) PG8_BAR;
    }
    PG8_WAIT_V(0);
    PG8_BAR;
#undef PG8_SA
#undef PG8_SB
#undef PG8_STAGE
#undef PG8_LDA
#undef PG8_LDB
#undef PG8_MMA
#undef PG8_WAIT_V
#undef PG8_WAIT_L
#undef PG8_BAR
#undef PG8_SCHED
}
}
using pg8::Unit;
typedef f32x4 Acc[2][2][4][2];
#define EPI_ROWS(ai, m, row) _Pragma("unroll") for (int ai = 0; ai < 2; ++ai) _Pragma("unroll") for (int m = 0; m < 4; ++m) { const int row = u.pm * 256 + ai * 128 + wr * 64 + m * 16 + fr;
#define EPI_END asm volatile("" ::: "memory"); }
__device__ __forceinline__ void get8(const Acc& acc, int ai, int bj, int m, float* v) {
    const f32x4 a = acc[ai][bj][m][0], b = acc[ai][bj][m][1]; v[0] = a[0]; v[1] = a[1]; v[2] = a[2]; v[3] = a[3]; v[4] = b[0]; v[5] = b[1]; v[6] = b[2]; v[7] = b[3]; }

struct Args {
    const float *x_prompt, *x_sample, *g_mix, *w_in, *lb_param, *g_onorm, *g_qa, *w_uq, *g_kva, *w_ukv, *w_branch, *w_out, *g_ffn, *w_gate_up, *w_down, *g_final;
    float* out; unsigned char* ws;
    double inv_rev[16];
    int ph_lo, ph_hi;
};

struct SchedSimple {
    const char* A; const char* B; int nM, nN, G, c; size_t tA, tB;
    __device__ __forceinline__ bool next(int i, Unit& u) const { const long L = (long)i * G + c; if (L >= (long)nM * nN) return false; pg8::tile_of((int)L, nM, nN, u.pm, u.pn); u.tag = 0; u.a = A + u.pm * tA; u.b = B + u.pn * tB; return true; }
};
struct SchedUp {
    const char* LAT; const char* Wuq; const char* Wukv; int G, c;
    __device__ __forceinline__ bool next(int i, Unit& u) const { const long L = (long)i * G + c; if (L >= 256L * 7) return false; pg8::tile_of((int)L, 256, 7, u.pm, u.pn); u.tag = 0;
        u.a = LAT + (size_t)u.pm * 256 * 512 * 2 + (u.pn >= 3 ? 512 : 0); u.b = u.pn < 3 ? Wuq + (size_t)u.pn * 256 * 256 * 2 : Wukv + (size_t)(u.pn - 3) * 256 * 256 * 2; return true; }
};
struct SchedBranch {
    const char* OH; const char* OMm; const char* W0; const char* W1; int G, c;
    __device__ __forceinline__ bool next(int i, Unit& u) const { const long L = (long)(i >> 1) * G + c; if (L >= 256L * 4) return false; pg8::tile_of((int)L, 256, 4, u.pm, u.pn); u.tag = i & 1;
        u.a = ((i & 1) ? OMm : OH) + (size_t)u.pm * 256 * 512 * 2; u.b = ((i & 1) ? W1 : W0) + (size_t)u.pn * 256 * 512 * 2; return true; }
};

struct SchedPanel {
    const char* A; const char* B; int G, c; size_t tA, tB;
    __device__ __forceinline__ bool next(int i, Unit& u) const { const int p = c + (i >> 2) * G; if (p >= 256) return false; u.pm = p; u.pn = i & 3; u.tag = 0; u.a = A + p * tA; u.b = B + u.pn * tB; return true; }
};
struct EpiIn {
    unsigned char* ws; bf16_t *GATES; const float* lbp;
    __device__ __forceinline__ bool operator()(const Acc& acc, const Unit& u, int wr, int wc, int fr, int fq) const {
        const int pn = u.pn, cb = wc * 32 + 8 * fq;
        if (pn < 4 || (pn >= 8 && pn < 10)) {
            bf16_t* dst = (bf16_t*)(ws + (pn < 2 ? WS_HQ : (pn < 4 ? WS_HI : WS_SG))); const int c0 = (pn & 1) * 256; const bool act = (pn < 2 || pn >= 8);
            EPI_ROWS(ai, m, row)
#pragma unroll
                for (int bj = 0; bj < 2; ++bj) { float v[8]; get8(acc, ai, bj, m, v);
                    if (act) {
#pragma unroll
                        for (int i = 0; i < 8; ++i) v[i] = siluf_(v[i]); }
                    *(u32x4*)(dst + (size_t)row * 512 + c0 + bj * 128 + cb) = pack8(v); }
            EPI_END
        } else if (pn < 8) {
            const int dir = (pn >= 6); _Float16* dst = (_Float16*)(ws + (dir ? WS_GB : WS_GF)); const int c0 = (pn & 1) * 256;
            float lb[2][8];
#pragma unroll
            for (int bj = 0; bj < 2; ++bj)
#pragma unroll
                for (int i = 0; i < 8; ++i) { const int col = c0 + bj * 128 + cb + i; lb[bj][i] = sigmoidf_(lbp[dir * 512 + col] - lbp[1024 + dir * 512 + col]); }
            EPI_ROWS(ai, m, row)
#pragma unroll
                for (int bj = 0; bj < 2; ++bj) { float v[8]; get8(acc, ai, bj, m, v); h16x8 h;
#pragma unroll
                    for (int i = 0; i < 8; ++i) { const float f = lb[bj][i] + (1.f - lb[bj][i]) * sigmoidf_(v[i]); h[i] = (_Float16)__logf(f); }
                    *(u32x4*)(dst + (size_t)row * 512 + c0 + bj * 128 + cb) = __builtin_bit_cast(u32x4, h); }
            EPI_END
        } else if (pn < 12) {
            float* RS = (float*)(ws + (pn == 10 ? WS_RSQ : WS_RSKV)); const int c0 = (pn - 10) * 256; bf16_t* LAT = (bf16_t*)(ws + WS_LAT);
            EPI_ROWS(ai, m, row)
                float ss = 0.f;
#pragma unroll
                for (int bj = 0; bj < 2; ++bj) { float v[8]; get8(acc, ai, bj, m, v);
#pragma unroll
                    for (int i = 0; i < 8; ++i) ss += v[i] * v[i];
                    *(u32x4*)(LAT + (size_t)row * 512 + c0 + bj * 128 + cb) = pack8(v); }
                ss += __shfl_xor(ss, 16); ss += __shfl_xor(ss, 32);
                if (fq == 0) atomicAdd(RS + row, ss);
            EPI_END
        } else if (pn < 20) {
            const int c0 = (pn - 12) * 256;
            EPI_ROWS(ai, m, row)
#pragma unroll
                for (int bj = 0; bj < 2; ++bj) { float v[8]; get8(acc, ai, bj, m, v);
#pragma unroll
                    for (int i = 0; i < 8; ++i) v[i] = sigmoidf_(v[i]);
                    *(u32x4*)(GATES + (size_t)row * 2048 + c0 + bj * 128 + cb) = pack8(v); }
            EPI_END
        } else {
            bf16_t* Kc = (bf16_t*)(ws + WS_K); const f32x2* rope = (const f32x2*)(ws + WS_ROPE); float kmx = 0.f;
            EPI_ROWS(ai, m, row)
                float v[8], p[8]; get8(acc, ai, 0, m, v);
                { float ss = 0.f;
#pragma unroll
                  for (int i = 0; i < 8; ++i) ss += v[i] * v[i];
                  ss += __shfl_xor(ss, 16); ss += __shfl_xor(ss, 32); kmx = fmaxf(kmx, ss); }
#pragma unroll
                for (int i = 0; i < 8; ++i) p[i] = __shfl_xor(v[i], 32);
                if (wc == 0) {
                    const int pos = row_pos(row); const f32x2* cs = rope + pos * 16 + 8 * (fq & 1); float o[8];
#pragma unroll
                    for (int i = 0; i < 8; ++i) { const f32x2 c = cs[i]; o[i] = (fq < 2) ? (v[i] * c.x - p[i] * c.y) : (v[i] * c.x + p[i] * c.y); }
                    const u32x4 w = pack8(o);
#pragma unroll
                    for (int h = 0; h < 8; ++h) *(u32x4*)(Kc + ((size_t)row * 8 + h) * 96 + 64 + 8 * fq) = w;
                }
            EPI_END
            if (wc == 0) { kmx = fmaxf(kmx, __shfl_xor(kmx, 1)); kmx = fmaxf(kmx, __shfl_xor(kmx, 2)); kmx = fmaxf(kmx, __shfl_xor(kmx, 4)); kmx = fmaxf(kmx, __shfl_xor(kmx, 8));
                if (fr == 0 && fq == 0) { unsigned* KM = (unsigned*)(ws + WS_KMAX) + row_seq(u.pm * 256) * 32;
#pragma unroll
                    for (int h = 0; h < 8; ++h) atomicMax(KM + h * 4 + 2, __float_as_uint(kmx)); } }
        }
        return false;
    }
};
struct EpiUp {
    bf16_t *Q, *Kc, *V; const float *RSQ, *RSKV; const f32x2* rope; unsigned* KMAX;
    __device__ __forceinline__ bool operator()(const Acc& acc, const Unit& u, int wr, int wc, int fr, int fq) const {
        const int pn = u.pn, cb = wc * 32 + 8 * fq;
#define LOAD_RSV(RSp) float rsv[2][4]; { int rb_ = u.pm * 256 + wr * 64 + fr; asm volatile("" : "+v"(rb_)); const float* rp_ = (RSp) + rb_; _Pragma("unroll") for (int ai = 0; ai < 2; ++ai) _Pragma("unroll") for (int m = 0; m < 4; ++m) rsv[ai][m] = rp_[ai * 128 + m * 16]; }
        if (pn < 2) { LOAD_RSV(RSQ)
            EPI_ROWS(ai, m, row)
                const float sc = __builtin_amdgcn_rsqf(rsv[ai][m] * (1.f / 256.f) + EPS) * QSCALE;
#pragma unroll
                for (int bj = 0; bj < 2; ++bj) { float v[8]; get8(acc, ai, bj, m, v);
#pragma unroll
                    for (int i = 0; i < 8; ++i) v[i] *= sc;
                    const int cg_ = pn * 256 + bj * 128 + cb, h = cg_ >> 6, d = cg_ & 63;
                    *(u32x4*)(Q + ((size_t)row * 8 + h) * 96 + d) = pack8(v); }
            EPI_END
        } else if (pn == 2) {
            EPI_ROWS(ai, m, row)
                const float sc = __builtin_amdgcn_rsqf(RSQ[row] * (1.f / 256.f) + EPS) * QSCALE;
                const int pos = row_pos(row); const f32x2* cs = rope + pos * 16 + 8 * (fq & 1);
#pragma unroll
                for (int bj = 0; bj < 2; ++bj) { float v[8], p[8], o[8]; get8(acc, ai, bj, m, v);
#pragma unroll
                    for (int i = 0; i < 8; ++i) p[i] = __shfl_xor(v[i], 32);
#pragma unroll
                    for (int i = 0; i < 8; ++i) { const f32x2 c = cs[i]; o[i] = ((fq < 2) ? (v[i] * c.x - p[i] * c.y) : (v[i] * c.x + p[i] * c.y)) * sc; }
                    const int h = bj * 4 + wc;
                    *(u32x4*)(Q + ((size_t)row * 8 + h) * 96 + 64 + 8 * fq) = pack8(o); asm volatile("" ::: "memory"); }
            EPI_END
        } else {
            float kmx[2] = {0.f, 0.f}; LOAD_RSV(RSKV)
            EPI_ROWS(ai, m, row)
                const float sc = __builtin_amdgcn_rsqf(rsv[ai][m] * (1.f / 256.f) + EPS);
#pragma unroll
                for (int bj = 0; bj < 2; ++bj) { float v[8]; get8(acc, ai, bj, m, v);
#pragma unroll
                    for (int i = 0; i < 8; ++i) v[i] *= sc;
                    const int cg_ = (pn - 3) * 256 + bj * 128 + cb, h = cg_ >> 7, d = cg_ & 127;
                    if (d < 64) { *(u32x4*)(Kc + ((size_t)row * 8 + h) * 96 + d) = pack8(v); float ss = 0.f;
#pragma unroll
                        for (int i = 0; i < 8; ++i) ss += v[i] * v[i];
                        ss += __shfl_xor(ss, 16); ss += __shfl_xor(ss, 32); kmx[bj] = fmaxf(kmx[bj], ss); }
                    else *(u32x4*)(V + ((size_t)row * 8 + h) * 64 + (d - 64)) = pack8(v); }
            EPI_END
            if (wc < 2) {
#pragma unroll
                for (int bj = 0; bj < 2; ++bj) { float k = kmx[bj]; k = fmaxf(k, __shfl_xor(k, 1)); k = fmaxf(k, __shfl_xor(k, 2)); k = fmaxf(k, __shfl_xor(k, 4)); k = fmaxf(k, __shfl_xor(k, 8));
                    if (fr == 0 && fq == 0) atomicMax(KMAX + row_seq(u.pm * 256) * 32 + ((pn - 3) * 2 + bj) * 4 + wc, __float_as_uint(k)); } }
        }
        return false;
    }
};
struct EpiBranch {
    const bf16_t* GATES; bf16_t* MERGED;
    __device__ __forceinline__ bool operator()(Acc& acc, const Unit& u, int wr, int wc, int fr, int fq) const {
        const int cb = wc * 32 + 8 * fq;
#pragma unroll
        for (int ai = 0; ai < 2; ++ai) {
            u32x4 g1v[4][2], g0v[4][2];
#pragma unroll
            for (int m = 0; m < 4; ++m)
#pragma unroll
                for (int bj = 0; bj < 2; ++bj) { const int row = u.pm * 256 + ai * 128 + wr * 64 + m * 16 + fr, col = u.pn * 256 + bj * 128 + cb;
                    g1v[m][bj] = *(const u32x4*)(GATES + (size_t)row * 2048 + 1024 + col); if (u.tag == 0) g0v[m][bj] = *(const u32x4*)(GATES + (size_t)row * 2048 + col); }
#pragma unroll
            for (int m = 0; m < 4; ++m)
#pragma unroll
                for (int bj = 0; bj < 2; ++bj) { const int row = u.pm * 256 + ai * 128 + wr * 64 + m * 16 + fr, col = u.pn * 256 + bj * 128 + cb;
                    const u32x4 g1 = g1v[m][bj]; float g1f[8] = {bflo(g1.x), bfhi(g1.x), bflo(g1.y), bfhi(g1.y), bflo(g1.z), bfhi(g1.z), bflo(g1.w), bfhi(g1.w)};
                    if (u.tag == 0) {
                        const u32x4 g0 = g0v[m][bj]; float g0f[8] = {bflo(g0.x), bfhi(g0.x), bflo(g0.y), bfhi(g0.y), bflo(g0.z), bfhi(g0.z), bflo(g0.w), bfhi(g0.w)};
#pragma unroll
                        for (int i = 0; i < 4; ++i) { acc[ai][bj][m][0][i] *= g0f[i] * __builtin_amdgcn_rcpf(g1f[i]); acc[ai][bj][m][1][i] *= g0f[4 + i] * __builtin_amdgcn_rcpf(g1f[4 + i]); }
                    } else {
                        float v[8]; get8(acc, ai, bj, m, v);
#pragma unroll
                        for (int i = 0; i < 8; ++i) v[i] *= g1f[i];
                        *(u32x4*)(MERGED + (size_t)row * 1024 + col) = pack8(v);
                    } }
            asm volatile("" ::: "memory");
        }
        return u.tag == 0;
    }
};
struct EpiOut {
    const float *xp, *xs; bf16_t* X1B; float* RS;
    __device__ __forceinline__ bool operator()(const Acc& acc, const Unit& u, int wr, int wc, int fr, int fq) const {
        const int cb = wc * 32 + 8 * fq;
#pragma unroll
        for (int ai = 0; ai < 2; ++ai) {
            f32x4 pre[4][2][2];
#pragma unroll
            for (int m = 0; m < 4; ++m) { const int row = u.pm * 256 + ai * 128 + wr * 64 + m * 16 + fr; const float* xr = xrow_ptr(xp, xs, row);
#pragma unroll
                for (int bj = 0; bj < 2; ++bj) { const int col = u.pn * 256 + bj * 128 + cb; pre[m][bj][0] = *(const f32x4*)(xr + col); pre[m][bj][1] = *(const f32x4*)(xr + col + 4); } }
#pragma unroll
            for (int m = 0; m < 4; ++m) { const int row = u.pm * 256 + ai * 128 + wr * 64 + m * 16 + fr; float ss = 0.f;
#pragma unroll
                for (int bj = 0; bj < 2; ++bj) { const int col = u.pn * 256 + bj * 128 + cb; float v[8]; get8(acc, ai, bj, m, v);
                    const f32x4 x0 = pre[m][bj][0], x1 = pre[m][bj][1];
                    v[0] += x0[0]; v[1] += x0[1]; v[2] += x0[2]; v[3] += x0[3]; v[4] += x1[0]; v[5] += x1[1]; v[6] += x1[2]; v[7] += x1[3];
#pragma unroll
                    for (int i = 0; i < 8; ++i) ss += v[i] * v[i];
                    *(u32x4*)(X1B + (size_t)row * 1024 + col) = pack8(v); }
                ss += __shfl_xor(ss, 16); ss += __shfl_xor(ss, 32);
                if (fq == 0) atomicAdd(RS + row, ss); }
            asm volatile("" ::: "memory");
        }
        return false;
    }
};
struct EpiGU {
    const float* RS; bf16_t* ACT;
    __device__ __forceinline__ bool operator()(const Acc& acc, const Unit& u, int wr, int wc, int fr, int fq) const {
        const int cb = wc * 32 + 8 * fq;
        float rsv[2][4];
        { int rb_ = u.pm * 256 + wr * 64 + fr; asm volatile("" : "+v"(rb_)); const float* rp_ = RS + rb_;
#pragma unroll
        for (int ai = 0; ai < 2; ++ai)
#pragma unroll
            for (int m = 0; m < 4; ++m) rsv[ai][m] = rp_[ai * 128 + m * 16]; }
        EPI_ROWS(ai, m, row)
            const float sc = __builtin_amdgcn_rsqf(rsv[ai][m] * (1.f / 1024.f) + EPS);
            float g[8], p[8]; get8(acc, ai, 0, m, g); get8(acc, ai, 1, m, p);
#pragma unroll
            for (int i = 0; i < 8; ++i) g[i] = siluf_(g[i] * sc) * (p[i] * sc);
            *(u32x4*)(ACT + (size_t)row * DFF + u.pn * 128 + cb) = pack8(g);
        EPI_END
        return false;
    }
};
struct EpiDown {
    const bf16_t* X1B; float* X2; float* RS;
    __device__ __forceinline__ bool operator()(const Acc& acc, const Unit& u, int wr, int wc, int fr, int fq) const {
        const int cb = wc * 32 + 8 * fq;
#pragma unroll
        for (int ai = 0; ai < 2; ++ai) {
            u32x4 pre[4][2];
#pragma unroll
            for (int m = 0; m < 4; ++m) { const int row = u.pm * 256 + ai * 128 + wr * 64 + m * 16 + fr;
#pragma unroll
                for (int bj = 0; bj < 2; ++bj) pre[m][bj] = *(const u32x4*)(X1B + (size_t)row * 1024 + u.pn * 256 + bj * 128 + cb); }
#pragma unroll
            for (int m = 0; m < 4; ++m) { const int row = u.pm * 256 + ai * 128 + wr * 64 + m * 16 + fr; float ss = 0.f;
#pragma unroll
                for (int bj = 0; bj < 2; ++bj) { const int col = u.pn * 256 + bj * 128 + cb; float v[8]; get8(acc, ai, bj, m, v);
                    const u32x4 x = pre[m][bj];
                    v[0] += bflo(x.x); v[1] += bfhi(x.x); v[2] += bflo(x.y); v[3] += bfhi(x.y); v[4] += bflo(x.z); v[5] += bfhi(x.z); v[6] += bflo(x.w); v[7] += bfhi(x.w);
#pragma unroll
                    for (int i = 0; i < 8; ++i) ss += v[i] * v[i];
                    *(f32x4*)(X2 + (size_t)row * 1024 + col) = (f32x4){v[0], v[1], v[2], v[3]}; *(f32x4*)(X2 + (size_t)row * 1024 + col + 4) = (f32x4){v[4], v[5], v[6], v[7]}; }
                ss += __shfl_xor(ss, 16); ss += __shfl_xor(ss, 32);
                if (fq == 0) atomicAdd(RS + row, ss); }
            asm volatile("" ::: "memory");
        }
        return false;
    }
};

namespace att {
constexpr int LDQ = 768, LDK = 768, LDV = 512, LDO = 512, KVBLK = 64, QBLK = 32;
constexpr int SHM_K = 64 * 256, SHM_V = 64 * 64 * 2;
#define KSWZ(row, colB) ((row) * 256 + ((colB) ^ (((row) & 7) << 4)))
__device__ __forceinline__ void expA(f32x16& p0) {
#pragma unroll
    for (int r = 0; r < 16; ++r) p0[r] = __builtin_amdgcn_exp2f(p0[r]);
}
__device__ __forceinline__ void finishSM(f32x16& p0, f32x16& p1, float& l_reg, bf16x8& pa0, bf16x8& pa1, bf16x8& pa2, bf16x8& pa3) {
#pragma unroll
    for (int r = 0; r < 16; ++r) p1[r] = __builtin_amdgcn_exp2f(p1[r]);
    float ps = 0;
#pragma unroll
    for (int r = 0; r < 16; ++r) ps += p0[r];
#pragma unroll
    for (int r = 0; r < 16; ++r) ps += p1[r];
    l_reg += ps;
#define PK4(P, BASE, OUT) do { unsigned a0 = cvtpk(P[BASE + 0], P[BASE + 1]), a1 = cvtpk(P[BASE + 2], P[BASE + 3]);   \
    unsigned b0 = cvtpk(P[BASE + 4], P[BASE + 5]), b1 = cvtpk(P[BASE + 6], P[BASE + 7]);                              \
    auto r0 = __builtin_amdgcn_permlane32_swap(a0, b0, false, false); auto r1 = __builtin_amdgcn_permlane32_swap(a1, b1, false, false); \
    u32x4 w = {r0[0], r1[0], r0[1], r1[1]}; OUT = *reinterpret_cast<bf16x8*>(&w); } while (0)
    PK4(p0, 0, pa0); PK4(p0, 8, pa1); PK4(p1, 0, pa2); PK4(p1, 8, pa3);
#undef PK4
}
__device__ __forceinline__ void qkt(f32x16& p0, f32x16& p1, const char* Ks, const bf16x8* qr, const float mrow, int r32, int hi) {
    p0 = f32x16{}; p1 = f32x16{};
#pragma unroll
    for (int d0 = 0; d0 < 6; ++d0) { const int cb = (d0 * 16 + hi * 8) * 2;
        bf16x8 b0 = *reinterpret_cast<const bf16x8*>(Ks + KSWZ(r32, cb));
        bf16x8 b1 = *reinterpret_cast<const bf16x8*>(Ks + KSWZ(32 + r32, cb));
        p0 = __builtin_amdgcn_mfma_f32_32x32x16_bf16(b0, qr[d0], p0, 0, 0, 0);
        p1 = __builtin_amdgcn_mfma_f32_32x32x16_bf16(b1, qr[d0], p1, 0, 0, 0); }
    if (mrow != 0.f) {
#pragma unroll
        for (int r = 0; r < 16; ++r) { p0[r] -= mrow; p1[r] -= mrow; } }
}
__device__ __forceinline__ int v_st(int k, int c) { const int kk = (k & ~0xC) | ((k & 4) << 1) | ((k & 8) >> 1); return ((kk >> 3) * 2 + (c >> 5)) * 512 + ((kk & 7) * 32 + (c & 31)) * 2; }
__device__ __forceinline__ int v_rd_base(int lane) { return ((lane & 3) << 3) | (((lane >> 2) & 3) << 6) | (((lane >> 4) & 1) << 5) | (((lane >> 5) & 1) << 8); }
constexpr int v_rd_off(int d0, int ks, int half) { return d0 * 512 + ks * 2048 + half * 1024; }
template <int OFF> __device__ __forceinline__ s16x4 tr_read(int vb) { s16x4 r; asm volatile("ds_read_b64_tr_b16 %0, %1 offset:%2" : "=&v"(r) : "v"(vb), "i"(OFF) : "memory"); return r; }
template <int D0> __device__ __forceinline__ void pv_one(f32x16& od, int vb, bf16x8 pa0, bf16x8 pa1, bf16x8 pa2, bf16x8 pa3) {
    const s16x4 l0 = tr_read<v_rd_off(D0, 0, 0)>(vb), h0 = tr_read<v_rd_off(D0, 0, 1)>(vb), l1 = tr_read<v_rd_off(D0, 1, 0)>(vb), h1 = tr_read<v_rd_off(D0, 1, 1)>(vb);
    const s16x4 l2 = tr_read<v_rd_off(D0, 2, 0)>(vb), h2 = tr_read<v_rd_off(D0, 2, 1)>(vb), l3 = tr_read<v_rd_off(D0, 3, 0)>(vb), h3 = tr_read<v_rd_off(D0, 3, 1)>(vb);
    asm volatile("s_waitcnt lgkmcnt(0)" ::: "memory"); SBAR();
#define PK(L, H) (bf16x8){L[0], L[1], L[2], L[3], H[0], H[1], H[2], H[3]}
    od = __builtin_amdgcn_mfma_f32_32x32x16_bf16(pa0, PK(l0, h0), od, 0, 0, 0);
    od = __builtin_amdgcn_mfma_f32_32x32x16_bf16(pa1, PK(l1, h1), od, 0, 0, 0);
    od = __builtin_amdgcn_mfma_f32_32x32x16_bf16(pa2, PK(l2, h2), od, 0, 0, 0);
    od = __builtin_amdgcn_mfma_f32_32x32x16_bf16(pa3, PK(l3, h3), od, 0, 0, 0);
#undef PK
}
__device__ __forceinline__ void pv_d0(f32x16* o, int vb, bf16x8 pa0, bf16x8 pa1, bf16x8 pa2, bf16x8 pa3) { pv_one<0>(o[0], vb, pa0, pa1, pa2, pa3); pv_one<1>(o[1], vb, pa0, pa1, pa2, pa3); }

__device__ __forceinline__ void attn_unit(const bf16_t* __restrict__ Qb, const bf16_t* __restrict__ Kh, const bf16_t* __restrict__ Vh, bf16_t* __restrict__ Ob, int seq, float kmax, char* lds, const int wv) {
    const int lane = lane_id(), wid = wv, tid = wv * 64 + lane, r32 = lane & 31, hi = lane >> 5;
    char* V_lds = lds; char* K_lds = lds + 2 * SHM_V;
    float* li_l = (float*)(lds + 2 * SHM_V + 2 * SHM_K) + wid * 64;
    float l_reg = 0; f32x16 o[2] = {}; bf16x8 qr[6];
    const bf16_t* Qw = Qb + (long)(wid * QBLK + r32) * LDQ + hi * 8;
    float qss = 0.f;
#pragma unroll
    for (int d0 = 0; d0 < 6; ++d0) { qr[d0] = *reinterpret_cast<const bf16x8*>(Qw + d0 * 16);
#pragma unroll
        for (int i = 0; i < 8; ++i) { const float f = bf2f((unsigned short)qr[d0][i]); qss += f * f; } }
    { auto rr = __builtin_amdgcn_permlane32_swap(__float_as_uint(qss), __float_as_uint(qss), false, false); qss = __uint_as_float(rr[0]) + __uint_as_float(rr[1]); }
    float mrow = sqrtf(qss) * kmax;
    if (__all(mrow < 64.f)) mrow = 0.f;
    const int kc1 = tid, kc2 = 512 + (tid & 255); const int kr1 = kc1 / 12, kp1 = kc1 % 12, kr2 = kc2 / 12, kp2 = kc2 % 12; const int vr = tid >> 3, vp = tid & 7;
    const int kst1 = KSWZ(kr1, kp1 * 16), kst2 = KSWZ(kr2, kp2 * 16), vst = v_st(vr, vp * 8);
    const int vb0 = (int)(uintptr_t)V_lds + v_rd_base(lane);
    struct { bf16x8 k1, k2, v; } sr_[2];
#define SLOAD(i, k0) do { sr_[i].k1 = *reinterpret_cast<const bf16x8*>(&Kh[(long)((k0) + kr1) * LDK + kp1 * 8]); if (wv < 4) sr_[i].k2 = *reinterpret_cast<const bf16x8*>(&Kh[(long)((k0) + kr2) * LDK + kp2 * 8]); \
    sr_[i].v = *reinterpret_cast<const bf16x8*>(&Vh[(long)((k0) + vr) * LDV + vp * 8]); } while (0)
#define SWRITE(b, i) do { *(bf16x8*)(K_lds + (b) * SHM_K + kst1) = sr_[i].k1; if (wv < 4) *(bf16x8*)(K_lds + (b) * SHM_K + kst2) = sr_[i].k2; *(bf16x8*)(V_lds + (b) * SHM_V + vst) = sr_[i].v; } while (0)
#define SWAIT() do { if (wv < 4) asm volatile("s_waitcnt vmcnt(3)" ::: "memory"); else asm volatile("s_waitcnt vmcnt(2)" ::: "memory"); } while (0)
    f32x16 pA0, pA1, pB0, pB1; bf16x8 pa0, pa1, pa2, pa3; const int NT = seq / KVBLK;
    constexpr int SE = 0, SO = 1;
    SLOAD(SE, 0); asm volatile("s_waitcnt vmcnt(0)" ::: "memory"); SWRITE(0, SE); __syncthreads();
    qkt(pA0, pA1, K_lds, qr, mrow, r32, hi); expA(pA0);
    SLOAD(SO, KVBLK); if (2 < NT) SLOAD(SE, 2 * KVBLK);
    SWAIT(); SWRITE(1, SO); __syncthreads();
    for (int j = 1; j + 1 < NT; j += 2) {
        SBAR(); qkt(pB0, pB1, K_lds + SHM_K, qr, mrow, r32, hi);
        finishSM(pA0, pA1, l_reg, pa0, pa1, pa2, pa3); SBAR();
        SLOAD(SO, (j + 2) * KVBLK); SBAR();
        pv_d0(o, vb0, pa0, pa1, pa2, pa3); expA(pB0);
        __syncthreads(); SWAIT(); SWRITE(0, SE);
        __syncthreads();
        SBAR(); qkt(pA0, pA1, K_lds, qr, mrow, r32, hi);
        finishSM(pB0, pB1, l_reg, pa0, pa1, pa2, pa3); SBAR();
        if (j + 3 < NT) SLOAD(SE, (j + 3) * KVBLK); SBAR();
        pv_d0(o, vb0 + SHM_V, pa0, pa1, pa2, pa3); expA(pA0);
        __syncthreads(); if (j + 3 < NT) SWAIT(); else asm volatile("s_waitcnt vmcnt(0)" ::: "memory"); SWRITE(1, SO);
        __syncthreads();
    }
    SBAR(); qkt(pB0, pB1, K_lds + SHM_K, qr, mrow, r32, hi);
    finishSM(pA0, pA1, l_reg, pa0, pa1, pa2, pa3); SBAR();
    pv_d0(o, vb0, pa0, pa1, pa2, pa3); expA(pB0);
    __syncthreads();
    finishSM(pB0, pB1, l_reg, pa0, pa1, pa2, pa3); SBAR();
    pv_d0(o, vb0 + SHM_V, pa0, pa1, pa2, pa3);
    { auto rr = __builtin_amdgcn_permlane32_swap(__float_as_uint(l_reg), __float_as_uint(l_reg), false, false); l_reg = __uint_as_float(rr[0]) + __uint_as_float(rr[1]); }
    if (hi == 0) li_l[r32] = l_reg; asm volatile("s_waitcnt lgkmcnt(0)" ::: "memory");
    float rli[16];
#pragma unroll
    for (int r = 0; r < 16; ++r) rli[r] = __builtin_amdgcn_rcpf(li_l[crow(r, hi)]);
    bf16_t* Ow = Ob + (long)(wid * QBLK) * LDO;
#pragma unroll
    for (int r = 0; r < 16; ++r) { const int orow = crow(r, hi);
#pragma unroll
        for (int d0 = 0; d0 < 2; ++d0) Ow[(long)orow * LDO + d0 * 32 + r32] = (bf16_t)(cvtpk(o[d0][r] * rli[r], 0.f) & 0xffffu); }
    __syncthreads();
#undef SLOAD
#undef SWRITE
#undef SWAIT
}
}

namespace hg {
constexpr int QP = 136, TP = 68;
constexpr int OFF_QIN = 0, OFF_KIN = 64 * QP * 2, OFF_KINT = 2 * 64 * QP * 2, OFF_VT = OFF_KINT + 128 * TP * 2, OFF_TOT1 = OFF_VT + 128 * TP * 2, OFF_FAC = OFF_TOT1 + 1024, HALF_BYTES = OFF_FAC + 512;
static_assert(2 * HALF_BYTES <= LDS_CTL, "HGRN LDS");
__device__ __forceinline__ bf16x8 ld2x4(const LAS char* p0, const LAS char* p1) { const s16x4 a = *(const LAS s16x4*)p0, b = *(const LAS s16x4*)p1; return (bf16x8){a[0], a[1], a[2], a[3], b[0], b[1], b[2], b[3]}; }
__device__ __forceinline__ bf16x8 packf8(const f32x16& a, int base) { u32x4 w; w.x = cvtpk(a[base], a[base + 1]); w.y = cvtpk(a[base + 2], a[base + 3]); w.z = cvtpk(a[base + 4], a[base + 5]); w.w = cvtpk(a[base + 6], a[base + 7]); return __builtin_bit_cast(bf16x8, w); }
__device__ __forceinline__ void unit(LAS char* lds, int seqbase, int S, int h, const bf16_t* __restrict__ HQp, const bf16_t* __restrict__ HIp, const _Float16* __restrict__ GFp, const _Float16* __restrict__ GBp, bf16_t* OFWp, bf16_t* OBWp, const int wv) {
    const int lane = lane_id(), tid = wv * 64 + lane, bwd = wv >> 2, ht = tid & 255, w = wv & 3, r32 = lane & 31, hi = lane >> 5;
    LAS char* base = lds + bwd * HALF_BYTES;
    LAS char* QIN = base + OFF_QIN; LAS char* KINT = base + OFF_KINT; LAS char* VT = base + OFF_VT; LAS float* TOT1 = (LAS float*)(base + OFF_TOT1); LAS float* FAC = (LAS float*)(base + OFF_FAC);
    const _Float16* G = bwd ? GBp : GFp; bf16_t* O = bwd ? OBWp : OFWp;
    const int nc = S / 64, part = ht >> 7, d = ht & 127, e0 = 32 * w;
    f32x16 Sacc[4] = {};
    if (part == 1) { TOT1[d] = 0.f; TOT1[128 + d] = 0.f; }
    u32x4 rg[4], rq[4], rv[4];
    const int trb = ht >> 4, c8 = (ht & 15) * 8, tv = (ht >> 2) & 63, ev = (ht & 3) * 8;
    const long jstep = bwd ? -16 * 512 : 16 * 512;
    const size_t gq_off = (size_t)(bwd ? 63 - trb : trb) * 512 + h * 128 + c8, v_off = (size_t)(bwd ? 63 - tv : tv) * 512 + h * 128 + ev;
#define HG_LOADRAW(c) do { const size_t cb_ = (size_t)(seqbase + (bwd ? (nc - 1 - (c)) * 64 : (c) * 64)) * 512 + gq_off; \
    _Pragma("unroll") for (int j = 0; j < 4; ++j) { rg[j] = *(const u32x4*)(G + cb_ + j * jstep); rq[j] = *(const u32x4*)(HQp + cb_ + j * jstep); } } while (0)
#define HG_LOADV(c) do { const size_t cb_ = (size_t)(seqbase + (bwd ? (nc - 1 - (c)) * 64 : (c) * 64)) * 512 + v_off; \
    _Pragma("unroll") for (int j = 0; j < 4; ++j) rv[j] = *(const u32x4*)(HIp + cb_ + 32 * j); } while (0)
    HG_LOADRAW(0); HG_LOADV(0);
    for (int c = 0; c < nc; ++c) {
        const int c0 = seqbase + (bwd ? (nc - 1 - c) * 64 : c * 64);
        LAS char* wq = QIN + (trb * QP + c8) * 2; LAS char* wvt = VT + (ev * TP + tv) * 2; LAS char* colb = QIN + d * 2; LAS char* ktb = KINT + d * TP * 2;
        asm volatile("" : "+v"(wq), "+v"(wvt), "+v"(colb), "+v"(ktb));
#pragma unroll
        for (int j = 0; j < 4; ++j) { *(LAS u32x4*)(wq + j * 16 * QP * 2) = rq[j]; *(LAS u32x4*)(wq + (OFF_KIN - OFF_QIN) + j * 16 * QP * 2) = rg[j]; }
#pragma unroll
        for (int j = 0; j < 4; ++j) { const unsigned vv[4] = {rv[j].x, rv[j].y, rv[j].z, rv[j].w};
#pragma unroll
            for (int i = 0; i < 4; ++i) { *(LAS bf16_t*)(wvt + (32 * j + 2 * i) * TP * 2) = (bf16_t)(vv[i] & 0xffffu); *(LAS bf16_t*)(wvt + (32 * j + 2 * i + 1) * TP * 2) = (bf16_t)(vv[i] >> 16); } }
        __syncthreads();
        if (c + 1 < nc) { HG_LOADRAW(c + 1); HG_LOADV(c + 1); }
        constexpr int KO = OFF_KIN - OFF_QIN;
        if (part == 0) {
            float E1 = 1.f, E2 = 1.f, tot = 0.f;
#pragma unroll 4
            for (int tp = 15; tp >= 0; --tp) { unsigned kpk[2];
#pragma unroll
                for (int s2 = 1; s2 >= 0; --s2) { const int tt = 2 * tp + s2;
                    const float g = (float)*(const LAS _Float16*)(colb + KO + tt * QP * 2), q = bf2f(*(const LAS bf16_t*)(colb + tt * QP * 2));
                    const float f = __expf(g), rf = __expf(-g);
                    const unsigned pq = cvtpk(q * E1, (1.f - f) * E2);
                    *(LAS bf16_t*)(colb + tt * QP * 2) = (bf16_t)(pq & 0xffffu); *(LAS bf16_t*)(colb + KO + tt * QP * 2) = (bf16_t)(pq >> 16); kpk[s2] = pq >> 16;
                    E1 *= rf; E2 *= f; tot += g; }
                *(LAS unsigned*)(ktb + 4 * tp) = kpk[0] | (kpk[1] << 16); }
            FAC[d] = __expf(tot + TOT1[((c + 1) & 1) * 128 + d]);
        } else {
            float E1 = 1.f, E2 = 1.f, tot = 0.f;
#pragma unroll 4
            for (int tp = 16; tp < 32; ++tp) { unsigned kpk[2];
#pragma unroll
                for (int s2 = 0; s2 < 2; ++s2) { const int tt = 2 * tp + s2;
                    const float g = (float)*(const LAS _Float16*)(colb + KO + tt * QP * 2), q = bf2f(*(const LAS bf16_t*)(colb + tt * QP * 2));
                    const float f = __expf(g), rf = __expf(-g);
                    E1 *= f; E2 *= rf; tot += g;
                    const unsigned pq = cvtpk(q * E1, (1.f - f) * E2);
                    *(LAS bf16_t*)(colb + tt * QP * 2) = (bf16_t)(pq & 0xffffu); *(LAS bf16_t*)(colb + KO + tt * QP * 2) = (bf16_t)(pq >> 16); kpk[s2] = pq >> 16; }
                *(LAS unsigned*)(ktb + 4 * tp) = kpk[0] | (kpk[1] << 16); }
            TOT1[(c & 1) * 128 + d] = tot;
        }
        __syncthreads();
        {
            const LAS char* bq16 = QIN + r32 * QP * 2 + 16 * hi; const LAS char* bq8 = QIN + r32 * QP * 2 + 8 * hi;
            const LAS char* bv16 = VT + (e0 + r32) * TP * 2 + 16 * hi; const LAS char* bv8 = VT + (e0 + r32) * TP * 2 + 8 * hi;
            const LAS char* bk16 = KINT + r32 * TP * 2 + 16 * hi; const LAS float* bfac = FAC + 4 * hi; int thr = r32 - 4 * hi;
            asm volatile("" : "+v"(bq16), "+v"(bq8), "+v"(bv16), "+v"(bv8), "+v"(bk16), "+v"(bfac), "+v"(thr));
            constexpr int KOFF = OFF_KIN - OFF_QIN, R32 = 32 * QP * 2;
#pragma unroll
            for (int db = 0; db < 4; ++db)
#pragma unroll
                for (int r4 = 0; r4 < 4; ++r4) { const f32x4 fc = *(const LAS f32x4*)(bfac + 32 * db + 8 * r4); Sacc[db][4 * r4] *= fc.x; Sacc[db][4 * r4 + 1] *= fc.y; Sacc[db][4 * r4 + 2] *= fc.z; Sacc[db][4 * r4 + 3] *= fc.w; }
            f32x16 o0 = {}, o1 = {};
#pragma unroll
            for (int kk = 0; kk < 8; ++kk) { const bf16x8 sf = packf8(Sacc[kk >> 1], 8 * (kk & 1));
                const bf16x8 b0 = ld2x4(bq8 + 32 * kk, bq8 + 32 * kk + 16), b1 = ld2x4(bq8 + R32 + 32 * kk, bq8 + R32 + 32 * kk + 16);
                o0 = __builtin_amdgcn_mfma_f32_32x32x16_bf16(sf, b0, o0, 0, 0, 0);
                o1 = __builtin_amdgcn_mfma_f32_32x32x16_bf16(sf, b1, o1, 0, 0, 0); if (kk & 1) SBAR(); }
            SBAR();
            {
                f32x16 p = {};
#pragma unroll
                for (int kk = 0; kk < 8; ++kk)
                    { p = __builtin_amdgcn_mfma_f32_32x32x16_bf16(*(const LAS bf16x8*)(bq16 + KOFF + 32 * kk), *(const LAS bf16x8*)(bq16 + 32 * kk), p, 0, 0, 0); if ((kk & 3) == 3) SBAR(); }
#pragma unroll
                for (int r = 0; r < 16; ++r) { if ((r & 3) + 8 * (r >> 2) > thr) p[r] = 0.f; }
#pragma unroll
                for (int k2 = 0; k2 < 2; ++k2) o0 = __builtin_amdgcn_mfma_f32_32x32x16_bf16(ld2x4(bv8 + 32 * k2, bv8 + 32 * k2 + 16), packf8(p, 8 * k2), o0, 0, 0, 0);
            }
            SBAR();
            {
                f32x16 p = {};
#pragma unroll
                for (int kk = 0; kk < 8; ++kk)
                    { p = __builtin_amdgcn_mfma_f32_32x32x16_bf16(*(const LAS bf16x8*)(bq16 + KOFF + 32 * kk), *(const LAS bf16x8*)(bq16 + R32 + 32 * kk), p, 0, 0, 0); if ((kk & 3) == 3) SBAR(); }
#pragma unroll
                for (int k2 = 0; k2 < 2; ++k2) o1 = __builtin_amdgcn_mfma_f32_32x32x16_bf16(ld2x4(bv8 + 32 * k2, bv8 + 32 * k2 + 16), packf8(p, 8 * k2), o1, 0, 0, 0);
            }
            SBAR();
            {
                f32x16 p = {};
#pragma unroll
                for (int kk = 0; kk < 8; ++kk)
                    { p = __builtin_amdgcn_mfma_f32_32x32x16_bf16(*(const LAS bf16x8*)(bq16 + KOFF + R32 + 32 * kk), *(const LAS bf16x8*)(bq16 + R32 + 32 * kk), p, 0, 0, 0); if ((kk & 3) == 3) SBAR(); }
#pragma unroll
                for (int r = 0; r < 16; ++r) { if ((r & 3) + 8 * (r >> 2) > thr) p[r] = 0.f; }
#pragma unroll
                for (int k2 = 0; k2 < 2; ++k2) o1 = __builtin_amdgcn_mfma_f32_32x32x16_bf16(ld2x4(bv8 + 64 + 32 * k2, bv8 + 64 + 32 * k2 + 16), packf8(p, 8 * k2), o1, 0, 0, 0);
            }
            SBAR();
#pragma unroll
            for (int kk = 0; kk < 4; ++kk) { const bf16x8 vfr = ld2x4(bv16 + 32 * kk, bv16 + 32 * kk + 8);
#pragma unroll
                for (int db = 0; db < 4; ++db) { const LAS char* kp = bk16 + 32 * db * TP * 2 + 32 * kk; Sacc[db] = __builtin_amdgcn_mfma_f32_32x32x16_bf16(ld2x4(kp, kp + 8), vfr, Sacc[db], 0, 0, 0); } SBAR(); }
            SBAR();
#pragma unroll
            for (int tb = 0; tb < 2; ++tb) { const int tt = 32 * tb + r32, row = c0 + (bwd ? 63 - tt : tt); bf16_t* op = O + (size_t)row * 512 + h * 128 + e0 + 16 * hi;
                const f32x16& oo = tb ? o1 : o0; unsigned dq[4][2];
#pragma unroll
                for (int r4 = 0; r4 < 4; ++r4) { dq[r4][0] = cvtpk(oo[4 * r4], oo[4 * r4 + 1]); dq[r4][1] = cvtpk(oo[4 * r4 + 2], oo[4 * r4 + 3]); }
                const auto s00 = __builtin_amdgcn_permlane32_swap(dq[0][0], dq[2][0], false, false), s01 = __builtin_amdgcn_permlane32_swap(dq[0][1], dq[2][1], false, false);
                const auto s10 = __builtin_amdgcn_permlane32_swap(dq[1][0], dq[3][0], false, false), s11 = __builtin_amdgcn_permlane32_swap(dq[1][1], dq[3][1], false, false);
                *(u32x4*)(op) = (u32x4){s00[0], s01[0], s00[1], s01[1]}; *(u32x4*)(op + 8) = (u32x4){s10[0], s11[0], s10[1], s11[1]}; }
        }
        __syncthreads();
    }
#undef HG_LOADRAW
#undef HG_LOADV
}
}

__device__ __forceinline__ float wave_sum(float v) {
#pragma unroll
    for (int o = 1; o < 64; o <<= 1) v += __shfl_xor(v, o);
    return v;
}
__device__ __forceinline__ void transpose_item(const float* W, int K, int N, int k0, int n0, bf16_t* WT, int dst0, const float* kscale, LAS float* scr, int lane) {
#pragma unroll 8
    for (int i = 0; i < 32; ++i) { const int kk = 2 * i + (lane >> 5); float v = W[(size_t)(k0 + kk) * N + n0 + (lane & 31)]; if (kscale) v *= kscale[k0 + kk]; scr[kk * 33 + (lane & 31)] = v; }
    asm volatile("s_waitcnt lgkmcnt(0)" ::: "memory");
    const int c = lane & 7;
#pragma unroll
    for (int j = 0; j < 4; ++j) { const int n = (lane >> 3) + 8 * j; const LAS float* s = scr + (8 * c) * 33 + n;
        u32x4 o; o.x = cvtpk(s[0 * 33], s[1 * 33]); o.y = cvtpk(s[2 * 33], s[3 * 33]); o.z = cvtpk(s[4 * 33], s[5 * 33]); o.w = cvtpk(s[6 * 33], s[7 * 33]);
        *(u32x4*)(WT + (size_t)(dst0 + n) * K + k0 + 8 * c) = o; }
    asm volatile("s_waitcnt lgkmcnt(0)" ::: "memory");
}

#define XB_TMO      128
#define XB_XCNT(j)  (256  + 64 * (j))
#define XB_XSUB(j)  (1280 + 64 * (j))
#define XB_XGEN(j)  (2304 + 64 * (j))
#define XB_TOP      3328
#define XB_TOPGEN   3392
#define XB_SPIN_CAP (1u << 22)
__device__ __forceinline__ unsigned xb_ld(unsigned* p)              { return __hip_atomic_load(p, __ATOMIC_RELAXED, __HIP_MEMORY_SCOPE_AGENT); }
__device__ __forceinline__ unsigned xb_add(unsigned* p, unsigned v) { return __hip_atomic_fetch_add(p, v, __ATOMIC_RELAXED, __HIP_MEMORY_SCOPE_AGENT); }
__device__ __forceinline__ unsigned xb_xcc_id() { return (unsigned)__builtin_amdgcn_s_getreg((3 << 11) | 20) & 0xFu; }
#define XB_SPIN(cond, bar) do { unsigned _sp = 0; while (cond) { __builtin_amdgcn_s_sleep(1); \
    if ((++_sp & 255u) == 0u) { if (xb_ld(&(bar)[XB_TMO])) break; if (_sp > XB_SPIN_CAP) { atomicAdd(&(bar)[XB_TMO], 1u); break; } } } } while (0)
__device__ __forceinline__ void xcd_barrier_complete(unsigned* bar, unsigned x, unsigned& nloc, unsigned& nx) {
    const unsigned G = gridDim.x;
    unsigned sum, cnt, mine, sp = 0u;
    for (;;) {
        sum = 0u; cnt = 0u; mine = 0u;
#pragma unroll
        for (unsigned j = 0; j < 16; ++j) { const unsigned c = xb_ld(&bar[XB_XCNT(j)]); sum += c; cnt += (c > 0u) ? 1u : 0u; mine = (j == x) ? c : mine; }
        if (sum == G) break;
        __builtin_amdgcn_s_sleep(1);
        if ((++sp & 255u) == 0u) { if (xb_ld(&bar[XB_TMO])) break; if (sp > XB_SPIN_CAP) { atomicAdd(&bar[XB_TMO], 1u); break; } }
    }
    nloc = mine > 0u ? mine : 1u; nx = cnt > 0u ? cnt : 1u;
}
__device__ __forceinline__ void grid_barrier(unsigned* bar, const int wv, volatile LAS unsigned* st) {
    asm volatile("s_waitcnt vmcnt(0)" ::: "memory");
    __syncthreads();
    if (wv == 0 && lane_id() == 0) {
        const unsigned x = xb_xcc_id();
        __builtin_amdgcn_s_waitcnt(0);
        unsigned nloc = st[0], nx = st[1];
        if (nloc == 0u) { xcd_barrier_complete(bar, x, nloc, nx); st[0] = nloc; st[1] = nx; }
        const unsigned old = xb_add(&bar[XB_XSUB(x)], 1u);
        const unsigned gen = old / nloc;
        if (old + 1u == (gen + 1u) * nloc) {
            __builtin_amdgcn_fence(__ATOMIC_RELEASE, "agent");
            asm volatile("s_waitcnt vmcnt(0)" ::: "memory");
            const unsigned og = xb_add(&bar[XB_TOP], 1u);
            const unsigned tg = og / nx;
            if (og + 1u == (tg + 1u) * nx) xb_add(&bar[XB_TOPGEN], 1u);
            else XB_SPIN(xb_ld(&bar[XB_TOPGEN]) == tg, bar);
            __builtin_amdgcn_fence(__ATOMIC_ACQUIRE, "agent");
            xb_add(&bar[XB_XGEN(x)], 1u);
            asm volatile("s_waitcnt vmcnt(0)" ::: "memory");
        } else {
            XB_SPIN(xb_ld(&bar[XB_XGEN(x)]) == gen, bar);
            __builtin_amdgcn_fence(__ATOMIC_ACQUIRE, "agent");
            asm volatile("s_waitcnt vmcnt(0)" ::: "memory");
        }
    }
    __syncthreads();
}
#define WinT ((bf16_t*)(ws + WS_WIN))
#define WuqT ((bf16_t*)(ws + WS_WUQ))
#define WukvT ((bf16_t*)(ws + WS_WUKV))
#define Wb0T ((bf16_t*)(ws + WS_WB0))
#define Wb1T ((bf16_t*)(ws + WS_WB1))
#define WoT ((bf16_t*)(ws + WS_WO))
#define WguT ((bf16_t*)(ws + WS_WGU))
#define WdT ((bf16_t*)(ws + WS_WD))
#define XN ((bf16_t*)(ws + WS_XN))
#define HQ ((bf16_t*)(ws + WS_HQ))
#define HI ((bf16_t*)(ws + WS_HI))
#define GF ((_Float16*)(ws + WS_GF))
#define GB ((_Float16*)(ws + WS_GB))
#define SG ((bf16_t*)(ws + WS_SG))
#define LAT ((bf16_t*)(ws + WS_LAT))
#define Qm ((bf16_t*)(ws + WS_Q))
#define Km ((bf16_t*)(ws + WS_K))
#define Vm ((bf16_t*)(ws + WS_V))
#define OM ((bf16_t*)(ws + WS_OM))
#define OFW ((bf16_t*)(ws + WS_OFW))
#define OBW ((bf16_t*)(ws + WS_OBW))
#define OH ((bf16_t*)(ws + WS_OH))
#define MERGED ((bf16_t*)(ws + WS_MERGED))
#define X1 ((float*)(ws + WS_X1))
#define X1B ((bf16_t*)(ws + WS_X1B))
#define ACT ((bf16_t*)(ws + WS_ACT))
#define GATES ((bf16_t*)a.out)
#define RSQ ((float*)(ws + WS_RSQ))
#define RSKV ((float*)(ws + WS_RSKV))
#define RSX1 ((float*)(ws + WS_RSX1))
#define RSX2 ((float*)(ws + WS_RSX2))
#define ROPE ((f32x2*)(ws + WS_ROPE))
#define QUEUE ((unsigned*)(ws + WS_QUEUE))
__global__ void __launch_bounds__(512, 2) fwd_megakernel(Args a) {
    extern __shared__ __attribute__((aligned(16))) unsigned char lds[];
    const int G = gridDim.x, bx = blockIdx.x;
    const int wv = __builtin_amdgcn_readfirstlane((int)threadIdx.x >> 6);
#define TIDS const int lane = lane_id(), wave = wv, tid = wv * 64 + lane; (void)tid;
    unsigned char* ws = a.ws;
    LAS unsigned char* ldsl = (LAS unsigned char*)lds;
    const int lo = a.ph_lo, hi_ = a.ph_hi;
#ifndef PHMASK
#define PHMASK 0x3ff
#endif
#define IN(k) (((PHMASK >> (k)) & 1) && lo <= (k) && (k) < hi_)
#define STAMP(k) do { if (PROBE_SEL && bx == 0 && wv == 0 && lane_id() == 0) ((unsigned long long*)(ws + WS_TS))[k] = __builtin_amdgcn_s_memrealtime(); } while (0)
#define SEAM(k) do { if (IN(k) && IN((k) + 1)) { if ((k) == 0) cg::this_grid().sync(); else grid_barrier((unsigned*)(ws + WS_XBAR), wv, (volatile LAS unsigned*)(ldsl + LDS_CTL + 32)); } } while (0)

    if (PROBE_SEL && bx == 0 && wv == 0 && lane_id() == 0) { for (int i = 1; i < 32; ++i) ((unsigned long long*)(ws + WS_TS))[i] = 0ull; }
    STAMP(0);
    if (IN(0)) { TIDS
        LAS float* scr = (LAS float*)(ldsl + wave * 16384);
        const int gw = bx * 8 + wave, NGW = G * 8;
        constexpr int I_IN = 16 * 161, I_UQ = 4 * 24, I_UKV = 4 * 32, I_B = 8 * 32, I_O = 16 * 32, I_GU = 16 * 176, I_D = 44 * 32;
        constexpr int NITEMS = I_IN + I_UQ + I_UKV + 2 * I_B + I_O + I_GU + I_D;
        for (int it = gw; it < NITEMS; it += NGW) {
            int r = it;
            if (r < I_IN) { const int kb = r / 161, nb = r % 161; const int dst = nb < 96 ? 32 * nb : (nb == 96 ? 5120 : 3072 + 32 * (nb - 97)); transpose_item(a.w_in, 1024, 5152, 64 * kb, 32 * nb, WinT, dst, nullptr, scr, lane); continue; } r -= I_IN;
            if (r < I_UQ) { const int kb = r / 24, nb = r % 24, h = nb / 3, p = nb % 3; const int dst = p < 2 ? h * 64 + 32 * p : 512 + 32 * h; transpose_item(a.w_uq, 256, 768, 64 * kb, 32 * nb, WuqT, dst, a.g_qa, scr, lane); continue; } r -= I_UQ;
            if (r < I_UKV) { const int kb = r / 32, nb = r % 32; transpose_item(a.w_ukv, 256, 1024, 64 * kb, 32 * nb, WukvT, 32 * nb, a.g_kva, scr, lane); continue; } r -= I_UKV;
            if (r < I_B) { const int kb = r / 32, nb = r % 32; transpose_item(a.w_branch, 512, 1024, 64 * kb, 32 * nb, Wb0T, 32 * nb, nullptr, scr, lane); continue; } r -= I_B;
            if (r < I_B) { const int kb = r / 32, nb = r % 32; transpose_item(a.w_branch + 512 * 1024, 512, 1024, 64 * kb, 32 * nb, Wb1T, 32 * nb, nullptr, scr, lane); continue; } r -= I_B;
            if (r < I_O) { const int kb = r / 32, nb = r % 32; transpose_item(a.w_out, 1024, 1024, 64 * kb, 32 * nb, WoT, 32 * nb, nullptr, scr, lane); continue; } r -= I_O;
            if (r < I_GU) { const int kb = r / 176, nb = r % 176; const int col = 32 * nb; const int j = col < DFF ? col : col - DFF; const int dst = 256 * (j / 128) + (col < DFF ? 0 : 128) + (j % 128);
                transpose_item(a.w_gate_up, 1024, 5632, 64 * kb, col, WguT, dst, a.g_ffn, scr, lane); continue; } r -= I_GU;
            { const int kb = r / 32, nb = r % 32; transpose_item(a.w_down, DFF, 1024, 64 * kb, 32 * nb, WdT, 32 * nb, nullptr, scr, lane); }
        }
        for (int m = gw; m < M; m += NGW) {
            const f32x4* xr = (const f32x4*)xrow_ptr(a.x_prompt, a.x_sample, m) + lane; f32x4 v[4]; float s = 0.f;
#pragma unroll
            for (int j = 0; j < 4; ++j) { v[j] = xr[64 * j]; s += (v[j].x * v[j].x + v[j].y * v[j].y) + (v[j].z * v[j].z + v[j].w * v[j].w); }
            const float rstd = __builtin_amdgcn_rsqf(wave_sum(s) * (1.f / 1024.f) + EPS);
            u32x2* o8 = (u32x2*)(XN + (size_t)m * 1024) + lane;
#pragma unroll
            for (int j = 0; j < 4; ++j) { const f32x4 g = ((const f32x4*)a.g_mix)[64 * j + lane]; u32x2 w; w.x = cvtpk(v[j].x * rstd * g.x, v[j].y * rstd * g.y); w.y = cvtpk(v[j].z * rstd * g.z, v[j].w * rstd * g.w); o8[64 * j] = w; }
        }
        for (int i = bx * 512 + tid; i < (int)(CTL_ZERO / 16); i += G * 512) { if (PROBE_SEL && i >= (int)(WS_TS / 16) && i < (int)(WS_TS / 16) + 16) continue; ((u32x4*)ws)[i] = (u32x4){0u, 0u, 0u, 0u}; }
        for (int i = bx * 512 + tid; i < 16384 * 16; i += G * 512) { const int pos = i >> 4, j = i & 15; const double rev = (double)pos * a.inv_rev[j]; const float fr_ = (float)(rev - floor(rev));
            ROPE[i] = (f32x2){__builtin_amdgcn_cosf(fr_), __builtin_amdgcn_sinf(fr_)}; }
    }
    SEAM(0); STAMP(1);
    {
        volatile LAS unsigned* st = (volatile LAS unsigned*)(ldsl + LDS_CTL + 32);
        if (wv == 0 && lane_id() == 0) { st[0] = 0u; st[1] = 0u; (void)xb_add((unsigned*)(ws + WS_XBAR) + XB_XCNT(xb_xcc_id()), 1u); }
        __syncthreads();
    }
    if (IN(1)) {
        SchedSimple S{(const char*)XN, (const char*)WinT, 256, 21, G, bx, (size_t)256 * 1024 * 2, (size_t)256 * 1024 * 2};
        EpiIn E{ws, GATES, a.lb_param};
        pg8::gemm_phase(wv, ldsl, 1024, 1024, S, E);
    }
    SEAM(1); STAMP(2);
    if (IN(2)) {
        SchedUp S{(const char*)LAT, (const char*)WuqT, (const char*)WukvT, G, bx};
        EpiUp E{Qm, Km, Vm, RSQ, RSKV, ROPE, (unsigned*)(ws + WS_KMAX)};
        pg8::gemm_phase(wv, ldsl, 256, 512, S, E);
    }
    SEAM(2); STAMP(3);
    if (IN(3)) { TIDS
        volatile LAS unsigned* ctl = (volatile LAS unsigned*)(ldsl + LDS_CTL);
        int did_hg = 0;
        for (int qk = 0; qk < 8; ++qk) {
            const int xq = (bx + qk) & 7;
            for (;;) {
                __syncthreads();
                if (tid == 0) ctl[0] = atomicAdd(QUEUE + xq * 64 + 32, 1u);
                __syncthreads();
                const int un = (int)ctl[0];
                if (un >= 3) break;
                int seqbase, S, h;
                if (un == 0) { seqbase = T0 + (xq >> 2) * 16384; S = 16384; h = xq & 3; }
                else { const int idx = 2 * xq + (un - 1); seqbase = (idx >> 2) * 8192; S = 8192; h = idx & 3; }
                hg::unit((LAS char*)ldsl, seqbase, S, h, HQ, HI, GF, GB, OFW, OBW, wv); did_hg = 1;
            }
        }
        if (PROBE_SEL && wv == 0 && lane_id() == 0) atomicMax((unsigned long long*)(ws + WS_TS) + 16, (unsigned long long)__builtin_amdgcn_s_memrealtime());
        for (int qk = 0; qk < 8; ++qk) {
            const int xq = (bx + qk) & 7;
            for (;;) {
                __syncthreads();
                if (tid == 0) ctl[0] = atomicAdd(QUEUE + xq * 64, 1u);
                __syncthreads();
                const int un = (int)ctl[0];
                if (un >= 256) break;
                int seqbase, S, h, qb;
                if (un < 128) { const int j = un, pair = 2 * xq + (j >> 6); seqbase = T0 + (pair >> 3) * 16384; S = 16384; h = pair & 7; qb = j & 63; }
                else { const int j = un - 128, pair = 4 * xq + (j >> 5); seqbase = (pair >> 3) * 8192; S = 8192; h = pair & 7; qb = j & 31; }
                const unsigned* km = (const unsigned*)(ws + WS_KMAX) + row_seq(seqbase) * 32 + h * 4;
                const float kmax = sqrtf(__uint_as_float(km[0]) + __uint_as_float(km[1]) + __uint_as_float(km[2])) * 1.01f;
                att::attn_unit(Qm + ((size_t)(seqbase + qb * 256) * 8 + h) * 96, Km + ((size_t)seqbase * 8 + h) * 96, Vm + ((size_t)seqbase * 8 + h) * 64, OM + (size_t)(seqbase + qb * 256) * 512 + h * 64, S, kmax, (char*)lds, wv);
            }
        }
        if (PROBE_SEL && !did_hg && wv == 0 && lane_id() == 0) atomicMax((unsigned long long*)(ws + WS_TS) + 17, (unsigned long long)__builtin_amdgcn_s_memrealtime());
    }
    SEAM(3); STAMP(4);
    if (IN(4)) { TIDS
        const int gw = bx * 8 + wave, NGW = G * 8;
        for (int m = gw; m < M; m += NGW) {
            const size_t off = (size_t)m * 512 + lane * 8;
            const u32x4 f = *(const u32x4*)(OFW + off), b = *(const u32x4*)(OBW + off), s = *(const u32x4*)(SG + off);
            const unsigned fu[4] = {f.x, f.y, f.z, f.w}, bu[4] = {b.x, b.y, b.z, b.w}, su[4] = {s.x, s.y, s.z, s.w};
            float o[8]; float ss = 0.f;
#pragma unroll
            for (int i = 0; i < 4; ++i) { o[2 * i] = bflo(fu[i]) + bflo(bu[i]); o[2 * i + 1] = bfhi(fu[i]) + bfhi(bu[i]); ss += o[2 * i] * o[2 * i] + o[2 * i + 1] * o[2 * i + 1]; }
            ss += __shfl_xor(ss, 1); ss += __shfl_xor(ss, 2); ss += __shfl_xor(ss, 4); ss += __shfl_xor(ss, 8);
            const float rstd = __builtin_amdgcn_rsqf(ss * (1.f / 128.f) + EPS);
            const f32x4 g0 = *(const f32x4*)(a.g_onorm + lane * 8), g1 = *(const f32x4*)(a.g_onorm + lane * 8 + 4); const float gg[8] = {g0.x, g0.y, g0.z, g0.w, g1.x, g1.y, g1.z, g1.w};
#pragma unroll
            for (int i = 0; i < 4; ++i) { o[2 * i] *= rstd * gg[2 * i] * bflo(su[i]); o[2 * i + 1] *= rstd * gg[2 * i + 1] * bfhi(su[i]); }
            *(u32x4*)(OH + off) = pack8(o);
        }
    }
    SEAM(4); STAMP(5);
    if (IN(5)) {
        SchedBranch S{(const char*)OH, (const char*)OM, (const char*)Wb0T, (const char*)Wb1T, G, bx};
        EpiBranch E{GATES, MERGED};
        pg8::gemm_phase(wv, ldsl, 512, 512, S, E);
    }
    SEAM(5); STAMP(6);
    if (IN(6)) {
        SchedSimple S{(const char*)MERGED, (const char*)WoT, 256, 4, G, bx, (size_t)256 * 1024 * 2, (size_t)256 * 1024 * 2};
        EpiOut E{a.x_prompt, a.x_sample, X1B, RSX1};
        pg8::gemm_phase(wv, ldsl, 1024, 1024, S, E);
    }
    SEAM(6); STAMP(7);
    if (IN(7)) {
        SchedSimple S{(const char*)X1B, (const char*)WguT, 256, 22, G, bx, (size_t)256 * 1024 * 2, (size_t)256 * 1024 * 2};
        EpiGU E{RSX1, ACT};
        pg8::gemm_phase(wv, ldsl, 1024, 1024, S, E);
    }
    SEAM(7); STAMP(8);
    if (PROBE_SEL) grid_barrier((unsigned*)(ws + WS_XBAR), wv, (volatile LAS unsigned*)(ldsl + LDS_CTL + 32));
    if (IN(8)) { TIDS
        SchedPanel S{(const char*)ACT, (const char*)WdT, G, bx, (size_t)256 * DFF * 2, (size_t)256 * DFF * 2};
        EpiDown E{X1B, a.out, RSX2};
        pg8::gemm_phase(wv, ldsl, DFF, DFF, S, E);
        asm volatile("s_waitcnt vmcnt(0)" ::: "memory");
        __builtin_amdgcn_fence(__ATOMIC_RELEASE, "workgroup"); __syncthreads();
        float pert = 0.f;
        if (PROBE_SEL) { const unsigned long long* ts = (const unsigned long long*)(ws + WS_TS); float tus = 0.f;
            if (PROBE_SEL == 1) tus = (float)(ts[4] - ts[3]) * 0.01f;
            if (PROBE_SEL == 2) tus = (float)(ts[16] - ts[3]) * 0.01f;
            if (PROBE_SEL == 3) tus = (float)(ts[17] - ts[3]) * 0.01f;
            if (PROBE_SEL == 4) tus = (float)((ts[1] - ts[0])) * 0.01f;
            if (PROBE_SEL == 5) tus = (float)((ts[5] - ts[4])) * 0.01f;
            if (PROBE_SEL == 6) tus = (float)((ts[8] - ts[0])) * 0.01f;
            if (PROBE_SEL == 8) tus = (float)((ts[2] - ts[1])) * 0.01f;
            if (PROBE_SEL == 9) tus = (float)((ts[8] - ts[7])) * 0.01f;
            pert = sqrtf(tus * 1e-9f); }
        for (int p = bx; p < 256; p += G)
            for (int r = wave; r < 256; r += 8) { const int m = p * 256 + r;
                const float rstd = __builtin_amdgcn_rsqf(__hip_atomic_load(RSX2 + m, __ATOMIC_RELAXED, __HIP_MEMORY_SCOPE_AGENT) * (1.f / 1024.f) + EPS);
                f32x4* yr = (f32x4*)(a.out + (size_t)m * 1024) + lane;
#pragma unroll
                for (int j = 0; j < 4; ++j) { const f32x4 g = ((const f32x4*)a.g_final)[64 * j + lane]; f32x4 v = yr[64 * j]; v.x = v.x * rstd * g.x + pert; v.y = v.y * rstd * g.y - pert; v.z = v.z * rstd * g.z + pert; v.w = v.w * rstd * g.w - pert; yr[64 * j] = v; }
            }
        if (PROBE_SEL == 7) {
            asm volatile("s_waitcnt vmcnt(0)" ::: "memory"); __syncthreads();
            unsigned long long* ts = (unsigned long long*)(ws + WS_TS);
            if (wv == 0 && lane == 0) { atomicMax(ts + 18, (unsigned long long)__builtin_amdgcn_s_memrealtime()); __threadfence(); atomicAdd((unsigned*)(ts + 19), 1u); }
            if (bx == 0) {
                if (wv == 0 && lane == 0) { while (__hip_atomic_load((unsigned*)(ts + 19), __ATOMIC_RELAXED, __HIP_MEMORY_SCOPE_AGENT) < (unsigned)G) __builtin_amdgcn_s_sleep(8); }
                __syncthreads();
                const unsigned long long tend = __hip_atomic_load(ts + 18, __ATOMIC_RELAXED, __HIP_MEMORY_SCOPE_AGENT), t0 = __hip_atomic_load(ts + 0, __ATOMIC_RELAXED, __HIP_MEMORY_SCOPE_AGENT);
                const float tus = (float)(tend - t0) * 0.01f; const float pe = sqrtf(tus * 256e-9f);
                for (int r = wave; r < 256; r += 8) { f32x4* yr = (f32x4*)(a.out + (size_t)r * 1024) + lane;
#pragma unroll
                    for (int j = 0; j < 4; ++j) { f32x4 v = yr[64 * j]; v.x += pe; v.y -= pe; v.z += pe; v.w -= pe; yr[64 * j] = v; } }
            }
        }
    }
#undef IN
#undef SEAM
}

extern "C" void kernel_launch(void* const* d_in, const int* in_sizes, int n_in, void* d_out, int out_size, void* d_ws, size_t ws_size, hipStream_t stream) {
    static int grid = 0;
    if (grid == 0) {
        if (n_in != 16 || out_size != M * DM || ws_size < WS_END) { fprintf(stderr, "kernel_launch: unexpected shapes: n_in %d out %d ws %zu (need %zu)\n", n_in, out_size, ws_size, (size_t)WS_END); grid = -1; return; }
        int dev = 0, cus = 0, per_cu = 0;
        if (hipGetDevice(&dev) != hipSuccess || hipDeviceGetAttribute(&cus, hipDeviceAttributeMultiprocessorCount, dev) != hipSuccess) { grid = -1; return; }
        if (hipFuncSetAttribute((const void*)fwd_megakernel, hipFuncAttributeMaxDynamicSharedMemorySize, LDS_BYTES) != hipSuccess) { fprintf(stderr, "kernel_launch: hipFuncSetAttribute failed\n"); grid = -1; return; }
        if (hipOccupancyMaxActiveBlocksPerMultiprocessor(&per_cu, (const void*)fwd_megakernel, 512, LDS_BYTES) != hipSuccess || per_cu < 1) { fprintf(stderr, "kernel_launch: occupancy query says %d\n", per_cu); per_cu = 1; }
        (void)hipGetLastError();
        grid = cus;
    }
    if (grid < 0) return;
    Args a{};
    a.x_prompt = (const float*)d_in[0]; a.x_sample = (const float*)d_in[1]; a.g_mix = (const float*)d_in[2]; a.w_in = (const float*)d_in[3]; a.lb_param = (const float*)d_in[4];
    a.g_onorm = (const float*)d_in[5]; a.g_qa = (const float*)d_in[6]; a.w_uq = (const float*)d_in[7]; a.g_kva = (const float*)d_in[8]; a.w_ukv = (const float*)d_in[9];
    a.w_branch = (const float*)d_in[10]; a.w_out = (const float*)d_in[11]; a.g_ffn = (const float*)d_in[12]; a.w_gate_up = (const float*)d_in[13]; a.w_down = (const float*)d_in[14]; a.g_final = (const float*)d_in[15];
    a.out = (float*)d_out; a.ws = (unsigned char*)d_ws;
    for (int i = 0; i < 16; ++i) a.inv_rev[i] = pow(10000.0, -(double)i / 16.0) / 6.283185307179586476925;
    a.ph_lo = 0; a.ph_hi = 9;
    void* args[] = {&a};
    const hipError_t e = hipLaunchCooperativeKernel((const void*)fwd_megakernel, dim3(grid), dim3(512), args, LDS_BYTES, stream);
    if (e != hipSuccess) fprintf(stderr, "kernel_launch: cooperative launch failed: %s (grid %d)\n", hipGetErrorString(e), grid);
}
```

```cpp
#include <hip/hip_runtime.h>
#include <hip/hip_cooperative_groups.h>
#include <hip/hip_bf16.h>
#include <cstdio>
#include <cstdint>
#include <cmath>
namespace cg = cooperative_groups;

#define LAS __attribute__((address_space(3)))
typedef unsigned short bf16_t;
typedef short bf16x8 __attribute__((ext_vector_type(8)));
typedef short s16x4 __attribute__((ext_vector_type(4)));
typedef float f32x4 __attribute__((ext_vector_type(4)));
typedef float f32x2 __attribute__((ext_vector_type(2)));
typedef float f32x16 __attribute__((ext_vector_type(16)));
typedef unsigned u32x4 __attribute__((ext_vector_type(4)));
typedef unsigned u32x2 __attribute__((ext_vector_type(2)));
typedef __bf16 bf16x2_t __attribute__((ext_vector_type(2)));
typedef _Float16 h16x8 __attribute__((ext_vector_type(8)));

constexpr int M = 65536, DM = 1024, T0 = 32768;
constexpr int NIN = 5376;
constexpr int DFF = 2816;
constexpr float EPS = 1e-6f;
constexpr float QSCALE = 0.10206207261596575f * 1.4426950408889634f;
constexpr size_t MiB = 1u << 20;
constexpr size_t WS_XBAR = 32768;
constexpr size_t WS_QUEUE = 0, WS_BAR = 4096, WS_TS = 8192, WS_KMAX = 16384;
#ifndef PROBE_SEL
#define PROBE_SEL 0
#endif
constexpr size_t WS_RSQ = 1 * MiB, WS_RSKV = WS_RSQ + 262144, WS_RSX1 = WS_RSKV + 262144, WS_RSX2 = WS_RSX1 + 262144;
constexpr size_t CTL_ZERO = 2 * MiB;
constexpr size_t WS_ROPE = 2 * MiB;
constexpr size_t WS_WIN = 4 * MiB, WS_WUQ = 15 * MiB, WS_WUKV = 15 * MiB + 512 * 1024, WS_WB0 = 16 * MiB, WS_WB1 = 17 * MiB, WS_WO = 18 * MiB, WS_WGU = 20 * MiB, WS_WD = 31 * MiB;
constexpr size_t WS_XN = 40 * MiB, WS_OFW = 40 * MiB, WS_OBW = 104 * MiB, WS_X1B = 40 * MiB;
constexpr size_t WS_HQ = 168 * MiB, WS_HI = 232 * MiB, WS_GF = 296 * MiB, WS_GB = 360 * MiB, WS_SG = 424 * MiB, WS_LAT = 488 * MiB;
constexpr size_t WS_Q = 552 * MiB, WS_K = 648 * MiB, WS_V = 744 * MiB, WS_OM = 808 * MiB;
constexpr size_t WS_OH = 168 * MiB, WS_MERGED = 232 * MiB, WS_X1 = 552 * MiB, WS_ACT = 168 * MiB;
constexpr size_t WS_END = 872 * MiB;
constexpr int LDS_BYTES = 155648;
constexpr int LDS_CTL = 155648 - 256;

__device__ __forceinline__ unsigned cvtpk(float lo, float hi) { f32x2 v = {lo, hi}; bf16x2_t b = __builtin_convertvector(v, bf16x2_t); return __builtin_bit_cast(unsigned, b); }
__device__ __forceinline__ float bf2f(unsigned short u) { return __builtin_bit_cast(float, (unsigned)u << 16); }
__device__ __forceinline__ float bflo(unsigned u) { return __builtin_bit_cast(float, u << 16); }
__device__ __forceinline__ float bfhi(unsigned u) { return __builtin_bit_cast(float, u & 0xffff0000u); }
__device__ __forceinline__ float sigmoidf_(float x) { return __builtin_amdgcn_rcpf(1.f + __expf(-x)); }
__device__ __forceinline__ float siluf_(float x) { return x * sigmoidf_(x); }
__device__ __forceinline__ u32x4 pack8(const float* v) { u32x4 w; w.x = cvtpk(v[0], v[1]); w.y = cvtpk(v[2], v[3]); w.z = cvtpk(v[4], v[5]); w.w = cvtpk(v[6], v[7]); return w; }
__device__ __forceinline__ int crow(int r, int hi) { return (r & 3) + 8 * (r >> 2) + 4 * hi; }
__device__ __forceinline__ const float* xrow_ptr(const float* xp, const float* xs, int row) { return row < T0 ? xp + (size_t)row * DM : xs + (size_t)(row - T0) * DM; }
__device__ __forceinline__ int row_seq(int row) { return row < T0 ? (row >> 13) : 4 + ((row - T0) >> 14); }
__device__ __forceinline__ int row_pos(int row) { return row < T0 ? (row & 8191) : (row & 16383); }
#define SBAR() __builtin_amdgcn_sched_barrier(0)
__device__ __forceinline__ int lane_id() { int l; asm volatile("v_mbcnt_lo_u32_b32 %0, -1, 0\n\tv_mbcnt_hi_u32_b32 %0, -1, %0" : "=v"(l)); return l; }

namespace pg8 {
constexpr int BM = 256, BK = 64, HALF = 128, HTB = HALF * BK * 2, STAGE_BYTES = 8 * HTB, NXCD = 8, WGM = 4;
__device__ __forceinline__ int lds_byte(int r, int c) { const int st = (r >> 4) * 2 + (c >> 5), rr = r & 15, cc = c & 31, ob = rr * 64 + cc * 2; return st * 1024 + (ob ^ (((ob >> 9) & 1) << 5)); }
__device__ __forceinline__ void stage_rc(int b, int& R, int& C) { const int st = b / 1024, sb = b % 1024, swz = sb ^ (((sb >> 9) & 1) << 5); R = (st >> 1) * 16 + swz / 64; C = (st & 1) * 32 + (swz % 64) / 2; }
__device__ __forceinline__ int perm32(int rho) { const int n = rho >> 4, i = rho & 15; return 8 * (i >> 2) + 4 * n + (i & 3); }
struct Unit { int pm, pn, tag; const char* a; const char* b; };
__device__ __forceinline__ void tile_of(int L, int nM, int nN, int& pm, int& pn) {
    const int nwg = nM * nN; int wgid = L;
    { const int q = nwg / NXCD, r = nwg % NXCD, xcd = wgid % NXCD, off = wgid / NXCD; wgid = (xcd < r ? xcd * (q + 1) : r * (q + 1) + (xcd - r) * q) + off; }
    const int nig = WGM * nN, gid = wgid / nig, fm = gid * WGM, gsz = (nM - fm) < WGM ? (nM - fm) : WGM;
    pm = fm + ((wgid % nig) % gsz); pn = (wgid % nig) / gsz;
}
template <class Epi, class Sched>
__device__ __forceinline__ void gemm_phase(const int wv, LAS unsigned char* lds, const int K, const int lda, const Sched& S, const Epi& E) {
    const int lane = lane_id(), wid = wv, tid = wv * 64 + lane, wr = wid >> 2, wc = wid & 3, fr = lane & 15, fq = lane >> 4;
    const int nt = K / BK;
    unsigned voffA[2], voffB[2];
#pragma unroll
    for (int i = 0; i < 2; ++i) { int R, C; stage_rc(tid * 16 + i * 8192, R, C); const int Rb = (R & ~31) + perm32(R & 31);
        voffA[i] = (unsigned)(R * lda + C) * 2u; voffB[i] = (unsigned)(Rb * K + C) * 2u; }
    const size_t kstep = (size_t)(BK * 2);
    const size_t hA = (size_t)HALF * lda * 2, hB = (size_t)HALF * K * 2;
    const unsigned ldsw = (unsigned)wid * 1024u;
    const int aoff = lds_byte(wr * 64 + fr, fq * 8), boff = lds_byte(wc * 32 + fr, fq * 8);
#define PG8_SA(b, h) (((b) * 2 + (h)) * HTB)
#define PG8_SB(b, h) ((4 + (b) * 2 + (h)) * HTB)
#define PG8_STAGE(bufoff, gbase, voff) do { _Pragma("unroll") for (int _i = 0; _i < 2; ++_i) \
        __builtin_amdgcn_global_load_lds((const unsigned*)((const char*)(gbase) + (voff)[_i]), (LAS unsigned*)(lds + (bufoff) + ldsw + _i * 8192), 16, 0, 0); } while (0)
#define PG8_LDA(dst, b, h) do { _Pragma("unroll") for (int m = 0; m < 4; ++m) _Pragma("unroll") for (int k = 0; k < 2; ++k) dst[m][k] = *(const LAS bf16x8*)(lds + PG8_SA(b, h) + aoff + m * 2048 + k * 1024); } while (0)
#define PG8_LDB(dst, b, h) do { _Pragma("unroll") for (int n = 0; n < 2; ++n) _Pragma("unroll") for (int k = 0; k < 2; ++k) dst[n][k] = *(const LAS bf16x8*)(lds + PG8_SB(b, h) + boff + n * 2048 + k * 1024); } while (0)
#define PG8_MMA(ai, bj, At, Bt) do { __builtin_amdgcn_s_setprio(1); _Pragma("unroll") for (int m = 0; m < 4; ++m) _Pragma("unroll") for (int n = 0; n < 2; ++n) _Pragma("unroll") for (int k = 0; k < 2; ++k) \
        acc[ai][bj][m][n] = __builtin_amdgcn_mfma_f32_16x16x32_bf16(Bt[n][k], At[m][k], acc[ai][bj][m][n], 0, 0, 0); __builtin_amdgcn_s_setprio(0); } while (0)
#define PG8_WAIT_V(n) asm volatile("s_waitcnt vmcnt(" #n ")" ::: "memory")
#define PG8_WAIT_L(n) asm volatile("s_waitcnt lgkmcnt(" #n ")" ::: "memory")
#define PG8_BAR __builtin_amdgcn_s_barrier()
#define PG8_SCHED __builtin_amdgcn_sched_barrier(0)
    Unit cur, nxt; int ui = 0;
    if (!S.next(0, cur)) return;
    f32x4 acc[2][2][4][2];
#pragma unroll
    for (int a = 0; a < 2; ++a)
#pragma unroll
        for (int b = 0; b < 2; ++b)
#pragma unroll
            for (int m = 0; m < 4; ++m)
#pragma unroll
                for (int n = 0; n < 2; ++n) acc[a][b][m][n] = (f32x4){0.f, 0.f, 0.f, 0.f};
    bf16x8 At[4][2], B0[2][2], B1[2][2];
    const char* cA = cur.a; const char* cB = cur.b;
    PG8_STAGE(PG8_SB(0, 0), cB, voffB); PG8_STAGE(PG8_SB(0, 1), cB + hB, voffB); PG8_STAGE(PG8_SA(0, 0), cA, voffA); PG8_STAGE(PG8_SA(0, 1), cA + hA, voffA);
    if (wr == 1) PG8_BAR;
    PG8_WAIT_V(2); PG8_BAR;
    PG8_STAGE(PG8_SB(1, 0), cB + kstep, voffB); PG8_STAGE(PG8_SA(1, 0), cA + kstep, voffA); PG8_STAGE(PG8_SB(1, 1), cB + hB + kstep, voffB);
    PG8_WAIT_V(6); PG8_BAR;
    for (;;) {
        const bool has_next = S.next(ui + 1, nxt);
        const char* nA = has_next ? nxt.a : cA; const char* nB = has_next ? nxt.b : cB;
        for (int t = 0; t < nt; t += 2) {
            const bool last = (t == nt - 2);
            const char* a1 = cA + (size_t)(t + 1) * kstep;
            const char* a2 = last ? nA : cA + (size_t)(t + 2) * kstep; const char* b2 = last ? nB : cB + (size_t)(t + 2) * kstep;
            const char* a3 = a2 + kstep; const char* b3 = b2 + kstep;
            PG8_LDB(B0, 0, 0); PG8_LDB(B1, 0, 1); PG8_SCHED; PG8_LDA(At, 0, 0); PG8_STAGE(PG8_SA(1, 1), a1 + hA, voffA);
            PG8_WAIT_V(8); PG8_WAIT_L(0); PG8_BAR; PG8_MMA(0, 0, At, B0); PG8_MMA(0, 1, At, B1); PG8_BAR; PG8_SCHED;
            PG8_LDA(At, 0, 1); PG8_STAGE(PG8_SB(0, 0), b2, voffB); PG8_STAGE(PG8_SB(0, 1), b2 + hB, voffB); PG8_STAGE(PG8_SA(0, 0), a2, voffA);
            PG8_WAIT_V(8); PG8_WAIT_L(0); PG8_BAR; PG8_MMA(1, 0, At, B0); PG8_MMA(1, 1, At, B1); PG8_BAR; PG8_SCHED;
            PG8_LDB(B0, 1, 0); PG8_LDB(B1, 1, 1); PG8_SCHED; PG8_LDA(At, 1, 0); PG8_STAGE(PG8_SA(0, 1), a2 + hA, voffA);
            PG8_WAIT_V(8); PG8_WAIT_L(0); PG8_BAR; PG8_MMA(0, 0, At, B0); PG8_MMA(0, 1, At, B1); PG8_BAR; PG8_SCHED;
            PG8_LDA(At, 1, 1); PG8_STAGE(PG8_SB(1, 0), b3, voffB); PG8_STAGE(PG8_SB(1, 1), b3 + hB, voffB); PG8_STAGE(PG8_SA(1, 0), a3, voffA);
            PG8_WAIT_V(8); PG8_WAIT_L(0); PG8_BAR; PG8_MMA(1, 0, At, B0); PG8_MMA(1, 1, At, B1); PG8_BAR; PG8_SCHED;
        }
        if (wr == 0) PG8_BAR;
        const int l2_ = lane_id(); const int fr_ = l2_ & 15, fq_ = l2_ >> 4;
        const bool keep = E(acc, cur, wr, wc, fr_, fq_);
        if (!has_next) break;
        if (!keep) {
#pragma unroll
        for (int a = 0; a < 2; ++a)
#pragma unroll
            for (int b = 0; b < 2; ++b)
#pragma unroll
                for (int m = 0; m < 4; ++m)
#pragma unroll
                    for (int n = 0; n < 2; ++n) acc[a][b][m][n] = (f32x4){0.f, 0.f, 0.f, 0.f};
        }
        cur = nxt; cA = nA; cB = nB; ++ui;
        if (wr == 1) PG8_BAR;
    }
    PG8_WAIT_V(0);
    PG8_BAR;
#undef PG8_SA
#undef PG8_SB
#undef PG8_STAGE
#undef PG8_LDA
#undef PG8_LDB
#undef PG8_MMA
#undef PG8_WAIT_V
#undef PG8_WAIT_L
#undef PG8_BAR
#undef PG8_SCHED
}
}
using pg8::Unit;
typedef f32x4 Acc[2][2][4][2];
#define EPI_ROWS(ai, m, row) _Pragma("unroll") for (int ai = 0; ai < 2; ++ai) _Pragma("unroll") for (int m = 0; m < 4; ++m) { const int row = u.pm * 256 + ai * 128 + wr * 64 + m * 16 + fr;
#define EPI_END asm volatile("" ::: "memory"); }
__device__ __forceinline__ void get8(const Acc& acc, int ai, int bj, int m, float* v) {
    const f32x4 a = acc[ai][bj][m][0], b = acc[ai][bj][m][1]; v[0] = a[0]; v[1] = a[1]; v[2] = a[2]; v[3] = a[3]; v[4] = b[0]; v[5] = b[1]; v[6] = b[2]; v[7] = b[3]; }

struct Args {
    const float *x_prompt, *x_sample, *g_mix, *w_in, *lb_param, *g_onorm, *g_qa, *w_uq, *g_kva, *w_ukv, *w_branch, *w_out, *g_ffn, *w_gate_up, *w_down, *g_final;
    float* out; unsigned char* ws;
    double inv_rev[16];
    int ph_lo, ph_hi;
};

struct SchedSimple {
    const char* A; const char* B; int nM, nN, G, c; size_t tA, tB;
    __device__ __forceinline__ bool next(int i, Unit& u) const { const long L = (long)i * G + c; if (L >= (long)nM * nN) return false; pg8::tile_of((int)L, nM, nN, u.pm, u.pn); u.tag = 0; u.a = A + u.pm * tA; u.b = B + u.pn * tB; return true; }
};
struct SchedUp {
    const char* LAT; const char* Wuq; const char* Wukv; int G, c;
    __device__ __forceinline__ bool next(int i, Unit& u) const { const long L = (long)i * G + c; if (L >= 256L * 7) return false; pg8::tile_of((int)L, 256, 7, u.pm, u.pn); u.tag = 0;
        u.a = LAT + (size_t)u.pm * 256 * 512 * 2 + (u.pn >= 3 ? 512 : 0); u.b = u.pn < 3 ? Wuq + (size_t)u.pn * 256 * 256 * 2 : Wukv + (size_t)(u.pn - 3) * 256 * 256 * 2; return true; }
};
struct SchedBranch {
    const char* OH; const char* OMm; const char* W0; const char* W1; int G, c;
    __device__ __forceinline__ bool next(int i, Unit& u) const { const long L = (long)(i >> 1) * G + c; if (L >= 256L * 4) return false; pg8::tile_of((int)L, 256, 4, u.pm, u.pn); u.tag = i & 1;
        u.a = ((i & 1) ? OMm : OH) + (size_t)u.pm * 256 * 512 * 2; u.b = ((i & 1) ? W1 : W0) + (size_t)u.pn * 256 * 512 * 2; return true; }
};

struct SchedPanel {
    const char* A; const char* B; int G, c; size_t tA, tB;
    __device__ __forceinline__ bool next(int i, Unit& u) const { const int p = c + (i >> 2) * G; if (p >= 256) return false; u.pm = p; u.pn = i & 3; u.tag = 0; u.a = A + p * tA; u.b = B + u.pn * tB; return true; }
};
struct EpiIn {
    unsigned char* ws; bf16_t *GATES; const float* lbp;
    __device__ __forceinline__ bool operator()(const Acc& acc, const Unit& u, int wr, int wc, int fr, int fq) const {
        const int pn = u.pn, cb = wc * 32 + 8 * fq;
        if (pn < 4 || (pn >= 8 && pn < 10)) {
            bf16_t* dst = (bf16_t*)(ws + (pn < 2 ? WS_HQ : (pn < 4 ? WS_HI : WS_SG))); const int c0 = (pn & 1) * 256; const bool act = (pn < 2 || pn >= 8);
            EPI_ROWS(ai, m, row)
#pragma unroll
                for (int bj = 0; bj < 2; ++bj) { float v[8]; get8(acc, ai, bj, m, v);
                    if (act) {
#pragma unroll
                        for (int i = 0; i < 8; ++i) v[i] = siluf_(v[i]); }
                    *(u32x4*)(dst + (size_t)row * 512 + c0 + bj * 128 + cb) = pack8(v); }
            EPI_END
        } else if (pn < 8) {
            const int dir = (pn >= 6); _Float16* dst = (_Float16*)(ws + (dir ? WS_GB : WS_GF)); const int c0 = (pn & 1) * 256;
            float lb[2][8];
#pragma unroll
            for (int bj = 0; bj < 2; ++bj)
#pragma unroll
                for (int i = 0; i < 8; ++i) { const int col = c0 + bj * 128 + cb + i; lb[bj][i] = sigmoidf_(lbp[dir * 512 + col] - lbp[1024 + dir * 512 + col]); }
            EPI_ROWS(ai, m, row)
#pragma unroll
                for (int bj = 0; bj < 2; ++bj) { float v[8]; get8(acc, ai, bj, m, v); h16x8 h;
#pragma unroll
                    for (int i = 0; i < 8; ++i) { const float f = lb[bj][i] + (1.f - lb[bj][i]) * sigmoidf_(v[i]); h[i] = (_Float16)__logf(f); }
                    *(u32x4*)(dst + (size_t)row * 512 + c0 + bj * 128 + cb) = __builtin_bit_cast(u32x4, h); }
            EPI_END
        } else if (pn < 12) {
            float* RS = (float*)(ws + (pn == 10 ? WS_RSQ : WS_RSKV)); const int c0 = (pn - 10) * 256; bf16_t* LAT = (bf16_t*)(ws + WS_LAT);
            EPI_ROWS(ai, m, row)
                float ss = 0.f;
#pragma unroll
                for (int bj = 0; bj < 2; ++bj) { float v[8]; get8(acc, ai, bj, m, v);
#pragma unroll
                    for (int i = 0; i < 8; ++i) ss += v[i] * v[i];
                    *(u32x4*)(LAT + (size_t)row * 512 + c0 + bj * 128 + cb) = pack8(v); }
                ss += __shfl_xor(ss, 16); ss += __shfl_xor(ss, 32);
                if (fq == 0) atomicAdd(RS + row, ss);
            EPI_END
        } else if (pn < 20) {
            const int c0 = (pn - 12) * 256;
            EPI_ROWS(ai, m, row)
#pragma unroll
                for (int bj = 0; bj < 2; ++bj) { float v[8]; get8(acc, ai, bj, m, v);
#pragma unroll
                    for (int i = 0; i < 8; ++i) v[i] = sigmoidf_(v[i]);
                    *(u32x4*)(GATES + (size_t)row * 2048 + c0 + bj * 128 + cb) = pack8(v); }
            EPI_END
        } else {
            bf16_t* Kc = (bf16_t*)(ws + WS_K); const f32x2* rope = (const f32x2*)(ws + WS_ROPE); float kmx = 0.f;
            EPI_ROWS(ai, m, row)
                float v[8], p[8]; get8(acc, ai, 0, m, v);
                { float ss = 0.f;
#pragma unroll
                  for (int i = 0; i < 8; ++i) ss += v[i] * v[i];
                  ss += __shfl_xor(ss, 16); ss += __shfl_xor(ss, 32); kmx = fmaxf(kmx, ss); }
#pragma unroll
                for (int i = 0; i < 8; ++i) p[i] = __shfl_xor(v[i], 32);
                if (wc == 0) {
                    const int pos = row_pos(row); const f32x2* cs = rope + pos * 16 + 8 * (fq & 1); float o[8];
#pragma unroll
                    for (int i = 0; i < 8; ++i) { const f32x2 c = cs[i]; o[i] = (fq < 2) ? (v[i] * c.x - p[i] * c.y) : (v[i] * c.x + p[i] * c.y); }
                    const u32x4 w = pack8(o);
#pragma unroll
                    for (int h = 0; h < 8; ++h) *(u32x4*)(Kc + ((size_t)row * 8 + h) * 96 + 64 + 8 * fq) = w;
                }
            EPI_END
            if (wc == 0) { kmx = fmaxf(kmx, __shfl_xor(kmx, 1)); kmx = fmaxf(kmx, __shfl_xor(kmx, 2)); kmx = fmaxf(kmx, __shfl_xor(kmx, 4)); kmx = fmaxf(kmx, __shfl_xor(kmx, 8));
                if (fr == 0 && fq == 0) { unsigned* KM = (unsigned*)(ws + WS_KMAX) + row_seq(u.pm * 256) * 32;
#pragma unroll
                    for (int h = 0; h < 8; ++h) atomicMax(KM + h * 4 + 2, __float_as_uint(kmx)); } }
        }
        return false;
    }
};
struct EpiUp {
    bf16_t *Q, *Kc, *V; const float *RSQ, *RSKV; const f32x2* rope; unsigned* KMAX;
    __device__ __forceinline__ bool operator()(const Acc& acc, const Unit& u, int wr, int wc, int fr, int fq) const {
        const int pn = u.pn, cb = wc * 32 + 8 * fq;
#define LOAD_RSV(RSp) float rsv[2][4]; { int rb_ = u.pm * 256 + wr * 64 + fr; asm volatile("" : "+v"(rb_)); const float* rp_ = (RSp) + rb_; _Pragma("unroll") for (int ai = 0; ai < 2; ++ai) _Pragma("unroll") for (int m = 0; m < 4; ++m) rsv[ai][m] = rp_[ai * 128 + m * 16]; }
        if (pn < 2) { LOAD_RSV(RSQ)
            EPI_ROWS(ai, m, row)
                const float sc = __builtin_amdgcn_rsqf(rsv[ai][m] * (1.f / 256.f) + EPS) * QSCALE;
#pragma unroll
                for (int bj = 0; bj < 2; ++bj) { float v[8]; get8(acc, ai, bj, m, v);
#pragma unroll
                    for (int i = 0; i < 8; ++i) v[i] *= sc;
                    const int cg_ = pn * 256 + bj * 128 + cb, h = cg_ >> 6, d = cg_ & 63;
                    *(u32x4*)(Q + ((size_t)row * 8 + h) * 96 + d) = pack8(v); }
            EPI_END
        } else if (pn == 2) {
            EPI_ROWS(ai, m, row)
                const float sc = __builtin_amdgcn_rsqf(RSQ[row] * (1.f / 256.f) + EPS) * QSCALE;
                const int pos = row_pos(row); const f32x2* cs = rope + pos * 16 + 8 * (fq & 1);
#pragma unroll
                for (int bj = 0; bj < 2; ++bj) { float v[8], p[8], o[8]; get8(acc, ai, bj, m, v);
#pragma unroll
                    for (int i = 0; i < 8; ++i) p[i] = __shfl_xor(v[i], 32);
#pragma unroll
                    for (int i = 0; i < 8; ++i) { const f32x2 c = cs[i]; o[i] = ((fq < 2) ? (v[i] * c.x - p[i] * c.y) : (v[i] * c.x + p[i] * c.y)) * sc; }
                    const int h = bj * 4 + wc;
                    *(u32x4*)(Q + ((size_t)row * 8 + h) * 96 + 64 + 8 * fq) = pack8(o); asm volatile("" ::: "memory"); }
            EPI_END
        } else {
            float kmx[2] = {0.f, 0.f}; LOAD_RSV(RSKV)
            EPI_ROWS(ai, m, row)
                const float sc = __builtin_amdgcn_rsqf(rsv[ai][m] * (1.f / 256.f) + EPS);
#pragma unroll
                for (int bj = 0; bj < 2; ++bj) { float v[8]; get8(acc, ai, bj, m, v);
#pragma unroll
                    for (int i = 0; i < 8; ++i) v[i] *= sc;
                    const int cg_ = (pn - 3) * 256 + bj * 128 + cb, h = cg_ >> 7, d = cg_ & 127;
                    if (d < 64) { *(u32x4*)(Kc + ((size_t)row * 8 + h) * 96 + d) = pack8(v); float ss = 0.f;
#pragma unroll
                        for (int i = 0; i < 8; ++i) ss += v[i] * v[i];
                        ss += __shfl_xor(ss, 16); ss += __shfl_xor(ss, 32); kmx[bj] = fmaxf(kmx[bj], ss); }
                    else *(u32x4*)(V + ((size_t)row * 8 + h) * 64 + (d - 64)) = pack8(v); }
            EPI_END
            if (wc < 2) {
#pragma unroll
                for (int bj = 0; bj < 2; ++bj) { float k = kmx[bj]; k = fmaxf(k, __shfl_xor(k, 1)); k = fmaxf(k, __shfl_xor(k, 2)); k = fmaxf(k, __shfl_xor(k, 4)); k = fmaxf(k, __shfl_xor(k, 8));
                    if (fr == 0 && fq == 0) atomicMax(KMAX + row_seq(u.pm * 256) * 32 + ((pn - 3) * 2 + bj) * 4 + wc, __float_as_uint(k)); } }
        }
        return false;
    }
};
struct EpiBranch {
    const bf16_t* GATES; bf16_t* MERGED;
    __device__ __forceinline__ bool operator()(Acc& acc, const Unit& u, int wr, int wc, int fr, int fq) const {
        const int cb = wc * 32 + 8 * fq;
#pragma unroll
        for (int ai = 0; ai < 2; ++ai) {
            u32x4 g1v[4][2], g0v[4][2];
#pragma unroll
            for (int m = 0; m < 4; ++m)
#pragma unroll
                for (int bj = 0; bj < 2; ++bj) { const int row = u.pm * 256 + ai * 128 + wr * 64 + m * 16 + fr, col = u.pn * 256 + bj * 128 + cb;
                    g1v[m][bj] = *(const u32x4*)(GATES + (size_t)row * 2048 + 1024 + col); if (u.tag == 0) g0v[m][bj] = *(const u32x4*)(GATES + (size_t)row * 2048 + col); }
#pragma unroll
            for (int m = 0; m < 4; ++m)
#pragma unroll
                for (int bj = 0; bj < 2; ++bj) { const int row = u.pm * 256 + ai * 128 + wr * 64 + m * 16 + fr, col = u.pn * 256 + bj * 128 + cb;
                    const u32x4 g1 = g1v[m][bj]; float g1f[8] = {bflo(g1.x), bfhi(g1.x), bflo(g1.y), bfhi(g1.y), bflo(g1.z), bfhi(g1.z), bflo(g1.w), bfhi(g1.w)};
                    if (u.tag == 0) {
                        const u32x4 g0 = g0v[m][bj]; float g0f[8] = {bflo(g0.x), bfhi(g0.x), bflo(g0.y), bfhi(g0.y), bflo(g0.z), bfhi(g0.z), bflo(g0.w), bfhi(g0.w)};
#pragma unroll
                        for (int i = 0; i < 4; ++i) { acc[ai][bj][m][0][i] *= g0f[i] * __builtin_amdgcn_rcpf(g1f[i]); acc[ai][bj][m][1][i] *= g0f[4 + i] * __builtin_amdgcn_rcpf(g1f[4 + i]); }
                    } else {
                        float v[8]; get8(acc, ai, bj, m, v);
#pragma unroll
                        for (int i = 0; i < 8; ++i) v[i] *= g1f[i];
                        *(u32x4*)(MERGED + (size_t)row * 1024 + col) = pack8(v);
                    } }
            asm volatile("" ::: "memory");
        }
        return u.tag == 0;
    }
};
struct EpiOut {
    const float *xp, *xs; bf16_t* X1B; float* RS;
    __device__ __forceinline__ bool operator()(const Acc& acc, const Unit& u, int wr, int wc, int fr, int fq) const {
        const int cb = wc * 32 + 8 * fq;
#pragma unroll
        for (int ai = 0; ai < 2; ++ai) {
            f32x4 pre[4][2][2];
#pragma unroll
            for (int m = 0; m < 4; ++m) { const int row = u.pm * 256 + ai * 128 + wr * 64 + m * 16 + fr; const float* xr = xrow_ptr(xp, xs, row);
#pragma unroll
                for (int bj = 0; bj < 2; ++bj) { const int col = u.pn * 256 + bj * 128 + cb; pre[m][bj][0] = *(const f32x4*)(xr + col); pre[m][bj][1] = *(const f32x4*)(xr + col + 4); } }
#pragma unroll
            for (int m = 0; m < 4; ++m) { const int row = u.pm * 256 + ai * 128 + wr * 64 + m * 16 + fr; float ss = 0.f;
#pragma unroll
                for (int bj = 0; bj < 2; ++bj) { const int col = u.pn * 256 + bj * 128 + cb; float v[8]; get8(acc, ai, bj, m, v);
                    const f32x4 x0 = pre[m][bj][0], x1 = pre[m][bj][1];
                    v[0] += x0[0]; v[1] += x0[1]; v[2] += x0[2]; v[3] += x0[3]; v[4] += x1[0]; v[5] += x1[1]; v[6] += x1[2]; v[7] += x1[3];
#pragma unroll
                    for (int i = 0; i < 8; ++i) ss += v[i] * v[i];
                    *(u32x4*)(X1B + (size_t)row * 1024 + col) = pack8(v); }
                ss += __shfl_xor(ss, 16); ss += __shfl_xor(ss, 32);
                if (fq == 0) atomicAdd(RS + row, ss); }
            asm volatile("" ::: "memory");
        }
        return false;
    }
};
struct EpiGU {
    const float* RS; bf16_t* ACT;
    __device__ __forceinline__ bool operator()(const Acc& acc, const Unit& u, int wr, int wc, int fr, int fq) const {
        const int cb = wc * 32 + 8 * fq;
        float rsv[2][4];
        { int rb_ = u.pm * 256 + wr * 64 + fr; asm volatile("" : "+v"(rb_)); const float* rp_ = RS + rb_;
#pragma unroll
        for (int ai = 0; ai < 2; ++ai)
#pragma unroll
            for (int m = 0; m < 4; ++m) rsv[ai][m] = rp_[ai * 128 + m * 16]; }
        EPI_ROWS(ai, m, row)
            const float sc = __builtin_amdgcn_rsqf(rsv[ai][m] * (1.f / 1024.f) + EPS);
            float g[8], p[8]; get8(acc, ai, 0, m, g); get8(acc, ai, 1, m, p);
#pragma unroll
            for (int i = 0; i < 8; ++i) g[i] = siluf_(g[i] * sc) * (p[i] * sc);
            *(u32x4*)(ACT + (size_t)row * DFF + u.pn * 128 + cb) = pack8(g);
        EPI_END
        return false;
    }
};
struct EpiDown {
    const bf16_t* X1B; float* X2; float* RS;
    __device__ __forceinline__ bool operator()(const Acc& acc, const Unit& u, int wr, int wc, int fr, int fq) const {
        const int cb = wc * 32 + 8 * fq;
#pragma unroll
        for (int ai = 0; ai < 2; ++ai) {
            u32x4 pre[4][2];
#pragma unroll
            for (int m = 0; m < 4; ++m) { const int row = u.pm * 256 + ai * 128 + wr * 64 + m * 16 + fr;
#pragma unroll
                for (int bj = 0; bj < 2; ++bj) pre[m][bj] = *(const u32x4*)(X1B + (size_t)row * 1024 + u.pn * 256 + bj * 128 + cb); }
#pragma unroll
            for (int m = 0; m < 4; ++m) { const int row = u.pm * 256 + ai * 128 + wr * 64 + m * 16 + fr; float ss = 0.f;
#pragma unroll
                for (int bj = 0; bj < 2; ++bj) { const int col = u.pn * 256 + bj * 128 + cb; float v[8]; get8(acc, ai, bj, m, v);
                    const u32x4 x = pre[m][bj];
                    v[0] += bflo(x.x); v[1] += bfhi(x.x); v[2] += bflo(x.y); v[3] += bfhi(x.y); v[4] += bflo(x.z); v[5] += bfhi(x.z); v[6] += bflo(x.w); v[7] += bfhi(x.w);
#pragma unroll
                    for (int i = 0; i < 8; ++i) ss += v[i] * v[i];
                    *(f32x4*)(X2 + (size_t)row * 1024 + col) = (f32x4){v[0], v[1], v[2], v[3]}; *(f32x4*)(X2 + (size_t)row * 1024 + col + 4) = (f32x4){v[4], v[5], v[6], v[7]}; }
                ss += __shfl_xor(ss, 16); ss += __shfl_xor(ss, 32);
                if (fq == 0) atomicAdd(RS + row, ss); }
            asm volatile("" ::: "memory");
        }
        return false;
    }
};

namespace att {
constexpr int LDQ = 768, LDK = 768, LDV = 512, LDO = 512, KVBLK = 64, QBLK = 32;
constexpr int SHM_K = 64 * 256, SHM_V = 64 * 64 * 2;
#define KSWZ(row, colB) ((row) * 256 + ((colB) ^ (((row) & 7) << 4)))
__device__ __forceinline__ void expA(f32x16& p0) {
#pragma unroll
    for (int r = 0; r < 16; ++r) p0[r] = __builtin_amdgcn_exp2f(p0[r]);
}
__device__ __forceinline__ void finishSM(f32x16& p0, f32x16& p1, float& l_reg, bf16x8& pa0, bf16x8& pa1, bf16x8& pa2, bf16x8& pa3) {
#pragma unroll
    for (int r = 0; r < 16; ++r) p1[r] = __builtin_amdgcn_exp2f(p1[r]);
    float ps = 0;
#pragma unroll
    for (int r = 0; r < 16; ++r) ps += p0[r];
#pragma unroll
    for (int r = 0; r < 16; ++r) ps += p1[r];
    l_reg += ps;
#define PK4(P, BASE, OUT) do { unsigned a0 = cvtpk(P[BASE + 0], P[BASE + 1]), a1 = cvtpk(P[BASE + 2], P[BASE + 3]);   \
    unsigned b0 = cvtpk(P[BASE + 4], P[BASE + 5]), b1 = cvtpk(P[BASE + 6], P[BASE + 7]);                              \
    auto r0 = __builtin_amdgcn_permlane32_swap(a0, b0, false, false); auto r1 = __builtin_amdgcn_permlane32_swap(a1, b1, false, false); \
    u32x4 w = {r0[0], r1[0], r0[1], r1[1]}; OUT = *reinterpret_cast<bf16x8*>(&w); } while (0)
    PK4(p0, 0, pa0); PK4(p0, 8, pa1); PK4(p1, 0, pa2); PK4(p1, 8, pa3);
#undef PK4
}
__device__ __forceinline__ void qkt(f32x16& p0, f32x16& p1, const char* Ks, const bf16x8* qr, const float mrow, int r32, int hi) {
    p0 = f32x16{}; p1 = f32x16{};
#pragma unroll
    for (int d0 = 0; d0 < 6; ++d0) { const int cb = (d0 * 16 + hi * 8) * 2;
        bf16x8 b0 = *reinterpret_cast<const bf16x8*>(Ks + KSWZ(r32, cb));
        bf16x8 b1 = *reinterpret_cast<const bf16x8*>(Ks + KSWZ(32 + r32, cb));
        p0 = __builtin_amdgcn_mfma_f32_32x32x16_bf16(b0, qr[d0], p0, 0, 0, 0);
        p1 = __builtin_amdgcn_mfma_f32_32x32x16_bf16(b1, qr[d0], p1, 0, 0, 0); }
    if (mrow != 0.f) {
#pragma unroll
        for (int r = 0; r < 16; ++r) { p0[r] -= mrow; p1[r] -= mrow; } }
}
__device__ __forceinline__ int v_st(int k, int c) { const int kk = (k & ~0xC) | ((k & 4) << 1) | ((k & 8) >> 1); return ((kk >> 3) * 2 + (c >> 5)) * 512 + ((kk & 7) * 32 + (c & 31)) * 2; }
__device__ __forceinline__ int v_rd_base(int lane) { return ((lane & 3) << 3) | (((lane >> 2) & 3) << 6) | (((lane >> 4) & 1) << 5) | (((lane >> 5) & 1) << 8); }
constexpr int v_rd_off(int d0, int ks, int half) { return d0 * 512 + ks * 2048 + half * 1024; }
template <int OFF> __device__ __forceinline__ s16x4 tr_read(int vb) { s16x4 r; asm volatile("ds_read_b64_tr_b16 %0, %1 offset:%2" : "=&v"(r) : "v"(vb), "i"(OFF) : "memory"); return r; }
template <int D0> __device__ __forceinline__ void pv_one(f32x16& od, int vb, bf16x8 pa0, bf16x8 pa1, bf16x8 pa2, bf16x8 pa3) {
    const s16x4 l0 = tr_read<v_rd_off(D0, 0, 0)>(vb), h0 = tr_read<v_rd_off(D0, 0, 1)>(vb), l1 = tr_read<v_rd_off(D0, 1, 0)>(vb), h1 = tr_read<v_rd_off(D0, 1, 1)>(vb);
    const s16x4 l2 = tr_read<v_rd_off(D0, 2, 0)>(vb), h2 = tr_read<v_rd_off(D0, 2, 1)>(vb), l3 = tr_read<v_rd_off(D0, 3, 0)>(vb), h3 = tr_read<v_rd_off(D0, 3, 1)>(vb);
    asm volatile("s_waitcnt lgkmcnt(0)" ::: "memory"); SBAR();
#define PK(L, H) (bf16x8){L[0], L[1], L[2], L[3], H[0], H[1], H[2], H[3]}
    od = __builtin_amdgcn_mfma_f32_32x32x16_bf16(pa0, PK(l0, h0), od, 0, 0, 0);
    od = __builtin_amdgcn_mfma_f32_32x32x16_bf16(pa1, PK(l1, h1), od, 0, 0, 0);
    od = __builtin_amdgcn_mfma_f32_32x32x16_bf16(pa2, PK(l2, h2), od, 0, 0, 0);
    od = __builtin_amdgcn_mfma_f32_32x32x16_bf16(pa3, PK(l3, h3), od, 0, 0, 0);
#undef PK
}
__device__ __forceinline__ void pv_d0(f32x16* o, int vb, bf16x8 pa0, bf16x8 pa1, bf16x8 pa2, bf16x8 pa3) { pv_one<0>(o[0], vb, pa0, pa1, pa2, pa3); pv_one<1>(o[1], vb, pa0, pa1, pa2, pa3); }

__device__ __forceinline__ void attn_unit(const bf16_t* __restrict__ Qb, const bf16_t* __restrict__ Kh, const bf16_t* __restrict__ Vh, bf16_t* __restrict__ Ob, int seq, float kmax, char* lds, const int wv) {
    const int lane = lane_id(), wid = wv, tid = wv * 64 + lane, r32 = lane & 31, hi = lane >> 5;
    char* V_lds = lds; char* K_lds = lds + 2 * SHM_V;
    float* li_l = (float*)(lds + 2 * SHM_V + 2 * SHM_K) + wid * 64;
    float l_reg = 0; f32x16 o[2] = {}; bf16x8 qr[6];
    const bf16_t* Qw = Qb + (long)(wid * QBLK + r32) * LDQ + hi * 8;
    float qss = 0.f;
#pragma unroll
    for (int d0 = 0; d0 < 6; ++d0) { qr[d0] = *reinterpret_cast<const bf16x8*>(Qw + d0 * 16);
#pragma unroll
        for (int i = 0; i < 8; ++i) { const float f = bf2f((unsigned short)qr[d0][i]); qss += f * f; } }
    { auto rr = __builtin_amdgcn_permlane32_swap(__float_as_uint(qss), __float_as_uint(qss), false, false); qss = __uint_as_float(rr[0]) + __uint_as_float(rr[1]); }
    float mrow = sqrtf(qss) * kmax;
    if (__all(mrow < 64.f)) mrow = 0.f;
    const int kc1 = tid, kc2 = 512 + (tid & 255); const int kr1 = kc1 / 12, kp1 = kc1 % 12, kr2 = kc2 / 12, kp2 = kc2 % 12; const int vr = tid >> 3, vp = tid & 7;
    const int kst1 = KSWZ(kr1, kp1 * 16), kst2 = KSWZ(kr2, kp2 * 16), vst = v_st(vr, vp * 8);
    const int vb0 = (int)(uintptr_t)V_lds + v_rd_base(lane);
    struct { bf16x8 k1, k2, v; } sr_[2];
#define SLOAD(i, k0) do { sr_[i].k1 = *reinterpret_cast<const bf16x8*>(&Kh[(long)((k0) + kr1) * LDK + kp1 * 8]); if (wv < 4) sr_[i].k2 = *reinterpret_cast<const bf16x8*>(&Kh[(long)((k0) + kr2) * LDK + kp2 * 8]); \
    sr_[i].v = *reinterpret_cast<const bf16x8*>(&Vh[(long)((k0) + vr) * LDV + vp * 8]); } while (0)
#define SWRITE(b, i) do { *(bf16x8*)(K_lds + (b) * SHM_K + kst1) = sr_[i].k1; if (wv < 4) *(bf16x8*)(K_lds + (b) * SHM_K + kst2) = sr_[i].k2; *(bf16x8*)(V_lds + (b) * SHM_V + vst) = sr_[i].v; } while (0)
#define SWAIT() do { if (wv < 4) asm volatile("s_waitcnt vmcnt(3)" ::: "memory"); else asm volatile("s_waitcnt vmcnt(2)" ::: "memory"); } while (0)
    f32x16 pA0, pA1, pB0, pB1; bf16x8 pa0, pa1, pa2, pa3; const int NT = seq / KVBLK;
    constexpr int SE = 0, SO = 1;
    SLOAD(SE, 0); asm volatile("s_waitcnt vmcnt(0)" ::: "memory"); SWRITE(0, SE); __syncthreads();
    qkt(pA0, pA1, K_lds, qr, mrow, r32, hi); expA(pA0);
    SLOAD(SO, KVBLK); if (2 < NT) SLOAD(SE, 2 * KVBLK);
    SWAIT(); SWRITE(1, SO); __syncthreads();
    for (int j = 1; j + 1 < NT; j += 2) {
        SBAR(); qkt(pB0, pB1, K_lds + SHM_K, qr, mrow, r32, hi);
        finishSM(pA0, pA1, l_reg, pa0, pa1, pa2, pa3); SBAR();
        SLOAD(SO, (j + 2) * KVBLK); SBAR();
        pv_d0(o, vb0, pa0, pa1, pa2, pa3); expA(pB0);
        __syncthreads(); SWAIT(); SWRITE(0, SE);
        __syncthreads();
        SBAR(); qkt(pA0, pA1, K_lds, qr, mrow, r32, hi);
        finishSM(pB0, pB1, l_reg, pa0, pa1, pa2, pa3); SBAR();
        if (j + 3 < NT) SLOAD(SE, (j + 3) * KVBLK); SBAR();
        pv_d0(o, vb0 + SHM_V, pa0, pa1, pa2, pa3); expA(pA0);
        __syncthreads(); if (j + 3 < NT) SWAIT(); else asm volatile("s_waitcnt vmcnt(0)" ::: "memory"); SWRITE(1, SO);
        __syncthreads();
    }
    SBAR(); qkt(pB0, pB1, K_lds + SHM_K, qr, mrow, r32, hi);
    finishSM(pA0, pA1, l_reg, pa0, pa1, pa2, pa3); SBAR();
    pv_d0(o, vb0, pa0, pa1, pa2, pa3); expA(pB0);
    __syncthreads();
    finishSM(pB0, pB1, l_reg, pa0, pa1, pa2, pa3); SBAR();
    pv_d0(o, vb0 + SHM_V, pa0, pa1, pa2, pa3);
    { auto rr = __builtin_amdgcn_permlane32_swap(__float_as_uint(l_reg), __float_as_uint(l_reg), false, false); l_reg = __uint_as_float(rr[0]) + __uint_as_float(rr[1]); }
    if (hi == 0) li_l[r32] = l_reg; asm volatile("s_waitcnt lgkmcnt(0)" ::: "memory");
    float rli[16];
#pragma unroll
    for (int r = 0; r < 16; ++r) rli[r] = __builtin_amdgcn_rcpf(li_l[crow(r, hi)]);
    bf16_t* Ow = Ob + (long)(wid * QBLK) * LDO;
#pragma unroll
    for (int r = 0; r < 16; ++r) { const int orow = crow(r, hi);
#pragma unroll
        for (int d0 = 0; d0 < 2; ++d0) Ow[(long)orow * LDO + d0 * 32 + r32] = (bf16_t)(cvtpk(o[d0][r] * rli[r], 0.f) & 0xffffu); }
    __syncthreads();
#undef SLOAD
#undef SWRITE
#undef SWAIT
}
}

namespace hg {
constexpr int QP = 136, TP = 68;
constexpr int OFF_QIN = 0, OFF_KIN = 64 * QP * 2, OFF_KINT = 2 * 64 * QP * 2, OFF_VT = OFF_KINT + 128 * TP * 2, OFF_TOT1 = OFF_VT + 128 * TP * 2, OFF_FAC = OFF_TOT1 + 1024, HALF_BYTES = OFF_FAC + 512;
static_assert(2 * HALF_BYTES <= LDS_CTL, "HGRN LDS");
__device__ __forceinline__ bf16x8 ld2x4(const LAS char* p0, const LAS char* p1) { const s16x4 a = *(const LAS s16x4*)p0, b = *(const LAS s16x4*)p1; return (bf16x8){a[0], a[1], a[2], a[3], b[0], b[1], b[2], b[3]}; }
__device__ __forceinline__ bf16x8 packf8(const f32x16& a, int base) { u32x4 w; w.x = cvtpk(a[base], a[base + 1]); w.y = cvtpk(a[base + 2], a[base + 3]); w.z = cvtpk(a[base + 4], a[base + 5]); w.w = cvtpk(a[base + 6], a[base + 7]); return __builtin_bit_cast(bf16x8, w); }
__device__ __forceinline__ void unit(LAS char* lds, int seqbase, int S, int h, const bf16_t* __restrict__ HQp, const bf16_t* __restrict__ HIp, const _Float16* __restrict__ GFp, const _Float16* __restrict__ GBp, bf16_t* OFWp, bf16_t* OBWp, const int wv) {
    const int lane = lane_id(), tid = wv * 64 + lane, bwd = wv >> 2, ht = tid & 255, w = wv & 3, r32 = lane & 31, hi = lane >> 5;
    LAS char* base = lds + bwd * HALF_BYTES;
    LAS char* QIN = base + OFF_QIN; LAS char* KINT = base + OFF_KINT; LAS char* VT = base + OFF_VT; LAS float* TOT1 = (LAS float*)(base + OFF_TOT1); LAS float* FAC = (LAS float*)(base + OFF_FAC);
    const _Float16* G = bwd ? GBp : GFp; bf16_t* O = bwd ? OBWp : OFWp;
    const int nc = S / 64, part = ht >> 7, d = ht & 127, e0 = 32 * w;
    f32x16 Sacc[4] = {};
    if (part == 1) { TOT1[d] = 0.f; TOT1[128 + d] = 0.f; }
    u32x4 rg[4], rq[4], rv[4];
    const int trb = ht >> 4, c8 = (ht & 15) * 8, tv = (ht >> 2) & 63, ev = (ht & 3) * 8;
    const long jstep = bwd ? -16 * 512 : 16 * 512;
    const size_t gq_off = (size_t)(bwd ? 63 - trb : trb) * 512 + h * 128 + c8, v_off = (size_t)(bwd ? 63 - tv : tv) * 512 + h * 128 + ev;
#define HG_LOADRAW(c) do { const size_t cb_ = (size_t)(seqbase + (bwd ? (nc - 1 - (c)) * 64 : (c) * 64)) * 512 + gq_off; \
    _Pragma("unroll") for (int j = 0; j < 4; ++j) { rg[j] = *(const u32x4*)(G + cb_ + j * jstep); rq[j] = *(const u32x4*)(HQp + cb_ + j * jstep); } } while (0)
#define HG_LOADV(c) do { const size_t cb_ = (size_t)(seqbase + (bwd ? (nc - 1 - (c)) * 64 : (c) * 64)) * 512 + v_off; \
    _Pragma("unroll") for (int j = 0; j < 4; ++j) rv[j] = *(const u32x4*)(HIp + cb_ + 32 * j); } while (0)
    HG_LOADRAW(0); HG_LOADV(0);
    for (int c = 0; c < nc; ++c) {
        const int c0 = seqbase + (bwd ? (nc - 1 - c) * 64 : c * 64);
        LAS char* wq = QIN + (trb * QP + c8) * 2; LAS char* wvt = VT + (ev * TP + tv) * 2; LAS char* colb = QIN + d * 2; LAS char* ktb = KINT + d * TP * 2;
        asm volatile("" : "+v"(wq), "+v"(wvt), "+v"(colb), "+v"(ktb));
#pragma unroll
        for (int j = 0; j < 4; ++j) { *(LAS u32x4*)(wq + j * 16 * QP * 2) = rq[j]; *(LAS u32x4*)(wq + (OFF_KIN - OFF_QIN) + j * 16 * QP * 2) = rg[j]; }
#pragma unroll
        for (int j = 0; j < 4; ++j) { const unsigned vv[4] = {rv[j].x, rv[j].y, rv[j].z, rv[j].w};
#pragma unroll
            for (int i = 0; i < 4; ++i) { *(LAS bf16_t*)(wvt + (32 * j + 2 * i) * TP * 2) = (bf16_t)(vv[i] & 0xffffu); *(LAS bf16_t*)(wvt + (32 * j + 2 * i + 1) * TP * 2) = (bf16_t)(vv[i] >> 16); } }
        __syncthreads();
        if (c + 1 < nc) { HG_LOADRAW(c + 1); HG_LOADV(c + 1); }
        constexpr int KO = OFF_KIN - OFF_QIN;
        if (part == 0) {
            float E1 = 1.f, E2 = 1.f, tot = 0.f;
#pragma unroll 4
            for (int tp = 15; tp >= 0; --tp) { unsigned kpk[2];
#pragma unroll
                for (int s2 = 1; s2 >= 0; --s2) { const int tt = 2 * tp + s2;
                    const float g = (float)*(const LAS _Float16*)(colb + KO + tt * QP * 2), q = bf2f(*(const LAS bf16_t*)(colb + tt * QP * 2));
                    const float f = __expf(g), rf = __expf(-g);
                    const unsigned pq = cvtpk(q * E1, (1.f - f) * E2);
                    *(LAS bf16_t*)(colb + tt * QP * 2) = (bf16_t)(pq & 0xffffu); *(LAS bf16_t*)(colb + KO + tt * QP * 2) = (bf16_t)(pq >> 16); kpk[s2] = pq >> 16;
                    E1 *= rf; E2 *= f; tot += g; }
                *(LAS unsigned*)(ktb + 4 * tp) = kpk[0] | (kpk[1] << 16); }
            FAC[d] = __expf(tot + TOT1[((c + 1) & 1) * 128 + d]);
        } else {
            float E1 = 1.f, E2 = 1.f, tot = 0.f;
#pragma unroll 4
            for (int tp = 16; tp < 32; ++tp) { unsigned kpk[2];
#pragma unroll
                for (int s2 = 0; s2 < 2; ++s2) { const int tt = 2 * tp + s2;
                    const float g = (float)*(const LAS _Float16*)(colb + KO + tt * QP * 2), q = bf2f(*(const LAS bf16_t*)(colb + tt * QP * 2));
                    const float f = __expf(g), rf = __expf(-g);
                    E1 *= f; E2 *= rf; tot += g;
                    const unsigned pq = cvtpk(q * E1, (1.f - f) * E2);
                    *(LAS bf16_t*)(colb + tt * QP * 2) = (bf16_t)(pq & 0xffffu); *(LAS bf16_t*)(colb + KO + tt * QP * 2) = (bf16_t)(pq >> 16); kpk[s2] = pq >> 16; }
                *(LAS unsigned*)(ktb + 4 * tp) = kpk[0] | (kpk[1] << 16); }
            TOT1[(c & 1) * 128 + d] = tot;
        }
        __syncthreads();
        {
            const LAS char* bq16 = QIN + r32 * QP * 2 + 16 * hi; const LAS char* bq8 = QIN + r32 * QP * 2 + 8 * hi;
            const LAS char* bv16 = VT + (e0 + r32) * TP * 2 + 16 * hi; const LAS char* bv8 = VT + (e0 + r32) * TP * 2 + 8 * hi;
            const LAS char* bk16 = KINT + r32 * TP * 2 + 16 * hi; const LAS float* bfac = FAC + 4 * hi; int thr = r32 - 4 * hi;
            asm volatile("" : "+v"(bq16), "+v"(bq8), "+v"(bv16), "+v"(bv8), "+v"(bk16), "+v"(bfac), "+v"(thr));
            constexpr int KOFF = OFF_KIN - OFF_QIN, R32 = 32 * QP * 2;
#pragma unroll
            for (int db = 0; db < 4; ++db)
#pragma unroll
                for (int r4 = 0; r4 < 4; ++r4) { const f32x4 fc = *(const LAS f32x4*)(bfac + 32 * db + 8 * r4); Sacc[db][4 * r4] *= fc.x; Sacc[db][4 * r4 + 1] *= fc.y; Sacc[db][4 * r4 + 2] *= fc.z; Sacc[db][4 * r4 + 3] *= fc.w; }
            f32x16 o0 = {}, o1 = {};
#pragma unroll
            for (int kk = 0; kk < 8; ++kk) { const bf16x8 sf = packf8(Sacc[kk >> 1], 8 * (kk & 1));
                const bf16x8 b0 = ld2x4(bq8 + 32 * kk, bq8 + 32 * kk + 16), b1 = ld2x4(bq8 + R32 + 32 * kk, bq8 + R32 + 32 * kk + 16);
                o0 = __builtin_amdgcn_mfma_f32_32x32x16_bf16(sf, b0, o0, 0, 0, 0);
                o1 = __builtin_amdgcn_mfma_f32_32x32x16_bf16(sf, b1, o1, 0, 0, 0); if (kk & 1) SBAR(); }
            SBAR();
            {
                f32x16 p = {};
#pragma unroll
                for (int kk = 0; kk < 8; ++kk)
                    { p = __builtin_amdgcn_mfma_f32_32x32x16_bf16(*(const LAS bf16x8*)(bq16 + KOFF + 32 * kk), *(const LAS bf16x8*)(bq16 + 32 * kk), p, 0, 0, 0); if ((kk & 3) == 3) SBAR(); }
#pragma unroll
                for (int r = 0; r < 16; ++r) { if ((r & 3) + 8 * (r >> 2) > thr) p[r] = 0.f; }
#pragma unroll
                for (int k2 = 0; k2 < 2; ++k2) o0 = __builtin_amdgcn_mfma_f32_32x32x16_bf16(ld2x4(bv8 + 32 * k2, bv8 + 32 * k2 + 16), packf8(p, 8 * k2), o0, 0, 0, 0);
            }
            SBAR();
            {
                f32x16 p = {};
#pragma unroll
                for (int kk = 0; kk < 8; ++kk)
                    { p = __builtin_amdgcn_mfma_f32_32x32x16_bf16(*(const LAS bf16x8*)(bq16 + KOFF + 32 * kk), *(const LAS bf16x8*)(bq16 + R32 + 32 * kk), p, 0, 0, 0); if ((kk & 3) == 3) SBAR(); }
#pragma unroll
                for (int k2 = 0; k2 < 2; ++k2) o1 = __builtin_amdgcn_mfma_f32_32x32x16_bf16(ld2x4(bv8 + 32 * k2, bv8 + 32 * k2 + 16), packf8(p, 8 * k2), o1, 0, 0, 0);
            }
            SBAR();
            {
                f32x16 p = {};
#pragma unroll
                for (int kk = 0; kk < 8; ++kk)
                    { p = __builtin_amdgcn_mfma_f32_32x32x16_bf16(*(const LAS bf16x8*)(bq16 + KOFF + R32 + 32 * kk), *(const LAS bf16x8*)(bq16 + R32 + 32 * kk), p, 0, 0, 0); if ((kk & 3) == 3) SBAR(); }
#pragma unroll
                for (int r = 0; r < 16; ++r) { if ((r & 3) + 8 * (r >> 2) > thr) p[r] = 0.f; }
#pragma unroll
                for (int k2 = 0; k2 < 2; ++k2) o1 = __builtin_amdgcn_mfma_f32_32x32x16_bf16(ld2x4(bv8 + 64 + 32 * k2, bv8 + 64 + 32 * k2 + 16), packf8(p, 8 * k2), o1, 0, 0, 0);
            }
            SBAR();
#pragma unroll
            for (int kk = 0; kk < 4; ++kk) { const bf16x8 vfr = ld2x4(bv16 + 32 * kk, bv16 + 32 * kk + 8);
#pragma unroll
                for (int db = 0; db < 4; ++db) { const LAS char* kp = bk16 + 32 * db * TP * 2 + 32 * kk; Sacc[db] = __builtin_amdgcn_mfma_f32_32x32x16_bf16(ld2x4(kp, kp + 8), vfr, Sacc[db], 0, 0, 0); } SBAR(); }
            SBAR();
#pragma unroll
            for (int tb = 0; tb < 2; ++tb) { const int tt = 32 * tb + r32, row = c0 + (bwd ? 63 - tt : tt); bf16_t* op = O + (size_t)row * 512 + h * 128 + e0 + 16 * hi;
                const f32x16& oo = tb ? o1 : o0; unsigned dq[4][2];
#pragma unroll
                for (int r4 = 0; r4 < 4; ++r4) { dq[r4][0] = cvtpk(oo[4 * r4], oo[4 * r4 + 1]); dq[r4][1] = cvtpk(oo[4 * r4 + 2], oo[4 * r4 + 3]); }
                const auto s00 = __builtin_amdgcn_permlane32_swap(dq[0][0], dq[2][0], false, false), s01 = __builtin_amdgcn_permlane32_swap(dq[0][1], dq[2][1], false, false);
                const auto s10 = __builtin_amdgcn_permlane32_swap(dq[1][0], dq[3][0], false, false), s11 = __builtin_amdgcn_permlane32_swap(dq[1][1], dq[3][1], false, false);
                *(u32x4*)(op) = (u32x4){s00[0], s01[0], s00[1], s01[1]}; *(u32x4*)(op + 8) = (u32x4){s10[0], s11[0], s10[1], s11[1]}; }
        }
        __syncthreads();
    }
#undef HG_LOADRAW
#undef HG_LOADV
}
}

__device__ __forceinline__ float wave_sum(float v) {
#pragma unroll
    for (int o = 1; o < 64; o <<= 1) v += __shfl_xor(v, o);
    return v;
}
__device__ __forceinline__ void transpose_item(const float* W, int K, int N, int k0, int n0, bf16_t* WT, int dst0, const float* kscale, LAS float* scr, int lane) {
#pragma unroll 8
    for (int i = 0; i < 32; ++i) { const int kk = 2 * i + (lane >> 5); float v = W[(size_t)(k0 + kk) * N + n0 + (lane & 31)]; if (kscale) v *= kscale[k0 + kk]; scr[kk * 33 + (lane & 31)] = v; }
    asm volatile("s_waitcnt lgkmcnt(0)" ::: "memory");
    const int c = lane & 7;
#pragma unroll
    for (int j = 0; j < 4; ++j) { const int n = (lane >> 3) + 8 * j; const LAS float* s = scr + (8 * c) * 33 + n;
        u32x4 o; o.x = cvtpk(s[0 * 33], s[1 * 33]); o.y = cvtpk(s[2 * 33], s[3 * 33]); o.z = cvtpk(s[4 * 33], s[5 * 33]); o.w = cvtpk(s[6 * 33], s[7 * 33]);
        *(u32x4*)(WT + (size_t)(dst0 + n) * K + k0 + 8 * c) = o; }
    asm volatile("s_waitcnt lgkmcnt(0)" ::: "memory");
}

#define XB_TMO      128
#define XB_XCNT(j)  (256  + 64 * (j))
#define XB_XSUB(j)  (1280 + 64 * (j))
#define XB_XGEN(j)  (2304 + 64 * (j))
#define XB_TOP      3328
#define XB_TOPGEN   3392
#define XB_SPIN_CAP (1u << 22)
__device__ __forceinline__ unsigned xb_ld(unsigned* p)              { return __hip_atomic_load(p, __ATOMIC_RELAXED, __HIP_MEMORY_SCOPE_AGENT); }
__device__ __forceinline__ unsigned xb_add(unsigned* p, unsigned v) { return __hip_atomic_fetch_add(p, v, __ATOMIC_RELAXED, __HIP_MEMORY_SCOPE_AGENT); }
__device__ __forceinline__ unsigned xb_xcc_id() { return (unsigned)__builtin_amdgcn_s_getreg((3 << 11) | 20) & 0xFu; }
#define XB_SPIN(cond, bar) do { unsigned _sp = 0; while (cond) { __builtin_amdgcn_s_sleep(1); \
    if ((++_sp & 255u) == 0u) { if (xb_ld(&(bar)[XB_TMO])) break; if (_sp > XB_SPIN_CAP) { atomicAdd(&(bar)[XB_TMO], 1u); break; } } } } while (0)
__device__ __forceinline__ void xcd_barrier_complete(unsigned* bar, unsigned x, unsigned& nloc, unsigned& nx) {
    const unsigned G = gridDim.x;
    unsigned sum, cnt, mine, sp = 0u;
    for (;;) {
        sum = 0u; cnt = 0u; mine = 0u;
#pragma unroll
        for (unsigned j = 0; j < 16; ++j) { const unsigned c = xb_ld(&bar[XB_XCNT(j)]); sum += c; cnt += (c > 0u) ? 1u : 0u; mine = (j == x) ? c : mine; }
        if (sum == G) break;
        __builtin_amdgcn_s_sleep(1);
        if ((++sp & 255u) == 0u) { if (xb_ld(&bar[XB_TMO])) break; if (sp > XB_SPIN_CAP) { atomicAdd(&bar[XB_TMO], 1u); break; } }
    }
    nloc = mine > 0u ? mine : 1u; nx = cnt > 0u ? cnt : 1u;
}
__device__ __forceinline__ void grid_barrier(unsigned* bar, const int wv, volatile LAS unsigned* st) {
    asm volatile("s_waitcnt vmcnt(0)" ::: "memory");
    __syncthreads();
    if (wv == 0 && lane_id() == 0) {
        const unsigned x = xb_xcc_id();
        __builtin_amdgcn_s_waitcnt(0);
        unsigned nloc = st[0], nx = st[1];
        if (nloc == 0u) { xcd_barrier_complete(bar, x, nloc, nx); st[0] = nloc; st[1] = nx; }
        const unsigned old = xb_add(&bar[XB_XSUB(x)], 1u);
        const unsigned gen = old / nloc;
        if (old + 1u == (gen + 1u) * nloc) {
            __builtin_amdgcn_fence(__ATOMIC_RELEASE, "agent");
            asm volatile("s_waitcnt vmcnt(0)" ::: "memory");
            const unsigned og = xb_add(&bar[XB_TOP], 1u);
            const unsigned tg = og / nx;
            if (og + 1u == (tg + 1u) * nx) xb_add(&bar[XB_TOPGEN], 1u);
            else XB_SPIN(xb_ld(&bar[XB_TOPGEN]) == tg, bar);
            __builtin_amdgcn_fence(__ATOMIC_ACQUIRE, "agent");
            xb_add(&bar[XB_XGEN(x)], 1u);
            asm volatile("s_waitcnt vmcnt(0)" ::: "memory");
        } else {
            XB_SPIN(xb_ld(&bar[XB_XGEN(x)]) == gen, bar);
            __builtin_amdgcn_fence(__ATOMIC_ACQUIRE, "agent");
            asm volatile("s_waitcnt vmcnt(0)" ::: "memory");
        }
    }
    __syncthreads();
}
#define WinT ((bf16_t*)(ws + WS_WIN))
#define WuqT ((bf16_t*)(ws + WS_WUQ))
#define WukvT ((bf16_t*)(ws + WS_WUKV))
#define Wb0T ((bf16_t*)(ws + WS_WB0))
#define Wb1T ((bf16_t*)(ws + WS_WB1))
#define WoT ((bf16_t*)(ws + WS_WO))
#define WguT ((bf16_t*)(ws + WS_WGU))
#define WdT ((bf16_t*)(ws + WS_WD))
#define XN ((bf16_t*)(ws + WS_XN))
#define HQ ((bf16_t*)(ws + WS_HQ))
#define HI ((bf16_t*)(ws + WS_HI))
#define GF ((_Float16*)(ws + WS_GF))
#define GB ((_Float16*)(ws + WS_GB))
#define SG ((bf16_t*)(ws + WS_SG))
#define LAT ((bf16_t*)(ws + WS_LAT))
#define Qm ((bf16_t*)(ws + WS_Q))
#define Km ((bf16_t*)(ws + WS_K))
#define Vm ((bf16_t*)(ws + WS_V))
#define OM ((bf16_t*)(ws + WS_OM))
#define OFW ((bf16_t*)(ws + WS_OFW))
#define OBW ((bf16_t*)(ws + WS_OBW))
#define OH ((bf16_t*)(ws + WS_OH))
#define MERGED ((bf16_t*)(ws + WS_MERGED))
#define X1 ((float*)(ws + WS_X1))
#define X1B ((bf16_t*)(ws + WS_X1B))
#define ACT ((bf16_t*)(ws + WS_ACT))
#define GATES ((bf16_t*)a.out)
#define RSQ ((float*)(ws + WS_RSQ))
#define RSKV ((float*)(ws + WS_RSKV))
#define RSX1 ((float*)(ws + WS_RSX1))
#define RSX2 ((float*)(ws + WS_RSX2))
#define ROPE ((f32x2*)(ws + WS_ROPE))
#define QUEUE ((unsigned*)(ws + WS_QUEUE))
__global__ void __launch_bounds__(512, 2) fwd_megakernel(Args a) {
    extern __shared__ __attribute__((aligned(16))) unsigned char lds[];
    const int G = gridDim.x, bx = blockIdx.x;
    const int wv = __builtin_amdgcn_readfirstlane((int)threadIdx.x >> 6);
#define TIDS const int lane = lane_id(), wave = wv, tid = wv * 64 + lane; (void)tid;
    unsigned char* ws = a.ws;
    LAS unsigned char* ldsl = (LAS unsigned char*)lds;
    const int lo = a.ph_lo, hi_ = a.ph_hi;
#ifndef PHMASK
#define PHMASK 0x3ff
#endif
#define IN(k) (((PHMASK >> (k)) & 1) && lo <= (k) && (k) < hi_)
#define STAMP(k) do { if (PROBE_SEL && bx == 0 && wv == 0 && lane_id() == 0) ((unsigned long long*)(ws + WS_TS))[k] = __builtin_amdgcn_s_memrealtime(); } while (0)
#define SEAM(k) do { if (IN(k) && IN((k) + 1)) { if ((k) == 0) cg::this_grid().sync(); else grid_barrier((unsigned*)(ws + WS_XBAR), wv, (volatile LAS unsigned*)(ldsl + LDS_CTL + 32)); } } while (0)

    if (PROBE_SEL && bx == 0 && wv == 0 && lane_id() == 0) { for (int i = 1; i < 32; ++i) ((unsigned long long*)(ws + WS_TS))[i] = 0ull; }
    STAMP(0);
    if (IN(0)) { TIDS
        LAS float* scr = (LAS float*)(ldsl + wave * 16384);
        const int gw = bx * 8 + wave, NGW = G * 8;
        constexpr int I_IN = 16 * 161, I_UQ = 4 * 24, I_UKV = 4 * 32, I_B = 8 * 32, I_O = 16 * 32, I_GU = 16 * 176, I_D = 44 * 32;
        constexpr int NITEMS = I_IN + I_UQ + I_UKV + 2 * I_B + I_O + I_GU + I_D;
        for (int it = gw; it < NITEMS; it += NGW) {
            int r = it;
            if (r < I_IN) { const int kb = r / 161, nb = r % 161; const int dst = nb < 96 ? 32 * nb : (nb == 96 ? 5120 : 3072 + 32 * (nb - 97)); transpose_item(a.w_in, 1024, 5152, 64 * kb, 32 * nb, WinT, dst, nullptr, scr, lane); continue; } r -= I_IN;
            if (r < I_UQ) { const int kb = r / 24, nb = r % 24, h = nb / 3, p = nb % 3; const int dst = p < 2 ? h * 64 + 32 * p : 512 + 32 * h; transpose_item(a.w_uq, 256, 768, 64 * kb, 32 * nb, WuqT, dst, a.g_qa, scr, lane); continue; } r -= I_UQ;
            if (r < I_UKV) { const int kb = r / 32, nb = r % 32; transpose_item(a.w_ukv, 256, 1024, 64 * kb, 32 * nb, WukvT, 32 * nb, a.g_kva, scr, lane); continue; } r -= I_UKV;
            if (r < I_B) { const int kb = r / 32, nb = r % 32; transpose_item(a.w_branch, 512, 1024, 64 * kb, 32 * nb, Wb0T, 32 * nb, nullptr, scr, lane); continue; } r -= I_B;
            if (r < I_B) { const int kb = r / 32, nb = r % 32; transpose_item(a.w_branch + 512 * 1024, 512, 1024, 64 * kb, 32 * nb, Wb1T, 32 * nb, nullptr, scr, lane); continue; } r -= I_B;
            if (r < I_O) { const int kb = r / 32, nb = r % 32; transpose_item(a.w_out, 1024, 1024, 64 * kb, 32 * nb, WoT, 32 * nb, nullptr, scr, lane); continue; } r -= I_O;
            if (r < I_GU) { const int kb = r / 176, nb = r % 176; const int col = 32 * nb; const int j = col < DFF ? col : col - DFF; const int dst = 256 * (j / 128) + (col < DFF ? 0 : 128) + (j % 128);
                transpose_item(a.w_gate_up, 1024, 5632, 64 * kb, col, WguT, dst, a.g_ffn, scr, lane); continue; } r -= I_GU;
            { const int kb = r / 32, nb = r % 32; transpose_item(a.w_down, DFF, 1024, 64 * kb, 32 * nb, WdT, 32 * nb, nullptr, scr, lane); }
        }
        for (int m = gw; m < M; m += NGW) {
            const f32x4* xr = (const f32x4*)xrow_ptr(a.x_prompt, a.x_sample, m) + lane; f32x4 v[4]; float s = 0.f;
#pragma unroll
            for (int j = 0; j < 4; ++j) { v[j] = xr[64 * j]; s += (v[j].x * v[j].x + v[j].y * v[j].y) + (v[j].z * v[j].z + v[j].w * v[j].w); }
            const float rstd = __builtin_amdgcn_rsqf(wave_sum(s) * (1.f / 1024.f) + EPS);
            u32x2* o8 = (u32x2*)(XN + (size_t)m * 1024) + lane;
#pragma unroll
            for (int j = 0; j < 4; ++j) { const f32x4 g = ((const f32x4*)a.g_mix)[64 * j + lane]; u32x2 w; w.x = cvtpk(v[j].x * rstd * g.x, v[j].y * rstd * g.y); w.y = cvtpk(v[j].z * rstd * g.z, v[j].w * rstd * g.w); o8[64 * j] = w; }
        }
        for (int i = bx * 512 + tid; i < (int)(CTL_ZERO / 16); i += G * 512) { if (PROBE_SEL && i >= (int)(WS_TS / 16) && i < (int)(WS_TS / 16) + 16) continue; ((u32x4*)ws)[i] = (u32x4){0u, 0u, 0u, 0u}; }
        for (int i = bx * 512 + tid; i < 16384 * 16; i += G * 512) { const int pos = i >> 4, j = i & 15; const double rev = (double)pos * a.inv_rev[j]; const float fr_ = (float)(rev - floor(rev));
            ROPE[i] = (f32x2){__builtin_amdgcn_cosf(fr_), __builtin_amdgcn_sinf(fr_)}; }
    }
    SEAM(0); STAMP(1);
    {
        volatile LAS unsigned* st = (volatile LAS unsigned*)(ldsl + LDS_CTL + 32);
        if (wv == 0 && lane_id() == 0) { st[0] = 0u; st[1] = 0u; (void)xb_add((unsigned*)(ws + WS_XBAR) + XB_XCNT(xb_xcc_id()), 1u); }
        __syncthreads();
    }
    if (IN(1)) {
        SchedSimple S{(const char*)XN, (const char*)WinT, 256, 21, G, bx, (size_t)256 * 1024 * 2, (size_t)256 * 1024 * 2};
        EpiIn E{ws, GATES, a.lb_param};
        pg8::gemm_phase(wv, ldsl, 1024, 1024, S, E);
    }
    SEAM(1); STAMP(2);
    if (IN(2)) {
        SchedUp S{(const char*)LAT, (const char*)WuqT, (const char*)WukvT, G, bx};
        EpiUp E{Qm, Km, Vm, RSQ, RSKV, ROPE, (unsigned*)(ws + WS_KMAX)};
        pg8::gemm_phase(wv, ldsl, 256, 512, S, E);
    }
    SEAM(2); STAMP(3);
    if (IN(3)) { TIDS
        volatile LAS unsigned* ctl = (volatile LAS unsigned*)(ldsl + LDS_CTL);
        int did_hg = 0;
        for (int qk = 0; qk < 8; ++qk) {
            const int xq = (bx + qk) & 7;
            for (;;) {
                __syncthreads();
                if (tid == 0) ctl[0] = atomicAdd(QUEUE + xq * 64 + 32, 1u);
                __syncthreads();
                const int un = (int)ctl[0];
                if (un >= 3) break;
                int seqbase, S, h;
                if (un == 0) { seqbase = T0 + (xq >> 2) * 16384; S = 16384; h = xq & 3; }
                else { const int idx = 2 * xq + (un - 1); seqbase = (idx >> 2) * 8192; S = 8192; h = idx & 3; }
                hg::unit((LAS char*)ldsl, seqbase, S, h, HQ, HI, GF, GB, OFW, OBW, wv); did_hg = 1;
            }
        }
        if (PROBE_SEL && wv == 0 && lane_id() == 0) atomicMax((unsigned long long*)(ws + WS_TS) + 16, (unsigned long long)__builtin_amdgcn_s_memrealtime());
        for (int qk = 0; qk < 8; ++qk) {
            const int xq = (bx + qk) & 7;
            for (;;) {
                __syncthreads();
                if (tid == 0) ctl[0] = atomicAdd(QUEUE + xq * 64, 1u);
                __syncthreads();
                const int un = (int)ctl[0];
                if (un >= 256) break;
                int seqbase, S, h, qb;
                if (un < 128) { const int j = un, pair = 2 * xq + (j >> 6); seqbase = T0 + (pair >> 3) * 16384; S = 16384; h = pair & 7; qb = j & 63; }
                else { const int j = un - 128, pair = 4 * xq + (j >> 5); seqbase = (pair >> 3) * 8192; S = 8192; h = pair & 7; qb = j & 31; }
                const unsigned* km = (const unsigned*)(ws + WS_KMAX) + row_seq(seqbase) * 32 + h * 4;
                const float kmax = sqrtf(__uint_as_float(km[0]) + __uint_as_float(km[1]) + __uint_as_float(km[2])) * 1.01f;
                att::attn_unit(Qm + ((size_t)(seqbase + qb * 256) * 8 + h) * 96, Km + ((size_t)seqbase * 8 + h) * 96, Vm + ((size_t)seqbase * 8 + h) * 64, OM + (size_t)(seqbase + qb * 256) * 512 + h * 64, S, kmax, (char*)lds, wv);
            }
        }
        if (PROBE_SEL && !did_hg && wv == 0 && lane_id() == 0) atomicMax((unsigned long long*)(ws + WS_TS) + 17, (unsigned long long)__builtin_amdgcn_s_memrealtime());
    }
    SEAM(3); STAMP(4);
    if (IN(4)) { TIDS
        const int gw = bx * 8 + wave, NGW = G * 8;
        for (int m = gw; m < M; m += NGW) {
            const size_t off = (size_t)m * 512 + lane * 8;
            const u32x4 f = *(const u32x4*)(OFW + off), b = *(const u32x4*)(OBW + off), s = *(const u32x4*)(SG + off);
            const unsigned fu[4] = {f.x, f.y, f.z, f.w}, bu[4] = {b.x, b.y, b.z, b.w}, su[4] = {s.x, s.y, s.z, s.w};
            float o[8]; float ss = 0.f;
#pragma unroll
            for (int i = 0; i < 4; ++i) { o[2 * i] = bflo(fu[i]) + bflo(bu[i]); o[2 * i + 1] = bfhi(fu[i]) + bfhi(bu[i]); ss += o[2 * i] * o[2 * i] + o[2 * i + 1] * o[2 * i + 1]; }
            ss += __shfl_xor(ss, 1); ss += __shfl_xor(ss, 2); ss += __shfl_xor(ss, 4); ss += __shfl_xor(ss, 8);
            const float rstd = __builtin_amdgcn_rsqf(ss * (1.f / 128.f) + EPS);
            const f32x4 g0 = *(const f32x4*)(a.g_onorm + lane * 8), g1 = *(const f32x4*)(a.g_onorm + lane * 8 + 4); const float gg[8] = {g0.x, g0.y, g0.z, g0.w, g1.x, g1.y, g1.z, g1.w};
#pragma unroll
            for (int i = 0; i < 4; ++i) { o[2 * i] *= rstd * gg[2 * i] * bflo(su[i]); o[2 * i + 1] *= rstd * gg[2 * i + 1] * bfhi(su[i]); }
            *(u32x4*)(OH + off) = pack8(o);
        }
    }
    SEAM(4); STAMP(5);
    if (IN(5)) {
        SchedBranch S{(const char*)OH, (const char*)OM, (const char*)Wb0T, (const char*)Wb1T, G, bx};
        EpiBranch E{GATES, MERGED};
        pg8::gemm_phase(wv, ldsl, 512, 512, S, E);
    }
    SEAM(5); STAMP(6);
    if (IN(6)) {
        SchedSimple S{(const char*)MERGED, (const char*)WoT, 256, 4, G, bx, (size_t)256 * 1024 * 2, (size_t)256 * 1024 * 2};
        EpiOut E{a.x_prompt, a.x_sample, X1B, RSX1};
        pg8::gemm_phase(wv, ldsl, 1024, 1024, S, E);
    }
    SEAM(6); STAMP(7);
    if (IN(7)) {
        SchedSimple S{(const char*)X1B, (const char*)WguT, 256, 22, G, bx, (size_t)256 * 1024 * 2, (size_t)256 * 1024 * 2};
        EpiGU E{RSX1, ACT};
        pg8::gemm_phase(wv, ldsl, 1024, 1024, S, E);
    }
    SEAM(7); STAMP(8);
    if (PROBE_SEL) grid_barrier((unsigned*)(ws + WS_XBAR), wv, (volatile LAS unsigned*)(ldsl + LDS_CTL + 32));
    if (IN(8)) { TIDS
        SchedPanel S{(const char*)ACT, (const char*)WdT, G, bx, (size_t)256 * DFF * 2, (size_t)256 * DFF * 2};
        EpiDown E{X1B, a.out, RSX2};
        pg8::gemm_phase(wv, ldsl, DFF, DFF, S, E);
        asm volatile("s_waitcnt vmcnt(0)" ::: "memory");
        __builtin_amdgcn_fence(__ATOMIC_RELEASE, "workgroup"); __syncthreads();
        float pert = 0.f;
        if (PROBE_SEL) { const unsigned long long* ts = (const unsigned long long*)(ws + WS_TS); float tus = 0.f;
            if (PROBE_SEL == 1) tus = (float)(ts[4] - ts[3]) * 0.01f;
            if (PROBE_SEL == 2) tus = (float)(ts[16] - ts[3]) * 0.01f;
            if (PROBE_SEL == 3) tus = (float)(ts[17] - ts[3]) * 0.01f;
            if (PROBE_SEL == 4) tus = (float)((ts[1] - ts[0])) * 0.01f;
            if (PROBE_SEL == 5) tus = (float)((ts[5] - ts[4])) * 0.01f;
            if (PROBE_SEL == 6) tus = (float)((ts[8] - ts[0])) * 0.01f;
            if (PROBE_SEL == 8) tus = (float)((ts[2] - ts[1])) * 0.01f;
            if (PROBE_SEL == 9) tus = (float)((ts[8] - ts[7])) * 0.01f;
            pert = sqrtf(tus * 1e-9f); }
        for (int p = bx; p < 256; p += G)
            for (int r = wave; r < 256; r += 8) { const int m = p * 256 + r;
                const float rstd = __builtin_amdgcn_rsqf(__hip_atomic_load(RSX2 + m, __ATOMIC_RELAXED, __HIP_MEMORY_SCOPE_AGENT) * (1.f / 1024.f) + EPS);
                f32x4* yr = (f32x4*)(a.out + (size_t)m * 1024) + lane;
#pragma unroll
                for (int j = 0; j < 4; ++j) { const f32x4 g = ((const f32x4*)a.g_final)[64 * j + lane]; f32x4 v = yr[64 * j]; v.x = v.x * rstd * g.x + pert; v.y = v.y * rstd * g.y - pert; v.z = v.z * rstd * g.z + pert; v.w = v.w * rstd * g.w - pert; yr[64 * j] = v; }
            }
        if (PROBE_SEL == 7) {
            asm volatile("s_waitcnt vmcnt(0)" ::: "memory"); __syncthreads();
            unsigned long long* ts = (unsigned long long*)(ws + WS_TS);
            if (wv == 0 && lane == 0) { atomicMax(ts + 18, (unsigned long long)__builtin_amdgcn_s_memrealtime()); __threadfence(); atomicAdd((unsigned*)(ts + 19), 1u); }
            if (bx == 0) {
                if (wv == 0 && lane == 0) { while (__hip_atomic_load((unsigned*)(ts + 19), __ATOMIC_RELAXED, __HIP_MEMORY_SCOPE_AGENT) < (unsigned)G) __builtin_amdgcn_s_sleep(8); }
                __syncthreads();
                const unsigned long long tend = __hip_atomic_load(ts + 18, __ATOMIC_RELAXED, __HIP_MEMORY_SCOPE_AGENT), t0 = __hip_atomic_load(ts + 0, __ATOMIC_RELAXED, __HIP_MEMORY_SCOPE_AGENT);
                const float tus = (float)(tend - t0) * 0.01f; const float pe = sqrtf(tus * 256e-9f);
                for (int r = wave; r < 256; r += 8) { f32x4* yr = (f32x4*)(a.out + (size_t)r * 1024) + lane;
#pragma unroll
                    for (int j = 0; j < 4; ++j) { f32x4 v = yr[64 * j]; v.x += pe; v.y -= pe; v.z += pe; v.w -= pe; yr[64 * j] = v; } }
            }
        }
    }
#undef IN
#undef SEAM
}

extern "C" void kernel_launch(void* const* d_in, const int* in_sizes, int n_in, void* d_out, int out_size, void* d_ws, size_t ws_size, hipStream_t stream) {
    static int grid = 0;
    if (grid == 0) {
        if (n_in != 16 || out_size != M * DM || ws_size < WS_END) { fprintf(stderr, "kernel_launch: unexpected shapes: n_in %d out %d ws %zu (need %zu)\n", n_in, out_size, ws_size, (size_t)WS_END); grid = -1; return; }
        int dev = 0, cus = 0, per_cu = 0;
        if (hipGetDevice(&dev) != hipSuccess || hipDeviceGetAttribute(&cus, hipDeviceAttributeMultiprocessorCount, dev) != hipSuccess) { grid = -1; return; }
        if (hipFuncSetAttribute((const void*)fwd_megakernel, hipFuncAttributeMaxDynamicSharedMemorySize, LDS_BYTES) != hipSuccess) { fprintf(stderr, "kernel_launch: hipFuncSetAttribute failed\n"); grid = -1; return; }
        if (hipOccupancyMaxActiveBlocksPerMultiprocessor(&per_cu, (const void*)fwd_megakernel, 512, LDS_BYTES) != hipSuccess || per_cu < 1) { fprintf(stderr, "kernel_launch: occupancy query says %d\n", per_cu); per_cu = 1; }
        (void)hipGetLastError();
        grid = cus;
    }
    if (grid < 0) return;
    Args a{};
    a.x_prompt = (const float*)d_in[0]; a.x_sample = (const float*)d_in[1]; a.g_mix = (const float*)d_in[2]; a.w_in = (const float*)d_in[3]; a.lb_param = (const float*)d_in[4];
    a.g_onorm = (const float*)d_in[5]; a.g_qa = (const float*)d_in[6]; a.w_uq = (const float*)d_in[7]; a.g_kva = (const float*)d_in[8]; a.w_ukv = (const float*)d_in[9];
    a.w_branch = (const float*)d_in[10]; a.w_out = (const float*)d_in[11]; a.g_ffn = (const float*)d_in[12]; a.w_gate_up = (const float*)d_in[13]; a.w_down = (const float*)d_in[14]; a.g_final = (const float*)d_in[15];
    a.out = (float*)d_out; a.ws = (unsigned char*)d_ws;
    for (int i = 0; i < 16; ++i) a.inv_rev[i] = pow(10000.0, -(double)i / 16.0) / 6.283185307179586476925;
    a.ph_lo = 0; a.ph_hi = 9;
    void* args[] = {&a};
    const hipError_t e = hipLaunchCooperativeKernel((const void*)fwd_megakernel, dim3(grid), dim3(512), args, LDS_BYTES, stream);
    if (e != hipSuccess) fprintf(stderr, "kernel_launch: cooperative launch failed: %s (grid %d)\n", hipGetErrorString(e), grid);
}
```

```cpp
#include <hip/hip_runtime.h>
#include <hip/hip_cooperative_groups.h>
#include <hip/hip_bf16.h>
#include <cstdio>
#include <cstdint>
#include <cmath>
namespace cg = cooperative_groups;

#define LAS __attribute__((address_space(3)))
typedef unsigned short bf16_t;
typedef short bf16x8 __attribute__((ext_vector_type(8)));
typedef short s16x4 __attribute__((ext_vector_type(4)));
typedef float f32x4 __attribute__((ext_vector_type(4)));
typedef float f32x2 __attribute__((ext_vector_type(2)));
typedef float f32x16 __attribute__((ext_vector_type(16)));
typedef unsigned u32x4 __attribute__((ext_vector_type(4)));
typedef unsigned u32x2 __attribute__((ext_vector_type(2)));
typedef __bf16 bf16x2_t __attribute__((ext_vector_type(2)));
typedef _Float16 h16x8 __attribute__((ext_vector_type(8)));

constexpr int M = 65536, DM = 1024, T0 = 32768;
constexpr int NIN = 5376;
constexpr int DFF = 2816;
constexpr float EPS = 1e-6f;
constexpr float QSCALE = 0.10206207261596575f * 1.4426950408889634f;
constexpr size_t MiB = 1u << 20;
constexpr size_t WS_XBAR = 32768;
constexpr size_t WS_QUEUE = 0, WS_BAR = 4096, WS_TS = 8192, WS_KMAX = 16384;
#ifndef PROBE_SEL
#define PROBE_SEL 0
#endif
constexpr size_t WS_RSQ = 1 * MiB, WS_RSKV = WS_RSQ + 262144, WS_RSX1 = WS_RSKV + 262144, WS_RSX2 = WS_RSX1 + 262144;
constexpr size_t CTL_ZERO = 2 * MiB;
constexpr size_t WS_ROPE = 2 * MiB;
constexpr size_t WS_WIN = 4 * MiB, WS_WUQ = 15 * MiB, WS_WUKV = 15 * MiB + 512 * 1024, WS_WB0 = 16 * MiB, WS_WB1 = 17 * MiB, WS_WO = 18 * MiB, WS_WGU = 20 * MiB, WS_WD = 31 * MiB;
constexpr size_t WS_XN = 40 * MiB, WS_OFW = 40 * MiB, WS_OBW = 104 * MiB, WS_X1B = 40 * MiB;
constexpr size_t WS_HQ = 168 * MiB, WS_HI = 232 * MiB, WS_GF = 296 * MiB, WS_GB = 360 * MiB, WS_SG = 424 * MiB, WS_LAT = 488 * MiB;
constexpr size_t WS_Q = 552 * MiB, WS_K = 648 * MiB, WS_V = 744 * MiB, WS_OM = 808 * MiB;
constexpr size_t WS_OH = 168 * MiB, WS_MERGED = 232 * MiB, WS_X1 = 552 * MiB, WS_ACT = 168 * MiB;
constexpr size_t WS_END = 872 * MiB;
constexpr int LDS_BYTES = 155648;
constexpr int LDS_CTL = 155648 - 256;

__device__ __forceinline__ unsigned cvtpk(float lo, float hi) { f32x2 v = {lo, hi}; bf16x2_t b = __builtin_convertvector(v, bf16x2_t); return __builtin_bit_cast(unsigned, b); }
__device__ __forceinline__ float bf2f(unsigned short u) { return __builtin_bit_cast(float, (unsigned)u << 16); }
__device__ __forceinline__ float bflo(unsigned u) { return __builtin_bit_cast(float, u << 16); }
__device__ __forceinline__ float bfhi(unsigned u) { return __builtin_bit_cast(float, u & 0xffff0000u); }
__device__ __forceinline__ float sigmoidf_(float x) { return __builtin_amdgcn_rcpf(1.f + __expf(-x)); }
__device__ __forceinline__ float siluf_(float x) { return x * sigmoidf_(x); }
__device__ __forceinline__ u32x4 pack8(const float* v) { u32x4 w; w.x = cvtpk(v[0], v[1]); w.y = cvtpk(v[2], v[3]); w.z = cvtpk(v[4], v[5]); w.w = cvtpk(v[6], v[7]); return w; }
__device__ __forceinline__ int crow(int r, int hi) { return (r & 3) + 8 * (r >> 2) + 4 * hi; }
__device__ __forceinline__ const float* xrow_ptr(const float* xp, const float* xs, int row) { return row < T0 ? xp + (size_t)row * DM : xs + (size_t)(row - T0) * DM; }
__device__ __forceinline__ int row_seq(int row) { return row < T0 ? (row >> 13) : 4 + ((row - T0) >> 14); }
__device__ __forceinline__ int row_pos(int row) { return row < T0 ? (row & 8191) : (row & 16383); }
#define SBAR() __builtin_amdgcn_sched_barrier(0)
__device__ __forceinline__ int lane_id() { int l; asm volatile("v_mbcnt_lo_u32_b32 %0, -1, 0\n\tv_mbcnt_hi_u32_b32 %0, -1, %0" : "=v"(l)); return l; }

namespace pg8 {
constexpr int BM = 256, BK = 64, HALF = 128, HTB = HALF * BK * 2, STAGE_BYTES = 8 * HTB, NXCD = 8, WGM = 4;
__device__ __forceinline__ int lds_byte(int r, int c) { const int st = (r >> 4) * 2 + (c >> 5), rr = r & 15, cc = c & 31, ob = rr * 64 + cc * 2; return st * 1024 + (ob ^ (((ob >> 9) & 1) << 5)); }
__device__ __forceinline__ void stage_rc(int b, int& R, int& C) { const int st = b / 1024, sb = b % 1024, swz = sb ^ (((sb >> 9) & 1) << 5); R = (st >> 1) * 16 + swz / 64; C = (st & 1) * 32 + (swz % 64) / 2; }
__device__ __forceinline__ int perm32(int rho) { const int n = rho >> 4, i = rho & 15; return 8 * (i >> 2) + 4 * n + (i & 3); }
struct Unit { int pm, pn, tag; const char* a; const char* b; };
__device__ __forceinline__ void tile_of(int L, int nM, int nN, int& pm, int& pn) {
    const int nwg = nM * nN; int wgid = L;
    { const int q = nwg / NXCD, r = nwg % NXCD, xcd = wgid % NXCD, off = wgid / NXCD; wgid = (xcd < r ? xcd * (q + 1) : r * (q + 1) + (xcd - r) * q) + off; }
    const int nig = WGM * nN, gid = wgid / nig, fm = gid * WGM, gsz = (nM - fm) < WGM ? (nM - fm) : WGM;
    pm = fm + ((wgid % nig) % gsz); pn = (wgid % nig) / gsz;
}
template <class Epi, class Sched>
__device__ __forceinline__ void gemm_phase(const int wv, LAS unsigned char* lds, const int K, const int lda, const Sched& S, const Epi& E) {
    const int lane = lane_id(), wid = wv, tid = wv * 64 + lane, wr = wid >> 2, wc = wid & 3, fr = lane & 15, fq = lane >> 4;
    const int nt = K / BK;
    unsigned voffA[2], voffB[2];
#pragma unroll
    for (int i = 0; i < 2; ++i) { int R, C; stage_rc(tid * 16 + i * 8192, R, C); const int Rb = (R & ~31) + perm32(R & 31);
        voffA[i] = (unsigned)(R * lda + C) * 2u; voffB[i] = (unsigned)(Rb * K + C) * 2u; }
    const size_t kstep = (size_t)(BK * 2);
    const size_t hA = (size_t)HALF * lda * 2, hB = (size_t)HALF * K * 2;
    const unsigned ldsw = (unsigned)wid * 1024u;
    const int aoff = lds_byte(wr * 64 + fr, fq * 8), boff = lds_byte(wc * 32 + fr, fq * 8);
#define PG8_SA(b, h) (((b) * 2 + (h)) * HTB)
#define PG8_SB(b, h) ((4 + (b) * 2 + (h)) * HTB)
#define PG8_STAGE(bufoff, gbase, voff) do { _Pragma("unroll") for (int _i = 0; _i < 2; ++_i) \
        __builtin_amdgcn_global_load_lds((const unsigned*)((const char*)(gbase) + (voff)[_i]), (LAS unsigned*)(lds + (bufoff) + ldsw + _i * 8192), 16, 0, 0); } while (0)
#define PG8_LDA(dst, b, h) do { _Pragma("unroll") for (int m = 0; m < 4; ++m) _Pragma("unroll") for (int k = 0; k < 2; ++k) dst[m][k] = *(const LAS bf16x8*)(lds + PG8_SA(b, h) + aoff + m * 2048 + k * 1024); } while (0)
#define PG8_LDB(dst, b, h) do { _Pragma("unroll") for (int n = 0; n < 2; ++n) _Pragma("unroll") for (int k = 0; k < 2; ++k) dst[n][k] = *(const LAS bf16x8*)(lds + PG8_SB(b, h) + boff + n * 2048 + k * 1024); } while (0)
#define PG8_MMA(ai, bj, At, Bt) do { __builtin_amdgcn_s_setprio(1); _Pragma("unroll") for (int m = 0; m < 4; ++m) _Pragma("unroll") for (int n = 0; n < 2; ++n) _Pragma("unroll") for (int k = 0; k < 2; ++k) \
        acc[ai][bj][m][n] = __builtin_amdgcn_mfma_f32_16x16x32_bf16(Bt[n][k], At[m][k], acc[ai][bj][m][n], 0, 0, 0); __builtin_amdgcn_s_setprio(0); } while (0)
#define PG8_WAIT_V(n) asm volatile("s_waitcnt vmcnt(" #n ")" ::: "memory")
#define PG8_WAIT_L(n) asm volatile("s_waitcnt lgkmcnt(" #n ")" ::: "memory")
#define PG8_BAR __builtin_amdgcn_s_barrier()
#define PG8_SCHED __builtin_amdgcn_sched_barrier(0)
    Unit cur, nxt; int ui = 0;
    if (!S.next(0, cur)) return;
    f32x4 acc[2][2][4][2];
#pragma unroll
    for (int a = 0; a < 2; ++a)
#pragma unroll
        for (int b = 0; b < 2; ++b)
#pragma unroll
            for (int m = 0; m < 4; ++m)
#pragma unroll
                for (int n = 0; n < 2; ++n) acc[a][b][m][n] = (f32x4){0.f, 0.f, 0.f, 0.f};
    bf16x8 At[4][2], B0[2][2], B1[2][2];
    const char* cA = cur.a; const char* cB = cur.b;
    PG8_STAGE(PG8_SB(0, 0), cB, voffB); PG8_STAGE(PG8_SB(0, 1), cB + hB, voffB); PG8_STAGE(PG8_SA(0, 0), cA, voffA); PG8_STAGE(PG8_SA(0, 1), cA + hA, voffA);
    if (wr == 1) PG8_BAR;
    PG8_WAIT_V(2); PG8_BAR;
    PG8_STAGE(PG8_SB(1, 0), cB + kstep, voffB); PG8_STAGE(PG8_SA(1, 0), cA + kstep, voffA); PG8_STAGE(PG8_SB(1, 1), cB + hB + kstep, voffB);
    PG8_WAIT_V(6); PG8_BAR;
    for (;;) {
        const bool has_next = S.next(ui + 1, nxt);
        const char* nA = has_next ? nxt.a : cA; const char* nB = has_next ? nxt.b : cB;
        for (int t = 0; t < nt; t += 2) {
            const bool last = (t == nt - 2);
            const char* a1 = cA + (size_t)(t + 1) * kstep;
            const char* a2 = last ? nA : cA + (size_t)(t + 2) * kstep; const char* b2 = last ? nB : cB + (size_t)(t + 2) * kstep;
            const char* a3 = a2 + kstep; const char* b3 = b2 + kstep;
            PG8_LDB(B0, 0, 0); PG8_LDB(B1, 0, 1); PG8_SCHED; PG8_LDA(At, 0, 0); PG8_STAGE(PG8_SA(1, 1), a1 + hA, voffA);
            PG8_WAIT_V(8); PG8_WAIT_L(0); PG8_BAR; PG8_MMA(0, 0, At, B0); PG8_MMA(0, 1, At, B1); PG8_BAR; PG8_SCHED;
            PG8_LDA(At, 0, 1); PG8_STAGE(PG8_SB(0, 0), b2, voffB); PG8_STAGE(PG8_SB(0, 1), b2 + hB, voffB); PG8_STAGE(PG8_SA(0, 0), a2, voffA);
            PG8_WAIT_V(8); PG8_WAIT_L(0); PG8_BAR; PG8_MMA(1, 0, At, B0); PG8_MMA(1, 1, At, B1); PG8_BAR; PG8_SCHED;
            PG8_LDB(B0, 1, 0); PG8_LDB(B1, 1, 1); PG8_SCHED; PG8_LDA(At, 1, 0); PG8_STAGE(PG8_SA(0, 1), a2 + hA, voffA);
            PG8_WAIT_V(8); PG8_WAIT_L(0); PG8_BAR; PG8_MMA(0, 0, At, B0); PG8_MMA(0, 1, At, B1); PG8_BAR; PG8_SCHED;
            PG8_LDA(At, 1, 1); PG8_STAGE(PG8_SB(1, 0), b3, voffB); PG8_STAGE(PG8_SB(1, 1), b3 + hB, voffB); PG8_STAGE(PG8_SA(1, 0), a3, voffA);
            PG8_WAIT_V(8); PG8_WAIT_L(0); PG8_BAR; PG8_MMA(1, 0, At, B0); PG8_MMA(1, 1, At, B1); PG8_BAR; PG8_SCHED;
        }
        if (wr == 0) PG8_BAR;
        const int l2_ = lane_id(); const int fr_ = l2_ & 15, fq_ = l2_ >> 4;
        const bool keep = E(acc, cur, wr, wc, fr_, fq_);
        if (!has_next) break;
        if (!keep) {
#pragma unroll
        for (int a = 0; a < 2; ++a)
#pragma unroll
            for (int b = 0; b < 2; ++b)
#pragma unroll
                for (int m = 0; m < 4; ++m)
#pragma unroll
                    for (int n = 0; n < 2; ++n) acc[a][b][m][n] = (f32x4){0.f, 0.f, 0.f, 0.f};
        }
        cur = nxt; cA = nA; cB = nB; ++ui;
        if (wr == 1) PG8_BAR;
    }
    PG8_WAIT_V(0);
    PG8_BAR;
#undef PG8_SA
#undef PG8_SB
#undef PG8_STAGE
#undef PG8_LDA
#undef PG8_LDB
#undef PG8_MMA
#undef PG8_WAIT_V
#undef PG8_WAIT_L
#undef PG8_BAR
#undef PG8_SCHED
}
}
using pg8::Unit;
typedef f32x4 Acc[2][2][4][2];
#define EPI_ROWS(ai, m, row) _Pragma("unroll") for (int ai = 0; ai < 2; ++ai) _Pragma("unroll") for (int m = 0; m < 4; ++m) { const int row = u.pm * 256 + ai * 128 + wr * 64 + m * 16 + fr;
#define EPI_END asm volatile("" ::: "memory"); }
__device__ __forceinline__ void get8(const Acc& acc, int ai, int bj, int m, float* v) {
    const f32x4 a = acc[ai][bj][m][0], b = acc[ai][bj][m][1]; v[0] = a[0]; v[1] = a[1]; v[2] = a[2]; v[3] = a[3]; v[4] = b[0]; v[5] = b[1]; v[6] = b[2]; v[7] = b[3]; }

struct Args {
    const float *x_prompt, *x_sample, *g_mix, *w_in, *lb_param, *g_onorm, *g_qa, *w_uq, *g_kva, *w_ukv, *w_branch, *w_out, *g_ffn, *w_gate_up, *w_down, *g_final;
    float* out; unsigned char* ws;
    double inv_rev[16];
    int ph_lo, ph_hi;
};

struct SchedSimple {
    const char* A; const char* B; int nM, nN, G, c; size_t tA, tB;
    __device__ __forceinline__ bool next(int i, Unit& u) const { const long L = (long)i * G + c; if (L >= (long)nM * nN) return false; pg8::tile_of((int)L, nM, nN, u.pm, u.pn); u.tag = 0; u.a = A + u.pm * tA; u.b = B + u.pn * tB; return true; }
};
struct SchedUp {
    const char* LAT; const char* Wuq; const char* Wukv; int G, c;
    __device__ __forceinline__ bool next(int i, Unit& u) const { const long L = (long)i * G + c; if (L >= 256L * 7) return false; pg8::tile_of((int)L, 256, 7, u.pm, u.pn); u.tag = 0;
        u.a = LAT + (size_t)u.pm * 256 * 512 * 2 + (u.pn >= 3 ? 512 : 0); u.b = u.pn < 3 ? Wuq + (size_t)u.pn * 256 * 256 * 2 : Wukv + (size_t)(u.pn - 3) * 256 * 256 * 2; return true; }
};
struct SchedBranch {
    const char* OH; const char* OMm; const char* W0; const char* W1; int G, c;
    __device__ __forceinline__ bool next(int i, Unit& u) const { const long L = (long)(i >> 1) * G + c; if (L >= 256L * 4) return false; pg8::tile_of((int)L, 256, 4, u.pm, u.pn); u.tag = i & 1;
        u.a = ((i & 1) ? OMm : OH) + (size_t)u.pm * 256 * 512 * 2; u.b = ((i & 1) ? W1 : W0) + (size_t)u.pn * 256 * 512 * 2; return true; }
};

struct SchedPanel {
    const char* A; const char* B; int G, c; size_t tA, tB;
    __device__ __forceinline__ bool next(int i, Unit& u) const { const int p = c + (i >> 2) * G; if (p >= 256) return false; u.pm = p; u.pn = i & 3; u.tag = 0; u.a = A + p * tA; u.b = B + u.pn * tB; return true; }
};
struct EpiIn {
    unsigned char* ws; bf16_t *GATES; const float* lbp;
    __device__ __forceinline__ bool operator()(const Acc& acc, const Unit& u, int wr, int wc, int fr, int fq) const {
        const int pn = u.pn, cb = wc * 32 + 8 * fq;
        if (pn < 4 || (pn >= 8 && pn < 10)) {
            bf16_t* dst = (bf16_t*)(ws + (pn < 2 ? WS_HQ : (pn < 4 ? WS_HI : WS_SG))); const int c0 = (pn & 1) * 256; const bool act = (pn < 2 || pn >= 8);
            EPI_ROWS(ai, m, row)
#pragma unroll
                for (int bj = 0; bj < 2; ++bj) { float v[8]; get8(acc, ai, bj, m, v);
                    if (act) {
#pragma unroll
                        for (int i = 0; i < 8; ++i) v[i] = siluf_(v[i]); }
                    *(u32x4*)(dst + (size_t)row * 512 + c0 + bj * 128 + cb) = pack8(v); }
            EPI_END
        } else if (pn < 8) {
            const int dir = (pn >= 6); _Float16* dst = (_Float16*)(ws + (dir ? WS_GB : WS_GF)); const int c0 = (pn & 1) * 256;
            float lb[2][8];
#pragma unroll
            for (int bj = 0; bj < 2; ++bj)
#pragma unroll
                for (int i = 0; i < 8; ++i) { const int col = c0 + bj * 128 + cb + i; lb[bj][i] = sigmoidf_(lbp[dir * 512 + col] - lbp[1024 + dir * 512 + col]); }
            EPI_ROWS(ai, m, row)
#pragma unroll
                for (int bj = 0; bj < 2; ++bj) { float v[8]; get8(acc, ai, bj, m, v); h16x8 h;
#pragma unroll
                    for (int i = 0; i < 8; ++i) { const float f = lb[bj][i] + (1.f - lb[bj][i]) * sigmoidf_(v[i]); h[i] = (_Float16)__logf(f); }
                    *(u32x4*)(dst + (size_t)row * 512 + c0 + bj * 128 + cb) = __builtin_bit_cast(u32x4, h); }
            EPI_END
        } else if (pn < 12) {
            float* RS = (float*)(ws + (pn == 10 ? WS_RSQ : WS_RSKV)); const int c0 = (pn - 10) * 256; bf16_t* LAT = (bf16_t*)(ws + WS_LAT);
            EPI_ROWS(ai, m, row)
                float ss = 0.f;
#pragma unroll
                for (int bj = 0; bj < 2; ++bj) { float v[8]; get8(acc, ai, bj, m, v);
#pragma unroll
                    for (int i = 0; i < 8; ++i) ss += v[i] * v[i];
                    *(u32x4*)(LAT + (size_t)row * 512 + c0 + bj * 128 + cb) = pack8(v); }
                ss += __shfl_xor(ss, 16); ss += __shfl_xor(ss, 32);
                if (fq == 0) atomicAdd(RS + row, ss);
            EPI_END
        } else if (pn < 20) {
            const int c0 = (pn - 12) * 256;
            EPI_ROWS(ai, m, row)
#pragma unroll
                for (int bj = 0; bj < 2; ++bj) { float v[8]; get8(acc, ai, bj, m, v);
#pragma unroll
                    for (int i = 0; i < 8; ++i) v[i] = sigmoidf_(v[i]);
                    *(u32x4*)(GATES + (size_t)row * 2048 + c0 + bj * 128 + cb) = pack8(v); }
            EPI_END
        } else {
            bf16_t* Kc = (bf16_t*)(ws + WS_K); const f32x2* rope = (const f32x2*)(ws + WS_ROPE); float kmx = 0.f;
            EPI_ROWS(ai, m, row)
                float v[8], p[8]; get8(acc, ai, 0, m, v);
                { float ss = 0.f;
#pragma unroll
                  for (int i = 0; i < 8; ++i) ss += v[i] * v[i];
                  ss += __shfl_xor(ss, 16); ss += __shfl_xor(ss, 32); kmx = fmaxf(kmx, ss); }
#pragma unroll
                for (int i = 0; i < 8; ++i) p[i] = __shfl_xor(v[i], 32);
                if (wc == 0) {
                    const int pos = row_pos(row); const f32x2* cs = rope + pos * 16 + 8 * (fq & 1); float o[8];
#pragma unroll
                    for (int i = 0; i < 8; ++i) { const f32x2 c = cs[i]; o[i] = (fq < 2) ? (v[i] * c.x - p[i] * c.y) : (v[i] * c.x + p[i] * c.y); }
                    const u32x4 w = pack8(o);
#pragma unroll
                    for (int h = 0; h < 8; ++h) *(u32x4*)(Kc + ((size_t)row * 8 + h) * 96 + 64 + 8 * fq) = w;
                }
            EPI_END
            if (wc == 0) { kmx = fmaxf(kmx, __shfl_xor(kmx, 1)); kmx = fmaxf(kmx, __shfl_xor(kmx, 2)); kmx = fmaxf(kmx, __shfl_xor(kmx, 4)); kmx = fmaxf(kmx, __shfl_xor(kmx, 8));
                if (fr == 0 && fq == 0) { unsigned* KM = (unsigned*)(ws + WS_KMAX) + row_seq(u.pm * 256) * 32;
#pragma unroll
                    for (int h = 0; h < 8; ++h) atomicMax(KM + h * 4 + 2, __float_as_uint(kmx)); } }
        }
        return false;
    }
};
struct EpiUp {
    bf16_t *Q, *Kc, *V; const float *RSQ, *RSKV; const f32x2* rope; unsigned* KMAX;
    __device__ __forceinline__ bool operator()(const Acc& acc, const Unit& u, int wr, int wc, int fr, int fq) const {
        const int pn = u.pn, cb = wc * 32 + 8 * fq;
#define LOAD_RSV(RSp) float rsv[2][4]; { int rb_ = u.pm * 256 + wr * 64 + fr; asm volatile("" : "+v"(rb_)); const float* rp_ = (RSp) + rb_; _Pragma("unroll") for (int ai = 0; ai < 2; ++ai) _Pragma("unroll") for (int m = 0; m < 4; ++m) rsv[ai][m] = rp_[ai * 128 + m * 16]; }
        if (pn < 2) { LOAD_RSV(RSQ)
            EPI_ROWS(ai, m, row)
                const float sc = __builtin_amdgcn_rsqf(rsv[ai][m] * (1.f / 256.f) + EPS) * QSCALE;
#pragma unroll
                for (int bj = 0; bj < 2; ++bj) { float v[8]; get8(acc, ai, bj, m, v);
#pragma unroll
                    for (int i = 0; i < 8; ++i) v[i] *= sc;
                    const int cg_ = pn * 256 + bj * 128 + cb, h = cg_ >> 6, d = cg_ & 63;
                    *(u32x4*)(Q + ((size_t)row * 8 + h) * 96 + d) = pack8(v); }
            EPI_END
        } else if (pn == 2) {
            EPI_ROWS(ai, m, row)
                const float sc = __builtin_amdgcn_rsqf(RSQ[row] * (1.f / 256.f) + EPS) * QSCALE;
                const int pos = row_pos(row); const f32x2* cs = rope + pos * 16 + 8 * (fq & 1);
#pragma unroll
                for (int bj = 0; bj < 2; ++bj) { float v[8], p[8], o[8]; get8(acc, ai, bj, m, v);
#pragma unroll
                    for (int i = 0; i < 8; ++i) p[i] = __shfl_xor(v[i], 32);
#pragma unroll
                    for (int i = 0; i < 8; ++i) { const f32x2 c = cs[i]; o[i] = ((fq < 2) ? (v[i] * c.x - p[i] * c.y) : (v[i] * c.x + p[i] * c.y)) * sc; }
                    const int h = bj * 4 + wc;
                    *(u32x4*)(Q + ((size_t)row * 8 + h) * 96 + 64 + 8 * fq) = pack8(o); asm volatile("" ::: "memory"); }
            EPI_END
        } else {
            float kmx[2] = {0.f, 0.f}; LOAD_RSV(RSKV)
            EPI_ROWS(ai, m, row)
                const float sc = __builtin_amdgcn_rsqf(rsv[ai][m] * (1.f / 256.f) + EPS);
#pragma unroll
                for (int bj = 0; bj < 2; ++bj) { float v[8]; get8(acc, ai, bj, m, v);
#pragma unroll
                    for (int i = 0; i < 8; ++i) v[i] *= sc;
                    const int cg_ = (pn - 3) * 256 + bj * 128 + cb, h = cg_ >> 7, d = cg_ & 127;
                    if (d < 64) { *(u32x4*)(Kc + ((size_t)row * 8 + h) * 96 + d) = pack8(v); float ss = 0.f;
#pragma unroll
                        for (int i = 0; i < 8; ++i) ss += v[i] * v[i];
                        ss += __shfl_xor(ss, 16); ss += __shfl_xor(ss, 32); kmx[bj] = fmaxf(kmx[bj], ss); }
                    else *(u32x4*)(V + ((size_t)row * 8 + h) * 64 + (d - 64)) = pack8(v); }
            EPI_END
            if (wc < 2) {
#pragma unroll
                for (int bj = 0; bj < 2; ++bj) { float k = kmx[bj]; k = fmaxf(k, __shfl_xor(k, 1)); k = fmaxf(k, __shfl_xor(k, 2)); k = fmaxf(k, __shfl_xor(k, 4)); k = fmaxf(k, __shfl_xor(k, 8));
                    if (fr == 0 && fq == 0) atomicMax(KMAX + row_seq(u.pm * 256) * 32 + ((pn - 3) * 2 + bj) * 4 + wc, __float_as_uint(k)); } }
        }
        return false;
    }
};
struct EpiBranch {
    const bf16_t* GATES; bf16_t* MERGED;
    __device__ __forceinline__ bool operator()(Acc& acc, const Unit& u, int wr, int wc, int fr, int fq) const {
        const int cb = wc * 32 + 8 * fq;
#pragma unroll
        for (int ai = 0; ai < 2; ++ai) {
            u32x4 g1v[4][2], g0v[4][2];
#pragma unroll
            for (int m = 0; m < 4; ++m)
#pragma unroll
                for (int bj = 0; bj < 2; ++bj) { const int row = u.pm * 256 + ai * 128 + wr * 64 + m * 16 + fr, col = u.pn * 256 + bj * 128 + cb;
                    g1v[m][bj] = *(const u32x4*)(GATES + (size_t)row * 2048 + 1024 + col); if (u.tag == 0) g0v[m][bj] = *(const u32x4*)(GATES + (size_t)row * 2048 + col); }
#pragma unroll
            for (int m = 0; m < 4; ++m)
#pragma unroll
                for (int bj = 0; bj < 2; ++bj) { const int row = u.pm * 256 + ai * 128 + wr * 64 + m * 16 + fr, col = u.pn * 256 + bj * 128 + cb;
                    const u32x4 g1 = g1v[m][bj]; float g1f[8] = {bflo(g1.x), bfhi(g1.x), bflo(g1.y), bfhi(g1.y), bflo(g1.z), bfhi(g1.z), bflo(g1.w), bfhi(g1.w)};
                    if (u.tag == 0) {
                        const u32x4 g0 = g0v[m][bj]; float g0f[8] = {bflo(g0.x), bfhi(g0.x), bflo(g0.y), bfhi(g0.y), bflo(g0.z), bfhi(g0.z), bflo(g0.w), bfhi(g0.w)};
#pragma unroll
                        for (int i = 0; i < 4; ++i) { acc[ai][bj][m][0][i] *= g0f[i] * __builtin_amdgcn_rcpf(g1f[i]); acc[ai][bj][m][1][i] *= g0f[4 + i] * __builtin_amdgcn_rcpf(g1f[4 + i]); }
                    } else {
                        float v[8]; get8(acc, ai, bj, m, v);
#pragma unroll
                        for (int i = 0; i < 8; ++i) v[i] *= g1f[i];
                        *(u32x4*)(MERGED + (size_t)row * 1024 + col) = pack8(v);
                    } }
            asm volatile("" ::: "memory");
        }
        return u.tag == 0;
    }
};
struct EpiOut {
    const float *xp, *xs; bf16_t* X1B; float* RS;
    __device__ __forceinline__ bool operator()(const Acc& acc, const Unit& u, int wr, int wc, int fr, int fq) const {
        const int cb = wc * 32 + 8 * fq;
#pragma unroll
        for (int ai = 0; ai < 2; ++ai) {
            f32x4 pre[4][2][2];
#pragma unroll
            for (int m = 0; m < 4; ++m) { const int row = u.pm * 256 + ai * 128 + wr * 64 + m * 16 + fr; const float* xr = xrow_ptr(xp, xs, row);
#pragma unroll
                for (int bj = 0; bj < 2; ++bj) { const int col = u.pn * 256 + bj * 128 + cb; pre[m][bj][0] = *(const f32x4*)(xr + col); pre[m][bj][1] = *(const f32x4*)(xr + col + 4); } }
#pragma unroll
            for (int m = 0; m < 4; ++m) { const int row = u.pm * 256 + ai * 128 + wr * 64 + m * 16 + fr; float ss = 0.f;
#pragma unroll
                for (int bj = 0; bj < 2; ++bj) { const int col = u.pn * 256 + bj * 128 + cb; float v[8]; get8(acc, ai, bj, m, v);
                    const f32x4 x0 = pre[m][bj][0], x1 = pre[m][bj][1];
                    v[0] += x0[0]; v[1] += x0[1]; v[2] += x0[2]; v[3] += x0[3]; v[4] += x1[0]; v[5] += x1[1]; v[6] += x1[2]; v[7] += x1[3];
#pragma unroll
                    for (int i = 0; i < 8; ++i) ss += v[i] * v[i];
                    *(u32x4*)(X1B + (size_t)row * 1024 + col) = pack8(v); }
                ss += __shfl_xor(ss, 16); ss += __shfl_xor(ss, 32);
                if (fq == 0) atomicAdd(RS + row, ss); }
            asm volatile("" ::: "memory");
        }
        return false;
    }
};
struct EpiGU {
    const float* RS; bf16_t* ACT;
    __device__ __forceinline__ bool operator()(const Acc& acc, const Unit& u, int wr, int wc, int fr, int fq) const {
        const int cb = wc * 32 + 8 * fq;
        float rsv[2][4];
        { int rb_ = u.pm * 256 + wr * 64 + fr; asm volatile("" : "+v"(rb_)); const float* rp_ = RS + rb_;
#pragma unroll
        for (int ai = 0; ai < 2; ++ai)
#pragma unroll
            for (int m = 0; m < 4; ++m) rsv[ai][m] = rp_[ai * 128 + m * 16]; }
        EPI_ROWS(ai, m, row)
            const float sc = __builtin_amdgcn_rsqf(rsv[ai][m] * (1.f / 1024.f) + EPS);
            float g[8], p[8]; get8(acc, ai, 0, m, g); get8(acc, ai, 1, m, p);
#pragma unroll
            for (int i = 0; i < 8; ++i) g[i] = siluf_(g[i] * sc) * (p[i] * sc);
            *(u32x4*)(ACT + (size_t)row * DFF + u.pn * 128 + cb) = pack8(g);
        EPI_END
        return false;
    }
};
struct EpiDown {
    const bf16_t* X1B; float* X2; float* RS;
    __device__ __forceinline__ bool operator()(const Acc& acc, const Unit& u, int wr, int wc, int fr, int fq) const {
        const int cb = wc * 32 + 8 * fq;
#pragma unroll
        for (int ai = 0; ai < 2; ++ai) {
            u32x4 pre[4][2];
#pragma unroll
            for (int m = 0; m < 4; ++m) { const int row = u.pm * 256 + ai * 128 + wr * 64 + m * 16 + fr;
#pragma unroll
                for (int bj = 0; bj < 2; ++bj) pre[m][bj] = *(const u32x4*)(X1B + (size_t)row * 1024 + u.pn * 256 + bj * 128 + cb); }
#pragma unroll
            for (int m = 0; m < 4; ++m) { const int row = u.pm * 256 + ai * 128 + wr * 64 + m * 16 + fr; float ss = 0.f;
#pragma unroll
                for (int bj = 0; bj < 2; ++bj) { const int col = u.pn * 256 + bj * 128 + cb; float v[8]; get8(acc, ai, bj, m, v);
                    const u32x4 x = pre[m][bj];
                    v[0] += bflo(x.x); v[1] += bfhi(x.x); v[2] += bflo(x.y); v[3] += bfhi(x.y); v[4] += bflo(x.z); v[5] += bfhi(x.z); v[6] += bflo(x.w); v[7] += bfhi(x.w);
#pragma unroll
                    for (int i = 0; i < 8; ++i) ss += v[i] * v[i];
                    *(f32x4*)(X2 + (size_t)row * 1024 + col) = (f32x4){v[0], v[1], v[2], v[3]}; *(f32x4*)(X2 + (size_t)row * 1024 + col + 4) = (f32x4){v[4], v[5], v[6], v[7]}; }
                ss += __shfl_xor(ss, 16); ss += __shfl_xor(ss, 32);
                if (fq == 0) atomicAdd(RS + row, ss); }
            asm volatile("" ::: "memory");
        }
        return false;
    }
};

namespace att {
constexpr int LDQ = 768, LDK = 768, LDV = 512, LDO = 512, KVBLK = 64, QBLK = 32;
constexpr int SHM_K = 64 * 256, SHM_V = 64 * 64 * 2;
#define KSWZ(row, colB) ((row) * 256 + ((colB) ^ (((row) & 15) << 4)))
__device__ __forceinline__ void expA(f32x16& p0) {
#pragma unroll
    for (int r = 0; r < 16; ++r) p0[r] = __builtin_amdgcn_exp2f(p0[r]);
}
__device__ __forceinline__ void finishSM(f32x16& p0, f32x16& p1, float& l_reg, bf16x8& pa0, bf16x8& pa1, bf16x8& pa2, bf16x8& pa3) {
#pragma unroll
    for (int r = 0; r < 16; ++r) p1[r] = __builtin_amdgcn_exp2f(p1[r]);
    float ps = 0;
#pragma unroll
    for (int r = 0; r < 16; ++r) ps += p0[r];
#pragma unroll
    for (int r = 0; r < 16; ++r) ps += p1[r];
    l_reg += ps;
#define PK4(P, BASE, OUT) do { unsigned a0 = cvtpk(P[BASE + 0], P[BASE + 1]), a1 = cvtpk(P[BASE + 2], P[BASE + 3]);   \
    unsigned b0 = cvtpk(P[BASE + 4], P[BASE + 5]), b1 = cvtpk(P[BASE + 6], P[BASE + 7]);                              \
    auto r0 = __builtin_amdgcn_permlane32_swap(a0, b0, false, false); auto r1 = __builtin_amdgcn_permlane32_swap(a1, b1, false, false); \
    u32x4 w = {r0[0], r1[0], r0[1], r1[1]}; OUT = *reinterpret_cast<bf16x8*>(&w); } while (0)
    PK4(p0, 0, pa0); PK4(p0, 8, pa1); PK4(p1, 0, pa2); PK4(p1, 8, pa3);
#undef PK4
}
__device__ __forceinline__ void qkt(f32x16& p0, f32x16& p1, const char* Ks, const bf16x8* qr, const float mrow, int r32, int hi) {
    p0 = f32x16{}; p1 = f32x16{};
#pragma unroll
    for (int d0 = 0; d0 < 6; ++d0) { const int cb = (d0 * 16 + hi * 8) * 2;
        bf16x8 b0 = *reinterpret_cast<const bf16x8*>(Ks + KSWZ(r32, cb));
        bf16x8 b1 = *reinterpret_cast<const bf16x8*>(Ks + KSWZ(32 + r32, cb));
        p0 = __builtin_amdgcn_mfma_f32_32x32x16_bf16(b0, qr[d0], p0, 0, 0, 0);
        p1 = __builtin_amdgcn_mfma_f32_32x32x16_bf16(b1, qr[d0], p1, 0, 0, 0); }
    if (mrow != 0.f) {
#pragma unroll
        for (int r = 0; r < 16; ++r) { p0[r] -= mrow; p1[r] -= mrow; } }
}
__device__ __forceinline__ int v_st(int k, int c) { const int kk = (k & ~0xC) | ((k & 4) << 1) | ((k & 8) >> 1); return ((kk >> 3) * 2 + (c >> 5)) * 512 + ((kk & 7) * 32 + (c & 31)) * 2; }
__device__ __forceinline__ int v_rd_base(int lane) { return ((lane & 3) << 3) | (((lane >> 2) & 3) << 6) | (((lane >> 4) & 1) << 5) | (((lane >> 5) & 1) << 8); }
constexpr int v_rd_off(int d0, int ks, int half) { return d0 * 512 + ks * 2048 + half * 1024; }
template <int OFF> __device__ __forceinline__ s16x4 tr_read(int vb) { s16x4 r; asm volatile("ds_read_b64_tr_b16 %0, %1 offset:%2" : "=&v"(r) : "v"(vb), "i"(OFF) : "memory"); return r; }
template <int D0> __device__ __forceinline__ void pv_one(f32x16& od, int vb, bf16x8 pa0, bf16x8 pa1, bf16x8 pa2, bf16x8 pa3) {
    const s16x4 l0 = tr_read<v_rd_off(D0, 0, 0)>(vb), h0 = tr_read<v_rd_off(D0, 0, 1)>(vb), l1 = tr_read<v_rd_off(D0, 1, 0)>(vb), h1 = tr_read<v_rd_off(D0, 1, 1)>(vb);
    const s16x4 l2 = tr_read<v_rd_off(D0, 2, 0)>(vb), h2 = tr_read<v_rd_off(D0, 2, 1)>(vb), l3 = tr_read<v_rd_off(D0, 3, 0)>(vb), h3 = tr_read<v_rd_off(D0, 3, 1)>(vb);
    asm volatile("s_waitcnt lgkmcnt(0)" ::: "memory"); SBAR();
#define PK(L, H) (bf16x8){L[0], L[1], L[2], L[3], H[0], H[1], H[2], H[3]}
    od = __builtin_amdgcn_mfma_f32_32x32x16_bf16(pa0, PK(l0, h0), od, 0, 0, 0);
    od = __builtin_amdgcn_mfma_f32_32x32x16_bf16(pa1, PK(l1, h1), od, 0, 0, 0);
    od = __builtin_amdgcn_mfma_f32_32x32x16_bf16(pa2, PK(l2, h2), od, 0, 0, 0);
    od = __builtin_amdgcn_mfma_f32_32x32x16_bf16(pa3, PK(l3, h3), od, 0, 0, 0);
#undef PK
}
__device__ __forceinline__ void pv_d0(f32x16* o, int vb, bf16x8 pa0, bf16x8 pa1, bf16x8 pa2, bf16x8 pa3) { pv_one<0>(o[0], vb, pa0, pa1, pa2, pa3); pv_one<1>(o[1], vb, pa0, pa1, pa2, pa3); }

__device__ __forceinline__ void attn_unit(const bf16_t* __restrict__ Qb, const bf16_t* __restrict__ Kh, const bf16_t* __restrict__ Vh, bf16_t* __restrict__ Ob, int seq, float kmax, char* lds, const int wv) {
    const int lane = lane_id(), wid = wv, tid = wv * 64 + lane, r32 = lane & 31, hi = lane >> 5;
    char* V_lds = lds; char* K_lds = lds + 2 * SHM_V;
    float* li_l = (float*)(lds + 2 * SHM_V + 2 * SHM_K) + wid * 64;
    float l_reg = 0; f32x16 o[2] = {}; bf16x8 qr[6];
    const bf16_t* Qw = Qb + (long)(wid * QBLK + r32) * LDQ + hi * 8;
    float qss = 0.f;
#pragma unroll
    for (int d0 = 0; d0 < 6; ++d0) { qr[d0] = *reinterpret_cast<const bf16x8*>(Qw + d0 * 16);
#pragma unroll
        for (int i = 0; i < 8; ++i) { const float f = bf2f((unsigned short)qr[d0][i]); qss += f * f; } }
    { auto rr = __builtin_amdgcn_permlane32_swap(__float_as_uint(qss), __float_as_uint(qss), false, false); qss = __uint_as_float(rr[0]) + __uint_as_float(rr[1]); }
    float mrow = sqrtf(qss) * kmax;
    if (__all(mrow < 64.f)) mrow = 0.f;
    const int kc1 = tid, kc2 = 512 + (tid & 255); const int kr1 = kc1 / 12, kp1 = kc1 % 12, kr2 = kc2 / 12, kp2 = kc2 % 12; const int vr = tid >> 3, vp = tid & 7;
    const int kst1 = KSWZ(kr1, kp1 * 16), kst2 = KSWZ(kr2, kp2 * 16), vst = v_st(vr, vp * 8);
    const int vb0 = (int)(uintptr_t)V_lds + v_rd_base(lane);
    struct { bf16x8 k1, k2, v; } sr_[2];
#define SLOAD(i, k0) do { sr_[i].k1 = *reinterpret_cast<const bf16x8*>(&Kh[(long)((k0) + kr1) * LDK + kp1 * 8]); if (wv < 4) sr_[i].k2 = *reinterpret_cast<const bf16x8*>(&Kh[(long)((k0) + kr2) * LDK + kp2 * 8]); \
    sr_[i].v = *reinterpret_cast<const bf16x8*>(&Vh[(long)((k0) + vr) * LDV + vp * 8]); } while (0)
#define SWRITE(b, i) do { *(bf16x8*)(K_lds + (b) * SHM_K + kst1) = sr_[i].k1; if (wv < 4) *(bf16x8*)(K_lds + (b) * SHM_K + kst2) = sr_[i].k2; *(bf16x8*)(V_lds + (b) * SHM_V + vst) = sr_[i].v; } while (0)
#define SWAIT() do { if (wv < 4) asm volatile("s_waitcnt vmcnt(3)" ::: "memory"); else asm volatile("s_waitcnt vmcnt(2)" ::: "memory"); } while (0)
    f32x16 pA0, pA1, pB0, pB1; bf16x8 pa0, pa1, pa2, pa3; const int NT = seq / KVBLK;
    constexpr int SE = 0, SO = 1;
    SLOAD(SE, 0); asm volatile("s_waitcnt vmcnt(0)" ::: "memory"); SWRITE(0, SE); __syncthreads();
    qkt(pA0, pA1, K_lds, qr, mrow, r32, hi); expA(pA0);
    SLOAD(SO, KVBLK); if (2 < NT) SLOAD(SE, 2 * KVBLK);
    SWAIT(); SWRITE(1, SO); __syncthreads();
    for (int j = 1; j + 1 < NT; j += 2) {
        SBAR(); qkt(pB0, pB1, K_lds + SHM_K, qr, mrow, r32, hi);
        finishSM(pA0, pA1, l_reg, pa0, pa1, pa2, pa3); SBAR();
        SLOAD(SO, (j + 2) * KVBLK); SBAR();
        pv_d0(o, vb0, pa0, pa1, pa2, pa3); expA(pB0);
        __syncthreads(); SWAIT(); SWRITE(0, SE);
        __syncthreads();
        SBAR(); qkt(pA0, pA1, K_lds, qr, mrow, r32, hi);
        finishSM(pB0, pB1, l_reg, pa0, pa1, pa2, pa3); SBAR();
        if (j + 3 < NT) SLOAD(SE, (j + 3) * KVBLK); SBAR();
        pv_d0(o, vb0 + SHM_V, pa0, pa1, pa2, pa3); expA(pA0);
        __syncthreads(); if (j + 3 < NT) SWAIT(); else asm volatile("s_waitcnt vmcnt(0)" ::: "memory"); SWRITE(1, SO);
        __syncthreads();
    }
    SBAR(); qkt(pB0, pB1, K_lds + SHM_K, qr, mrow, r32, hi);
    finishSM(pA0, pA1, l_reg, pa0, pa1, pa2, pa3); SBAR();
    pv_d0(o, vb0, pa0, pa1, pa2, pa3); expA(pB0);
    __syncthreads();
    finishSM(pB0, pB1, l_reg, pa0, pa1, pa2, pa3); SBAR();
    pv_d0(o, vb0 + SHM_V, pa0, pa1, pa2, pa3);
    { auto rr = __builtin_amdgcn_permlane32_swap(__float_as_uint(l_reg), __float_as_uint(l_reg), false, false); l_reg = __uint_as_float(rr[0]) + __uint_as_float(rr[1]); }
    if (hi == 0) li_l[r32] = l_reg; asm volatile("s_waitcnt lgkmcnt(0)" ::: "memory");
    float rli[16];
#pragma unroll
    for (int r = 0; r < 16; ++r) rli[r] = __builtin_amdgcn_rcpf(li_l[crow(r, hi)]);
    bf16_t* Ow = Ob + (long)(wid * QBLK) * LDO;
#pragma unroll
    for (int r = 0; r < 16; ++r) { const int orow = crow(r, hi);
#pragma unroll
        for (int d0 = 0; d0 < 2; ++d0) Ow[(long)orow * LDO + d0 * 32 + r32] = (bf16_t)(cvtpk(o[d0][r] * rli[r], 0.f) & 0xffffu); }
    __syncthreads();
#undef SLOAD
#undef SWRITE
#undef SWAIT
}
}

namespace hg {
constexpr int QP = 136, TP = 68;
constexpr int OFF_QIN = 0, OFF_KIN = 64 * QP * 2, OFF_KINT = 2 * 64 * QP * 2, OFF_VT = OFF_KINT + 128 * TP * 2, OFF_TOT1 = OFF_VT + 128 * TP * 2, OFF_FAC = OFF_TOT1 + 1024, HALF_BYTES = OFF_FAC + 512;
static_assert(2 * HALF_BYTES <= LDS_CTL, "HGRN LDS");
__device__ __forceinline__ bf16x8 ld2x4(const LAS char* p0, const LAS char* p1) { const s16x4 a = *(const LAS s16x4*)p0, b = *(const LAS s16x4*)p1; return (bf16x8){a[0], a[1], a[2], a[3], b[0], b[1], b[2], b[3]}; }
__device__ __forceinline__ bf16x8 packf8(const f32x16& a, int base) { u32x4 w; w.x = cvtpk(a[base], a[base + 1]); w.y = cvtpk(a[base + 2], a[base + 3]); w.z = cvtpk(a[base + 4], a[base + 5]); w.w = cvtpk(a[base + 6], a[base + 7]); return __builtin_bit_cast(bf16x8, w); }
__device__ __forceinline__ void unit(LAS char* lds, int seqbase, int S, int h, const bf16_t* __restrict__ HQp, const bf16_t* __restrict__ HIp, const _Float16* __restrict__ GFp, const _Float16* __restrict__ GBp, bf16_t* OFWp, bf16_t* OBWp, const int wv) {
    const int lane = lane_id(), tid = wv * 64 + lane, bwd = wv >> 2, ht = tid & 255, w = wv & 3, r32 = lane & 31, hi = lane >> 5;
    LAS char* base = lds + bwd * HALF_BYTES;
    LAS char* QIN = base + OFF_QIN; LAS char* KINT = base + OFF_KINT; LAS char* VT = base + OFF_VT; LAS float* TOT1 = (LAS float*)(base + OFF_TOT1); LAS float* FAC = (LAS float*)(base + OFF_FAC);
    const _Float16* G = bwd ? GBp : GFp; bf16_t* O = bwd ? OBWp : OFWp;
    const int nc = S / 64, part = ht >> 7, d = ht & 127, e0 = 32 * w;
    f32x16 Sacc[4] = {};
    if (part == 1) { TOT1[d] = 0.f; TOT1[128 + d] = 0.f; }
    u32x4 rg[4], rq[4], rv[4];
    const int trb = ht >> 4, c8 = (ht & 15) * 8, tv = (ht >> 2) & 63, ev = (ht & 3) * 8;
    const long jstep = bwd ? -16 * 512 : 16 * 512;
    const size_t gq_off = (size_t)(bwd ? 63 - trb : trb) * 512 + h * 128 + c8, v_off = (size_t)(bwd ? 63 - tv : tv) * 512 + h * 128 + ev;
#define HG_LOADRAW(c) do { const size_t cb_ = (size_t)(seqbase + (bwd ? (nc - 1 - (c)) * 64 : (c) * 64)) * 512 + gq_off; \
    _Pragma("unroll") for (int j = 0; j < 4; ++j) { rg[j] = *(const u32x4*)(G + cb_ + j * jstep); rq[j] = *(const u32x4*)(HQp + cb_ + j * jstep); } } while (0)
#define HG_LOADV(c) do { const size_t cb_ = (size_t)(seqbase + (bwd ? (nc - 1 - (c)) * 64 : (c) * 64)) * 512 + v_off; \
    _Pragma("unroll") for (int j = 0; j < 4; ++j) rv[j] = *(const u32x4*)(HIp + cb_ + 32 * j); } while (0)
    HG_LOADRAW(0); HG_LOADV(0);
    for (int c = 0; c < nc; ++c) {
        const int c0 = seqbase + (bwd ? (nc - 1 - c) * 64 : c * 64);
        LAS char* wq = QIN + (trb * QP + c8) * 2; LAS char* wvt = VT + (ev * TP + tv) * 2; LAS char* colb = QIN + d * 2; LAS char* ktb = KINT + d * TP * 2;
        asm volatile("" : "+v"(wq), "+v"(wvt), "+v"(colb), "+v"(ktb));
#pragma unroll
        for (int j = 0; j < 4; ++j) { *(LAS u32x4*)(wq + j * 16 * QP * 2) = rq[j]; *(LAS u32x4*)(wq + (OFF_KIN - OFF_QIN) + j * 16 * QP * 2) = rg[j]; }
#pragma unroll
        for (int j = 0; j < 4; ++j) { const unsigned vv[4] = {rv[j].x, rv[j].y, rv[j].z, rv[j].w};
#pragma unroll
            for (int i = 0; i < 4; ++i) { *(LAS bf16_t*)(wvt + (32 * j + 2 * i) * TP * 2) = (bf16_t)(vv[i] & 0xffffu); *(LAS bf16_t*)(wvt + (32 * j + 2 * i + 1) * TP * 2) = (bf16_t)(vv[i] >> 16); } }
        __syncthreads();
        if (c + 1 < nc) { HG_LOADRAW(c + 1); HG_LOADV(c + 1); }
        constexpr int KO = OFF_KIN - OFF_QIN;
        if (part == 0) {
            float E1 = 1.f, E2 = 1.f, tot = 0.f;
#pragma unroll 4
            for (int tp = 15; tp >= 0; --tp) { unsigned kpk[2];
#pragma unroll
                for (int s2 = 1; s2 >= 0; --s2) { const int tt = 2 * tp + s2;
                    const float g = (float)*(const LAS _Float16*)(colb + KO + tt * QP * 2), q = bf2f(*(const LAS bf16_t*)(colb + tt * QP * 2));
                    const float f = __expf(g), rf = __expf(-g);
                    const unsigned pq = cvtpk(q * E1, (1.f - f) * E2);
                    *(LAS bf16_t*)(colb + tt * QP * 2) = (bf16_t)(pq & 0xffffu); *(LAS bf16_t*)(colb + KO + tt * QP * 2) = (bf16_t)(pq >> 16); kpk[s2] = pq >> 16;
                    E1 *= rf; E2 *= f; tot += g; }
                *(LAS unsigned*)(ktb + 4 * tp) = kpk[0] | (kpk[1] << 16); }
            FAC[d] = __expf(tot + TOT1[((c + 1) & 1) * 128 + d]);
        } else {
            float E1 = 1.f, E2 = 1.f, tot = 0.f;
#pragma unroll 4
            for (int tp = 16; tp < 32; ++tp) { unsigned kpk[2];
#pragma unroll
                for (int s2 = 0; s2 < 2; ++s2) { const int tt = 2 * tp + s2;
                    const float g = (float)*(const LAS _Float16*)(colb + KO + tt * QP * 2), q = bf2f(*(const LAS bf16_t*)(colb + tt * QP * 2));
                    const float f = __expf(g), rf = __expf(-g);
                    E1 *= f; E2 *= rf; tot += g;
                    const unsigned pq = cvtpk(q * E1, (1.f - f) * E2);
                    *(LAS bf16_t*)(colb + tt * QP * 2) = (bf16_t)(pq & 0xffffu); *(LAS bf16_t*)(colb + KO + tt * QP * 2) = (bf16_t)(pq >> 16); kpk[s2] = pq >> 16; }
                *(LAS unsigned*)(ktb + 4 * tp) = kpk[0] | (kpk[1] << 16); }
            TOT1[(c & 1) * 128 + d] = tot;
        }
        __syncthreads();
        {
            const LAS char* bq16 = QIN + r32 * QP * 2 + 16 * hi; const LAS char* bq8 = QIN + r32 * QP * 2 + 8 * hi;
            const LAS char* bv16 = VT + (e0 + r32) * TP * 2 + 16 * hi; const LAS char* bv8 = VT + (e0 + r32) * TP * 2 + 8 * hi;
            const LAS char* bk16 = KINT + r32 * TP * 2 + 16 * hi; const LAS float* bfac = FAC + 4 * hi; int thr = r32 - 4 * hi;
            asm volatile("" : "+v"(bq16), "+v"(bq8), "+v"(bv16), "+v"(bv8), "+v"(bk16), "+v"(bfac), "+v"(thr));
            constexpr int KOFF = OFF_KIN - OFF_QIN, R32 = 32 * QP * 2;
#pragma unroll
            for (int db = 0; db < 4; ++db)
#pragma unroll
                for (int r4 = 0; r4 < 4; ++r4) { const f32x4 fc = *(const LAS f32x4*)(bfac + 32 * db + 8 * r4); Sacc[db][4 * r4] *= fc.x; Sacc[db][4 * r4 + 1] *= fc.y; Sacc[db][4 * r4 + 2] *= fc.z; Sacc[db][4 * r4 + 3] *= fc.w; }
            f32x16 o0 = {}, o1 = {};
#pragma unroll
            for (int kk = 0; kk < 8; ++kk) { const bf16x8 sf = packf8(Sacc[kk >> 1], 8 * (kk & 1));
                const bf16x8 b0 = ld2x4(bq8 + 32 * kk, bq8 + 32 * kk + 16), b1 = ld2x4(bq8 + R32 + 32 * kk, bq8 + R32 + 32 * kk + 16);
                o0 = __builtin_amdgcn_mfma_f32_32x32x16_bf16(sf, b0, o0, 0, 0, 0);
                o1 = __builtin_amdgcn_mfma_f32_32x32x16_bf16(sf, b1, o1, 0, 0, 0); if (kk & 1) SBAR(); }
            SBAR();
            {
                f32x16 p = {};
#pragma unroll
                for (int kk = 0; kk < 8; ++kk)
                    { p = __builtin_amdgcn_mfma_f32_32x32x16_bf16(*(const LAS bf16x8*)(bq16 + KOFF + 32 * kk), *(const LAS bf16x8*)(bq16 + 32 * kk), p, 0, 0, 0); if ((kk & 3) == 3) SBAR(); }
#pragma unroll
                for (int r = 0; r < 16; ++r) { if ((r & 3) + 8 * (r >> 2) > thr) p[r] = 0.f; }
#pragma unroll
                for (int k2 = 0; k2 < 2; ++k2) o0 = __builtin_amdgcn_mfma_f32_32x32x16_bf16(ld2x4(bv8 + 32 * k2, bv8 + 32 * k2 + 16), packf8(p, 8 * k2), o0, 0, 0, 0);
            }
            SBAR();
            {
                f32x16 p = {};
#pragma unroll
                for (int kk = 0; kk < 8; ++kk)
                    { p = __builtin_amdgcn_mfma_f32_32x32x16_bf16(*(const LAS bf16x8*)(bq16 + KOFF + 32 * kk), *(const LAS bf16x8*)(bq16 + R32 + 32 * kk), p, 0, 0, 0); if ((kk & 3) == 3) SBAR(); }
#pragma unroll
                for (int k2 = 0; k2 < 2; ++k2) o1 = __builtin_amdgcn_mfma_f32_32x32x16_bf16(ld2x4(bv8 + 32 * k2, bv8 + 32 * k2 + 16), packf8(p, 8 * k2), o1, 0, 0, 0);
            }
            SBAR();
            {
                f32x16 p = {};
#pragma unroll
                for (int kk = 0; kk < 8; ++kk)
                    { p = __builtin_amdgcn_mfma_f32_32x32x16_bf16(*(const LAS bf16x8*)(bq16 + KOFF + R32 + 32 * kk), *(const LAS bf16x8*)(bq16 + R32 + 32 * kk), p, 0, 0, 0); if ((kk & 3) == 3) SBAR(); }
#pragma unroll
                for (int r = 0; r < 16; ++r) { if ((r & 3) + 8 * (r >> 2) > thr) p[r] = 0.f; }
#pragma unroll
                for (int k2 = 0; k2 < 2; ++k2) o1 = __builtin_amdgcn_mfma_f32_32x32x16_bf16(ld2x4(bv8 + 64 + 32 * k2, bv8 + 64 + 32 * k2 + 16), packf8(p, 8 * k2), o1, 0, 0, 0);
            }
            SBAR();
#pragma unroll
            for (int kk = 0; kk < 4; ++kk) { const bf16x8 vfr = ld2x4(bv16 + 32 * kk, bv16 + 32 * kk + 8);
#pragma unroll
                for (int db = 0; db < 4; ++db) { const LAS char* kp = bk16 + 32 * db * TP * 2 + 32 * kk; Sacc[db] = __builtin_amdgcn_mfma_f32_32x32x16_bf16(ld2x4(kp, kp + 8), vfr, Sacc[db], 0, 0, 0); } SBAR(); }
            SBAR();
#pragma unroll
            for (int tb = 0; tb < 2; ++tb) { const int tt = 32 * tb + r32, row = c0 + (bwd ? 63 - tt : tt); bf16_t* op = O + (size_t)row * 512 + h * 128 + e0 + 16 * hi;
                const f32x16& oo = tb ? o1 : o0; unsigned dq[4][2];
#pragma unroll
                for (int r4 = 0; r4 < 4; ++r4) { dq[r4][0] = cvtpk(oo[4 * r4], oo[4 * r4 + 1]); dq[r4][1] = cvtpk(oo[4 * r4 + 2], oo[4 * r4 + 3]); }
                const auto s00 = __builtin_amdgcn_permlane32_swap(dq[0][0], dq[2][0], false, false), s01 = __builtin_amdgcn_permlane32_swap(dq[0][1], dq[2][1], false, false);
                const auto s10 = __builtin_amdgcn_permlane32_swap(dq[1][0], dq[3][0], false, false), s11 = __builtin_amdgcn_permlane32_swap(dq[1][1], dq[3][1], false, false);
                *(u32x4*)(op) = (u32x4){s00[0], s01[0], s00[1], s01[1]}; *(u32x4*)(op + 8) = (u32x4){s10[0], s11[0], s10[1], s11[1]}; }
        }
        __syncthreads();
    }
#undef HG_LOADRAW
#undef HG_LOADV
}
}

__device__ __forceinline__ float wave_sum(float v) {
#pragma unroll
    for (int o = 1; o < 64; o <<= 1) v += __shfl_xor(v, o);
    return v;
}
__device__ __forceinline__ void transpose_item(const float* W, int K, int N, int k0, int n0, bf16_t* WT, int dst0, const float* kscale, LAS float* scr, int lane) {
#pragma unroll 8
    for (int i = 0; i < 32; ++i) { const int kk = 2 * i + (lane >> 5); float v = W[(size_t)(k0 + kk) * N + n0 + (lane & 31)]; if (kscale) v *= kscale[k0 + kk]; scr[kk * 33 + (lane & 31)] = v; }
    asm volatile("s_waitcnt lgkmcnt(0)" ::: "memory");
    const int c = lane & 7;
#pragma unroll
    for (int j = 0; j < 4; ++j) { const int n = (lane >> 3) + 8 * j; const LAS float* s = scr + (8 * c) * 33 + n;
        u32x4 o; o.x = cvtpk(s[0 * 33], s[1 * 33]); o.y = cvtpk(s[2 * 33], s[3 * 33]); o.z = cvtpk(s[4 * 33], s[5 * 33]); o.w = cvtpk(s[6 * 33], s[7 * 33]);
        *(u32x4*)(WT + (size_t)(dst0 + n) * K + k0 + 8 * c) = o; }
    asm volatile("s_waitcnt lgkmcnt(0)" ::: "memory");
}

#define XB_TMO      128
#define XB_XCNT(j)  (256  + 64 * (j))
#define XB_XSUB(j)  (1280 + 64 * (j))
#define XB_XGEN(j)  (2304 + 64 * (j))
#define XB_TOP      3328
#define XB_TOPGEN   3392
#define XB_SPIN_CAP (1u << 22)
__device__ __forceinline__ unsigned xb_ld(unsigned* p)              { return __hip_atomic_load(p, __ATOMIC_RELAXED, __HIP_MEMORY_SCOPE_AGENT); }
__device__ __forceinline__ unsigned xb_add(unsigned* p, unsigned v) { return __hip_atomic_fetch_add(p, v, __ATOMIC_RELAXED, __HIP_MEMORY_SCOPE_AGENT); }
__device__ __forceinline__ unsigned xb_xcc_id() { return (unsigned)__builtin_amdgcn_s_getreg((3 << 11) | 20) & 0xFu; }
#define XB_SPIN(cond, bar) do { unsigned _sp = 0; while (cond) { __builtin_amdgcn_s_sleep(1); \
    if ((++_sp & 255u) == 0u) { if (xb_ld(&(bar)[XB_TMO])) break; if (_sp > XB_SPIN_CAP) { atomicAdd(&(bar)[XB_TMO], 1u); break; } } } } while (0)
__device__ __forceinline__ void xcd_barrier_complete(unsigned* bar, unsigned x, unsigned& nloc, unsigned& nx) {
    const unsigned G = gridDim.x;
    unsigned sum, cnt, mine, sp = 0u;
    for (;;) {
        sum = 0u; cnt = 0u; mine = 0u;
#pragma unroll
        for (unsigned j = 0; j < 16; ++j) { const unsigned c = xb_ld(&bar[XB_XCNT(j)]); sum += c; cnt += (c > 0u) ? 1u : 0u; mine = (j == x) ? c : mine; }
        if (sum == G) break;
        __builtin_amdgcn_s_sleep(1);
        if ((++sp & 255u) == 0u) { if (xb_ld(&bar[XB_TMO])) break; if (sp > XB_SPIN_CAP) { atomicAdd(&bar[XB_TMO], 1u); break; } }
    }
    nloc = mine > 0u ? mine : 1u; nx = cnt > 0u ? cnt : 1u;
}
__device__ __forceinline__ void grid_barrier(unsigned* bar, const int wv, volatile LAS unsigned* st) {
    asm volatile("s_waitcnt vmcnt(0)" ::: "memory");
    __syncthreads();
    if (wv == 0 && lane_id() == 0) {
        const unsigned x = xb_xcc_id();
        __builtin_amdgcn_s_waitcnt(0);
        unsigned nloc = st[0], nx = st[1];
        if (nloc == 0u) { xcd_barrier_complete(bar, x, nloc, nx); st[0] = nloc; st[1] = nx; }
        const unsigned old = xb_add(&bar[XB_XSUB(x)], 1u);
        const unsigned gen = old / nloc;
        if (old + 1u == (gen + 1u) * nloc) {
            __builtin_amdgcn_fence(__ATOMIC_RELEASE, "agent");
            asm volatile("s_waitcnt vmcnt(0)" ::: "memory");
            const unsigned og = xb_add(&bar[XB_TOP], 1u);
            const unsigned tg = og / nx;
            if (og + 1u == (tg + 1u) * nx) xb_add(&bar[XB_TOPGEN], 1u);
            else XB_SPIN(xb_ld(&bar[XB_TOPGEN]) == tg, bar);
            __builtin_amdgcn_fence(__ATOMIC_ACQUIRE, "agent");
            xb_add(&bar[XB_XGEN(x)], 1u);
            asm volatile("s_waitcnt vmcnt(0)" ::: "memory");
        } else {
            XB_SPIN(xb_ld(&bar[XB_XGEN(x)]) == gen, bar);
            __builtin_amdgcn_fence(__ATOMIC_ACQUIRE, "agent");
            asm volatile("s_waitcnt vmcnt(0)" ::: "memory");
        }
    }
    __syncthreads();
}
#define WinT ((bf16_t*)(ws + WS_WIN))
#define WuqT ((bf16_t*)(ws + WS_WUQ))
#define WukvT ((bf16_t*)(ws + WS_WUKV))
#define Wb0T ((bf16_t*)(ws + WS_WB0))
#define Wb1T ((bf16_t*)(ws + WS_WB1))
#define WoT ((bf16_t*)(ws + WS_WO))
#define WguT ((bf16_t*)(ws + WS_WGU))
#define WdT ((bf16_t*)(ws + WS_WD))
#define XN ((bf16_t*)(ws + WS_XN))
#define HQ ((bf16_t*)(ws + WS_HQ))
#define HI ((bf16_t*)(ws + WS_HI))
#define GF ((_Float16*)(ws + WS_GF))
#define GB ((_Float16*)(ws + WS_GB))
#define SG ((bf16_t*)(ws + WS_SG))
#define LAT ((bf16_t*)(ws + WS_LAT))
#define Qm ((bf16_t*)(ws + WS_Q))
#define Km ((bf16_t*)(ws + WS_K))
#define Vm ((bf16_t*)(ws + WS_V))
#define OM ((bf16_t*)(ws + WS_OM))
#define OFW ((bf16_t*)(ws + WS_OFW))
#define OBW ((bf16_t*)(ws + WS_OBW))
#define OH ((bf16_t*)(ws + WS_OH))
#define MERGED ((bf16_t*)(ws + WS_MERGED))
#define X1 ((float*)(ws + WS_X1))
#define X1B ((bf16_t*)(ws + WS_X1B))
#define ACT ((bf16_t*)(ws + WS_ACT))
#define GATES ((bf16_t*)a.out)
#define RSQ ((float*)(ws + WS_RSQ))
#define RSKV ((float*)(ws + WS_RSKV))
#define RSX1 ((float*)(ws + WS_RSX1))
#define RSX2 ((float*)(ws + WS_RSX2))
#define ROPE ((f32x2*)(ws + WS_ROPE))
#define QUEUE ((unsigned*)(ws + WS_QUEUE))
__global__ void __launch_bounds__(512, 2) fwd_megakernel(Args a) {
    extern __shared__ __attribute__((aligned(16))) unsigned char lds[];
    const int G = gridDim.x, bx = blockIdx.x;
    const int wv = __builtin_amdgcn_readfirstlane((int)threadIdx.x >> 6);
#define TIDS const int lane = lane_id(), wave = wv, tid = wv * 64 + lane; (void)tid;
    unsigned char* ws = a.ws;
    LAS unsigned char* ldsl = (LAS unsigned char*)lds;
    const int lo = a.ph_lo, hi_ = a.ph_hi;
#ifndef PHMASK
#define PHMASK 0x3ff
#endif
#define IN(k) (((PHMASK >> (k)) & 1) && lo <= (k) && (k) < hi_)
#define STAMP(k) do { if (PROBE_SEL && bx == 0 && wv == 0 && lane_id() == 0) ((unsigned long long*)(ws + WS_TS))[k] = __builtin_amdgcn_s_memrealtime(); } while (0)
#define SEAM(k) do { if (IN(k) && IN((k) + 1)) { if ((k) == 0) cg::this_grid().sync(); else grid_barrier((unsigned*)(ws + WS_XBAR), wv, (volatile LAS unsigned*)(ldsl + LDS_CTL + 32)); } } while (0)

    if (PROBE_SEL && bx == 0 && wv == 0 && lane_id() == 0) { for (int i = 1; i < 32; ++i) ((unsigned long long*)(ws + WS_TS))[i] = 0ull; }
    STAMP(0);
    if (IN(0)) { TIDS
        LAS float* scr = (LAS float*)(ldsl + wave * 16384);
        const int gw = bx * 8 + wave, NGW = G * 8;
        constexpr int I_IN = 16 * 161, I_UQ = 4 * 24, I_UKV = 4 * 32, I_B = 8 * 32, I_O = 16 * 32, I_GU = 16 * 176, I_D = 44 * 32;
        constexpr int NITEMS = I_IN + I_UQ + I_UKV + 2 * I_B + I_O + I_GU + I_D;
        for (int it = gw; it < NITEMS; it += NGW) {
            int r = it;
            if (r < I_IN) { const int kb = r / 161, nb = r % 161; const int dst = nb < 96 ? 32 * nb : (nb == 96 ? 5120 : 3072 + 32 * (nb - 97)); transpose_item(a.w_in, 1024, 5152, 64 * kb, 32 * nb, WinT, dst, nullptr, scr, lane); continue; } r -= I_IN;
            if (r < I_UQ) { const int kb = r / 24, nb = r % 24, h = nb / 3, p = nb % 3; const int dst = p < 2 ? h * 64 + 32 * p : 512 + 32 * h; transpose_item(a.w_uq, 256, 768, 64 * kb, 32 * nb, WuqT, dst, a.g_qa, scr, lane); continue; } r -= I_UQ;
            if (r < I_UKV) { const int kb = r / 32, nb = r % 32; transpose_item(a.w_ukv, 256, 1024, 64 * kb, 32 * nb, WukvT, 32 * nb, a.g_kva, scr, lane); continue; } r -= I_UKV;
            if (r < I_B) { const int kb = r / 32, nb = r % 32; transpose_item(a.w_branch, 512, 1024, 64 * kb, 32 * nb, Wb0T, 32 * nb, nullptr, scr, lane); continue; } r -= I_B;
            if (r < I_B) { const int kb = r / 32, nb = r % 32; transpose_item(a.w_branch + 512 * 1024, 512, 1024, 64 * kb, 32 * nb, Wb1T, 32 * nb, nullptr, scr, lane); continue; } r -= I_B;
            if (r < I_O) { const int kb = r / 32, nb = r % 32; transpose_item(a.w_out, 1024, 1024, 64 * kb, 32 * nb, WoT, 32 * nb, nullptr, scr, lane); continue; } r -= I_O;
            if (r < I_GU) { const int kb = r / 176, nb = r % 176; const int col = 32 * nb; const int j = col < DFF ? col : col - DFF; const int dst = 256 * (j / 128) + (col < DFF ? 0 : 128) + (j % 128);
                transpose_item(a.w_gate_up, 1024, 5632, 64 * kb, col, WguT, dst, a.g_ffn, scr, lane); continue; } r -= I_GU;
            { const int kb = r / 32, nb = r % 32; transpose_item(a.w_down, DFF, 1024, 64 * kb, 32 * nb, WdT, 32 * nb, nullptr, scr, lane); }
        }
        for (int m = gw; m < M; m += NGW) {
            const f32x4* xr = (const f32x4*)xrow_ptr(a.x_prompt, a.x_sample, m) + lane; f32x4 v[4]; float s = 0.f;
#pragma unroll
            for (int j = 0; j < 4; ++j) { v[j] = xr[64 * j]; s += (v[j].x * v[j].x + v[j].y * v[j].y) + (v[j].z * v[j].z + v[j].w * v[j].w); }
            const float rstd = __builtin_amdgcn_rsqf(wave_sum(s) * (1.f / 1024.f) + EPS);
            u32x2* o8 = (u32x2*)(XN + (size_t)m * 1024) + lane;
#pragma unroll
            for (int j = 0; j < 4; ++j) { const f32x4 g = ((const f32x4*)a.g_mix)[64 * j + lane]; u32x2 w; w.x = cvtpk(v[j].x * rstd * g.x, v[j].y * rstd * g.y); w.y = cvtpk(v[j].z * rstd * g.z, v[j].w * rstd * g.w); o8[64 * j] = w; }
        }
        for (int i = bx * 512 + tid; i < (int)(CTL_ZERO / 16); i += G * 512) { if (PROBE_SEL && i >= (int)(WS_TS / 16) && i < (int)(WS_TS / 16) + 16) continue; ((u32x4*)ws)[i] = (u32x4){0u, 0u, 0u, 0u}; }
        for (int i = bx * 512 + tid; i < 16384 * 16; i += G * 512) { const int pos = i >> 4, j = i & 15; const double rev = (double)pos * a.inv_rev[j]; const float fr_ = (float)(rev - floor(rev));
            ROPE[i] = (f32x2){__builtin_amdgcn_cosf(fr_), __builtin_amdgcn_sinf(fr_)}; }
    }
    SEAM(0); STAMP(1);
    {
        volatile LAS unsigned* st = (volatile LAS unsigned*)(ldsl + LDS_CTL + 32);
        if (wv == 0 && lane_id() == 0) { st[0] = 0u; st[1] = 0u; (void)xb_add((unsigned*)(ws + WS_XBAR) + XB_XCNT(xb_xcc_id()), 1u); }
        __syncthreads();
    }
    if (IN(1)) {
        SchedSimple S{(const char*)XN, (const char*)WinT, 256, 21, G, bx, (size_t)256 * 1024 * 2, (size_t)256 * 1024 * 2};
        EpiIn E{ws, GATES, a.lb_param};
        pg8::gemm_phase(wv, ldsl, 1024, 1024, S, E);
    }
    SEAM(1); STAMP(2);
    if (IN(2)) {
        SchedUp S{(const char*)LAT, (const char*)WuqT, (const char*)WukvT, G, bx};
        EpiUp E{Qm, Km, Vm, RSQ, RSKV, ROPE, (unsigned*)(ws + WS_KMAX)};
        pg8::gemm_phase(wv, ldsl, 256, 512, S, E);
    }
    SEAM(2); STAMP(3);
    if (IN(3)) { TIDS
        volatile LAS unsigned* ctl = (volatile LAS unsigned*)(ldsl + LDS_CTL);
        int did_hg = 0;
        for (int qk = 0; qk < 8; ++qk) {
            const int xq = (bx + qk) & 7;
            for (;;) {
                __syncthreads();
                if (tid == 0) ctl[0] = atomicAdd(QUEUE + xq * 64 + 32, 1u);
                __syncthreads();
                const int un = (int)ctl[0];
                if (un >= 3) break;
                int seqbase, S, h;
                if (un == 0) { seqbase = T0 + (xq >> 2) * 16384; S = 16384; h = xq & 3; }
                else { const int idx = 2 * xq + (un - 1); seqbase = (idx >> 2) * 8192; S = 8192; h = idx & 3; }
                hg::unit((LAS char*)ldsl, seqbase, S, h, HQ, HI, GF, GB, OFW, OBW, wv); did_hg = 1;
            }
        }
        if (PROBE_SEL && wv == 0 && lane_id() == 0) atomicMax((unsigned long long*)(ws + WS_TS) + 16, (unsigned long long)__builtin_amdgcn_s_memrealtime());
        for (int qk = 0; qk < 8; ++qk) {
            const int xq = (bx + qk) & 7;
            for (;;) {
                __syncthreads();
                if (tid == 0) ctl[0] = atomicAdd(QUEUE + xq * 64, 1u);
                __syncthreads();
                const int un = (int)ctl[0];
                if (un >= 256) break;
                int seqbase, S, h, qb;
                if (un < 128) { const int j = un, pair = 2 * xq + (j >> 6); seqbase = T0 + (pair >> 3) * 16384; S = 16384; h = pair & 7; qb = j & 63; }
                else { const int j = un - 128, pair = 4 * xq + (j >> 5); seqbase = (pair >> 3) * 8192; S = 8192; h = pair & 7; qb = j & 31; }
                const unsigned* km = (const unsigned*)(ws + WS_KMAX) + row_seq(seqbase) * 32 + h * 4;
                const float kmax = sqrtf(__uint_as_float(km[0]) + __uint_as_float(km[1]) + __uint_as_float(km[2])) * 1.01f;
                att::attn_unit(Qm + ((size_t)(seqbase + qb * 256) * 8 + h) * 96, Km + ((size_t)seqbase * 8 + h) * 96, Vm + ((size_t)seqbase * 8 + h) * 64, OM + (size_t)(seqbase + qb * 256) * 512 + h * 64, S, kmax, (char*)lds, wv);
            }
        }
        if (PROBE_SEL && !did_hg && wv == 0 && lane_id() == 0) atomicMax((unsigned long long*)(ws + WS_TS) + 17, (unsigned long long)__builtin_amdgcn_s_memrealtime());
    }
    SEAM(3); STAMP(4);
    if (IN(4)) { TIDS
        const int gw = bx * 8 + wave, NGW = G * 8;
        for (int m = gw; m < M; m += NGW) {
            const size_t off = (size_t)m * 512 + lane * 8;
            const u32x4 f = *(const u32x4*)(OFW + off), b = *(const u32x4*)(OBW + off), s = *(const u32x4*)(SG + off);
            const unsigned fu[4] = {f.x, f.y, f.z, f.w}, bu[4] = {b.x, b.y, b.z, b.w}, su[4] = {s.x, s.y, s.z, s.w};
            float o[8]; float ss = 0.f;
#pragma unroll
            for (int i = 0; i < 4; ++i) { o[2 * i] = bflo(fu[i]) + bflo(bu[i]); o[2 * i + 1] = bfhi(fu[i]) + bfhi(bu[i]); ss += o[2 * i] * o[2 * i] + o[2 * i + 1] * o[2 * i + 1]; }
            ss += __shfl_xor(ss, 1); ss += __shfl_xor(ss, 2); ss += __shfl_xor(ss, 4); ss += __shfl_xor(ss, 8);
            const float rstd = __builtin_amdgcn_rsqf(ss * (1.f / 128.f) + EPS);
            const f32x4 g0 = *(const f32x4*)(a.g_onorm + lane * 8), g1 = *(const f32x4*)(a.g_onorm + lane * 8 + 4); const float gg[8] = {g0.x, g0.y, g0.z, g0.w, g1.x, g1.y, g1.z, g1.w};
#pragma unroll
            for (int i = 0; i < 4; ++i) { o[2 * i] *= rstd * gg[2 * i] * bflo(su[i]); o[2 * i + 1] *= rstd * gg[2 * i + 1] * bfhi(su[i]); }
            *(u32x4*)(OH + off) = pack8(o);
        }
    }
    SEAM(4); STAMP(5);
    if (IN(5)) {
        SchedBranch S{(const char*)OH, (const char*)OM, (const char*)Wb0T, (const char*)Wb1T, G, bx};
        EpiBranch E{GATES, MERGED};
        pg8::gemm_phase(wv, ldsl, 512, 512, S, E);
    }
    SEAM(5); STAMP(6);
    if (IN(6)) {
        SchedSimple S{(const char*)MERGED, (const char*)WoT, 256, 4, G, bx, (size_t)256 * 1024 * 2, (size_t)256 * 1024 * 2};
        EpiOut E{a.x_prompt, a.x_sample, X1B, RSX1};
        pg8::gemm_phase(wv, ldsl, 1024, 1024, S, E);
    }
    SEAM(6); STAMP(7);
    if (IN(7)) {
        SchedSimple S{(const char*)X1B, (const char*)WguT, 256, 22, G, bx, (size_t)256 * 1024 * 2, (size_t)256 * 1024 * 2};
        EpiGU E{RSX1, ACT};
        pg8::gemm_phase(wv, ldsl, 1024, 1024, S, E);
    }
    SEAM(7); STAMP(8);
    if (PROBE_SEL) grid_barrier((unsigned*)(ws + WS_XBAR), wv, (volatile LAS unsigned*)(ldsl + LDS_CTL + 32));
    if (IN(8)) { TIDS
        SchedPanel S{(const char*)ACT, (const char*)WdT, G, bx, (size_t)256 * DFF * 2, (size_t)256 * DFF * 2};
        EpiDown E{X1B, a.out, RSX2};
        pg8::gemm_phase(wv, ldsl, DFF, DFF, S, E);
        asm volatile("s_waitcnt vmcnt(0)" ::: "memory");
        __builtin_amdgcn_fence(__ATOMIC_RELEASE, "workgroup"); __syncthreads();
        float pert = 0.f;
        if (PROBE_SEL) { const unsigned long long* ts = (const unsigned long long*)(ws + WS_TS); float tus = 0.f;
            if (PROBE_SEL == 1) tus = (float)(ts[4] - ts[3]) * 0.01f;
            if (PROBE_SEL == 2) tus = (float)(ts[16] - ts[3]) * 0.01f;
            if (PROBE_SEL == 3) tus = (float)(ts[17] - ts[3]) * 0.01f;
            if (PROBE_SEL == 4) tus = (float)((ts[1] - ts[0])) * 0.01f;
            if (PROBE_SEL == 5) tus = (float)((ts[5] - ts[4])) * 0.01f;
            if (PROBE_SEL == 6) tus = (float)((ts[8] - ts[0])) * 0.01f;
            if (PROBE_SEL == 8) tus = (float)((ts[2] - ts[1])) * 0.01f;
            if (PROBE_SEL == 9) tus = (float)((ts[8] - ts[7])) * 0.01f;
            pert = sqrtf(tus * 1e-9f); }
        for (int p = bx; p < 256; p += G)
            for (int r = wave; r < 256; r += 8) { const int m = p * 256 + r;
                const float rstd = __builtin_amdgcn_rsqf(__hip_atomic_load(RSX2 + m, __ATOMIC_RELAXED, __HIP_MEMORY_SCOPE_AGENT) * (1.f / 1024.f) + EPS);
                f32x4* yr = (f32x4*)(a.out + (size_t)m * 1024) + lane;
#pragma unroll
                for (int j = 0; j < 4; ++j) { const f32x4 g = ((const f32x4*)a.g_final)[64 * j + lane]; f32x4 v = yr[64 * j]; v.x = v.x * rstd * g.x + pert; v.y = v.y * rstd * g.y - pert; v.z = v.z * rstd * g.z + pert; v.w = v.w * rstd * g.w - pert; yr[64 * j] = v; }
            }
        if (PROBE_SEL == 7) {
            asm volatile("s_waitcnt vmcnt(0)" ::: "memory"); __syncthreads();
            unsigned long long* ts = (unsigned long long*)(ws + WS_TS);
            if (wv == 0 && lane == 0) { atomicMax(ts + 18, (unsigned long long)__builtin_amdgcn_s_memrealtime()); __threadfence(); atomicAdd((unsigned*)(ts + 19), 1u); }
            if (bx == 0) {
                if (wv == 0 && lane == 0) { while (__hip_atomic_load((unsigned*)(ts + 19), __ATOMIC_RELAXED, __HIP_MEMORY_SCOPE_AGENT) < (unsigned)G) __builtin_amdgcn_s_sleep(8); }
                __syncthreads();
                const unsigned long long tend = __hip_atomic_load(ts + 18, __ATOMIC_RELAXED, __HIP_MEMORY_SCOPE_AGENT), t0 = __hip_atomic_load(ts + 0, __ATOMIC_RELAXED, __HIP_MEMORY_SCOPE_AGENT);
                const float tus = (float)(tend - t0) * 0.01f; const float pe = sqrtf(tus * 256e-9f);
                for (int r = wave; r < 256; r += 8) { f32x4* yr = (f32x4*)(a.out + (size_t)r * 1024) + lane;
#pragma unroll
                    for (int j = 0; j < 4; ++j) { f32x4 v = yr[64 * j]; v.x += pe; v.y -= pe; v.z += pe; v.w -= pe; yr[64 * j] = v; } }
            }
        }
    }
#undef IN
#undef SEAM
}

extern "C" void kernel_launch(void* const* d_in, const int* in_sizes, int n_in, void* d_out, int out_size, void* d_ws, size_t ws_size, hipStream_t stream) {
    static int grid = 0;
    if (grid == 0) {
        if (n_in != 16 || out_size != M * DM || ws_size < WS_END) { fprintf(stderr, "kernel_launch: unexpected shapes: n_in %d out %d ws %zu (need %zu)\n", n_in, out_size, ws_size, (size_t)WS_END); grid = -1; return; }
        int dev = 0, cus = 0, per_cu = 0;
        if (hipGetDevice(&dev) != hipSuccess || hipDeviceGetAttribute(&cus, hipDeviceAttributeMultiprocessorCount, dev) != hipSuccess) { grid = -1; return; }
        if (hipFuncSetAttribute((const void*)fwd_megakernel, hipFuncAttributeMaxDynamicSharedMemorySize, LDS_BYTES) != hipSuccess) { fprintf(stderr, "kernel_launch: hipFuncSetAttribute failed\n"); grid = -1; return; }
        if (hipOccupancyMaxActiveBlocksPerMultiprocessor(&per_cu, (const void*)fwd_megakernel, 512, LDS_BYTES) != hipSuccess || per_cu < 1) { fprintf(stderr, "kernel_launch: occupancy query says %d\n", per_cu); per_cu = 1; }
        (void)hipGetLastError();
        grid = cus;
    }
    if (grid < 0) return;
    Args a{};
    a.x_prompt = (const float*)d_in[0]; a.x_sample = (const float*)d_in[1]; a.g_mix = (const float*)d_in[2]; a.w_in = (const float*)d_in[3]; a.lb_param = (const float*)d_in[4];
    a.g_onorm = (const float*)d_in[5]; a.g_qa = (const float*)d_in[6]; a.w_uq = (const float*)d_in[7]; a.g_kva = (const float*)d_in[8]; a.w_ukv = (const float*)d_in[9];
    a.w_branch = (const float*)d_in[10]; a.w_out = (const float*)d_in[11]; a.g_ffn = (const float*)d_in[12]; a.w_gate_up = (const float*)d_in[13]; a.w_down = (const float*)d_in[14]; a.g_final = (const float*)d_in[15];
    a.out = (float*)d_out; a.ws = (unsigned char*)d_ws;
    for (int i = 0; i < 16; ++i) a.inv_rev[i] = pow(10000.0, -(double)i / 16.0) / 6.283185307179586476925;
    a.ph_lo = 0; a.ph_hi = 9;
    void* args[] = {&a};
    const hipError_t e = hipLaunchCooperativeKernel((const void*)fwd_megakernel, dim3(grid), dim3(512), args, LDS_BYTES, stream);
    if (e != hipSuccess) fprintf(stderr, "kernel_launch: cooperative launch failed: %s (grid %d)\n", hipGetErrorString(e), grid);
}
```

```cpp
#include <hip/hip_runtime.h>
#include <hip/hip_cooperative_groups.h>
#include <hip/hip_bf16.h>
#include <cstdio>
#include <cstdint>
#include <cmath>
namespace cg = cooperative_groups;

#define LAS __attribute__((address_space(3)))
typedef unsigned short bf16_t;
typedef short bf16x8 __attribute__((ext_vector_type(8)));
typedef short s16x4 __attribute__((ext_vector_type(4)));
typedef float f32x4 __attribute__((ext_vector_type(4)));
typedef float f32x2 __attribute__((ext_vector_type(2)));
typedef float f32x16 __attribute__((ext_vector_type(16)));
typedef unsigned u32x4 __attribute__((ext_vector_type(4)));
typedef unsigned u32x2 __attribute__((ext_vector_type(2)));
typedef __bf16 bf16x2_t __attribute__((ext_vector_type(2)));
typedef _Float16 h16x8 __attribute__((ext_vector_type(8)));

constexpr int M = 65536, DM = 1024, T0 = 32768;
constexpr int NIN = 5376;
constexpr int DFF = 2816;
constexpr float EPS = 1e-6f;
constexpr float QSCALE = 0.10206207261596575f * 1.4426950408889634f;
constexpr size_t MiB = 1u << 20;
constexpr size_t WS_XBAR = 32768;
constexpr size_t WS_QUEUE = 0, WS_BAR = 4096, WS_TS = 8192, WS_KMAX = 16384;
#ifndef PROBE_SEL
#define PROBE_SEL 0
#endif
constexpr size_t WS_RSQ = 1 * MiB, WS_RSKV = WS_RSQ + 262144, WS_RSX1 = WS_RSKV + 262144, WS_RSX2 = WS_RSX1 + 262144;
constexpr size_t CTL_ZERO = 2 * MiB;
constexpr size_t WS_ROPE = 2 * MiB;
constexpr size_t WS_WIN = 4 * MiB, WS_WUQ = 15 * MiB, WS_WUKV = 15 * MiB + 512 * 1024, WS_WB0 = 16 * MiB, WS_WB1 = 17 * MiB, WS_WO = 18 * MiB, WS_WGU = 20 * MiB, WS_WD = 31 * MiB;
constexpr size_t WS_XN = 40 * MiB, WS_OFW = 40 * MiB, WS_OBW = 104 * MiB, WS_X1B = 40 * MiB;
constexpr size_t WS_HQ = 168 * MiB, WS_HI = 232 * MiB, WS_GF = 296 * MiB, WS_GB = 360 * MiB, WS_SG = 424 * MiB, WS_LAT = 488 * MiB;
constexpr size_t WS_Q = 552 * MiB, WS_K = 648 * MiB, WS_V = 744 * MiB, WS_OM = 808 * MiB;
constexpr size_t WS_OH = 168 * MiB, WS_MERGED = 232 * MiB, WS_X1 = 552 * MiB, WS_ACT = 168 * MiB;
constexpr size_t WS_END = 872 * MiB;
constexpr int LDS_BYTES = 155648;
constexpr int LDS_CTL = 155648 - 256;

__device__ __forceinline__ unsigned cvtpk(float lo, float hi) { f32x2 v = {lo, hi}; bf16x2_t b = __builtin_convertvector(v, bf16x2_t); return __builtin_bit_cast(unsigned, b); }
__device__ __forceinline__ float bf2f(unsigned short u) { return __builtin_bit_cast(float, (unsigned)u << 16); }
__device__ __forceinline__ float bflo(unsigned u) { return __builtin_bit_cast(float, u << 16); }
__device__ __forceinline__ float bfhi(unsigned u) { return __builtin_bit_cast(float, u & 0xffff0000u); }
__device__ __forceinline__ float sigmoidf_(float x) { return __builtin_amdgcn_rcpf(1.f + __expf(-x)); }
__device__ __forceinline__ float siluf_(float x) { return x * sigmoidf_(x); }
__device__ __forceinline__ u32x4 pack8(const float* v) { u32x4 w; w.x = cvtpk(v[0], v[1]); w.y = cvtpk(v[2], v[3]); w.z = cvtpk(v[4], v[5]); w.w = cvtpk(v[6], v[7]); return w; }
__device__ __forceinline__ int crow(int r, int hi) { return (r & 3) + 8 * (r >> 2) + 4 * hi; }
__device__ __forceinline__ const float* xrow_ptr(const float* xp, const float* xs, int row) { return row < T0 ? xp + (size_t)row * DM : xs + (size_t)(row - T0) * DM; }
__device__ __forceinline__ int row_seq(int row) { return row < T0 ? (row >> 13) : 4 + ((row - T0) >> 14); }
__device__ __forceinline__ int row_pos(int row) { return row < T0 ? (row & 8191) : (row & 16383); }
#define SBAR() __builtin_amdgcn_sched_barrier(0)
__device__ __forceinline__ int lane_id() { int l; asm volatile("v_mbcnt_lo_u32_b32 %0, -1, 0\n\tv_mbcnt_hi_u32_b32 %0, -1, %0" : "=v"(l)); return l; }

namespace pg8 {
constexpr int BM = 256, BK = 64, HALF = 128, HTB = HALF * BK * 2, STAGE_BYTES = 8 * HTB, NXCD = 8, WGM = 4;
__device__ __forceinline__ int lds_byte(int r, int c) { const int st = (r >> 4) * 2 + (c >> 5), rr = r & 15, cc = c & 31, ob = rr * 64 + cc * 2; return st * 1024 + (ob ^ (((ob >> 9) & 1) << 5)); }
__device__ __forceinline__ void stage_rc(int b, int& R, int& C) { const int st = b / 1024, sb = b % 1024, swz = sb ^ (((sb >> 9) & 1) << 5); R = (st >> 1) * 16 + swz / 64; C = (st & 1) * 32 + (swz % 64) / 2; }
__device__ __forceinline__ int perm32(int rho) { const int n = rho >> 4, i = rho & 15; return 8 * (i >> 2) + 4 * n + (i & 3); }
struct Unit { int pm, pn, tag; const char* a; const char* b; };
__device__ __forceinline__ void tile_of(int L, int nM, int nN, int& pm, int& pn) {
    const int nwg = nM * nN; int wgid = L;
    { const int q = nwg / NXCD, r = nwg % NXCD, xcd = wgid % NXCD, off = wgid / NXCD; wgid = (xcd < r ? xcd * (q + 1) : r * (q + 1) + (xcd - r) * q) + off; }
    const int nig = WGM * nN, gid = wgid / nig, fm = gid * WGM, gsz = (nM - fm) < WGM ? (nM - fm) : WGM;
    pm = fm + ((wgid % nig) % gsz); pn = (wgid % nig) / gsz;
}
template <class Epi, class Sched>
__device__ __forceinline__ void gemm_phase(const int wv, LAS unsigned char* lds, const int K, const int lda, const Sched& S, const Epi& E) {
    const int lane = lane_id(), wid = wv, tid = wv * 64 + lane, wr = wid >> 2, wc = wid & 3, fr = lane & 15, fq = lane >> 4;
    const int nt = K / BK;
    unsigned voffA[2], voffB[2];
#pragma unroll
    for (int i = 0; i < 2; ++i) { int R, C; stage_rc(tid * 16 + i * 8192, R, C); const int Rb = (R & ~31) + perm32(R & 31);
        voffA[i] = (unsigned)(R * lda + C) * 2u; voffB[i] = (unsigned)(Rb * K + C) * 2u; }
    const size_t kstep = (size_t)(BK * 2);
    const size_t hA = (size_t)HALF * lda * 2, hB = (size_t)HALF * K * 2;
    const unsigned ldsw = (unsigned)wid * 1024u;
    const int aoff = lds_byte(wr * 64 + fr, fq * 8), boff = lds_byte(wc * 32 + fr, fq * 8);
#define PG8_SA(b, h) (((b) * 2 + (h)) * HTB)
#define PG8_SB(b, h) ((4 + (b) * 2 + (h)) * HTB)
#define PG8_STAGE(bufoff, gbase, voff) do { _Pragma("unroll") for (int _i = 0; _i < 2; ++_i) \
        __builtin_amdgcn_global_load_lds((const unsigned*)((const char*)(gbase) + (voff)[_i]), (LAS unsigned*)(lds + (bufoff) + ldsw + _i * 8192), 16, 0, 0); } while (0)
#define PG8_LDA(dst, b, h) do { _Pragma("unroll") for (int m = 0; m < 4; ++m) _Pragma("unroll") for (int k = 0; k < 2; ++k) dst[m][k] = *(const LAS bf16x8*)(lds + PG8_SA(b, h) + aoff + m * 2048 + k * 1024); } while (0)
#define PG8_LDB(dst, b, h) do { _Pragma("unroll") for (int n = 0; n < 2; ++n) _Pragma("unroll") for (int k = 0; k < 2; ++k) dst[n][k] = *(const LAS bf16x8*)(lds + PG8_SB(b, h) + boff + n * 2048 + k * 1024); } while (0)
#define PG8_MMA(ai, bj, At, Bt) do { __builtin_amdgcn_s_setprio(1); _Pragma("unroll") for (int m = 0; m < 4; ++m) _Pragma("unroll") for (int n = 0; n < 2; ++n) _Pragma("unroll") for (int k = 0; k < 2; ++k) \
        acc[ai][bj][m][n] = __builtin_amdgcn_mfma_f32_16x16x32_bf16(Bt[n][k], At[m][k], acc[ai][bj][m][n], 0, 0, 0); __builtin_amdgcn_s_setprio(0); } while (0)
#define PG8_WAIT_V(n) asm volatile("s_waitcnt vmcnt(" #n ")" ::: "memory")
#define PG8_WAIT_L(n) asm volatile("s_waitcnt lgkmcnt(" #n ")" ::: "memory")
#define PG8_BAR __builtin_amdgcn_s_barrier()
#define PG8_SCHED __builtin_amdgcn_sched_barrier(0)
    Unit cur, nxt; int ui = 0;
    if (!S.next(0, cur)) return;
    f32x4 acc[2][2][4][2];
#pragma unroll
    for (int a = 0; a < 2; ++a)
#pragma unroll
        for (int b = 0; b < 2; ++b)
#pragma unroll
            for (int m = 0; m < 4; ++m)
#pragma unroll
                for (int n = 0; n < 2; ++n) acc[a][b][m][n] = (f32x4){0.f, 0.f, 0.f, 0.f};
    bf16x8 At[4][2], B0[2][2], B1[2][2];
    const char* cA = cur.a; const char* cB = cur.b;
    PG8_STAGE(PG8_SB(0, 0), cB, voffB); PG8_STAGE(PG8_SB(0, 1), cB + hB, voffB); PG8_STAGE(PG8_SA(0, 0), cA, voffA); PG8_STAGE(PG8_SA(0, 1), cA + hA, voffA);
    if (wr == 1) PG8_BAR;
    PG8_WAIT_V(2); PG8_BAR;
    PG8_STAGE(PG8_SB(1, 0), cB + kstep, voffB); PG8_STAGE(PG8_SA(1, 0), cA + kstep, voffA); PG8_STAGE(PG8_SB(1, 1), cB + hB + kstep, voffB);
    PG8_WAIT_V(6); PG8_BAR;
    for (;;) {
        const bool has_next = S.next(ui + 1, nxt);
        const char* nA = has_next ? nxt.a : cA; const char* nB = has_next ? nxt.b : cB;
        for (int t = 0; t < nt; t += 2) {
            const bool last = (t == nt - 2);
            const char* a1 = cA + (size_t)(t + 1) * kstep;
            const char* a2 = last ? nA : cA + (size_t)(t + 2) * kstep; const char* b2 = last ? nB : cB + (size_t)(t + 2) * kstep;
            const char* a3 = a2 + kstep; const char* b3 = b2 + kstep;
            PG8_LDB(B0, 0, 0); PG8_LDB(B1, 0, 1); PG8_SCHED; PG8_LDA(At, 0, 0); PG8_STAGE(PG8_SA(1, 1), a1 + hA, voffA);
            PG8_WAIT_V(8); PG8_WAIT_L(0); PG8_BAR; PG8_MMA(0, 0, At, B0); PG8_MMA(0, 1, At, B1); PG8_BAR; PG8_SCHED;
            PG8_LDA(At, 0, 1); PG8_STAGE(PG8_SB(0, 0), b2, voffB); PG8_STAGE(PG8_SB(0, 1), b2 + hB, voffB); PG8_STAGE(PG8_SA(0, 0), a2, voffA);
            PG8_WAIT_V(8); PG8_WAIT_L(0); PG8_BAR; PG8_MMA(1, 0, At, B0); PG8_MMA(1, 1, At, B1); PG8_BAR; PG8_SCHED;
            PG8_LDB(B0, 1, 0); PG8_LDB(B1, 1, 1); PG8_SCHED; PG8_LDA(At, 1, 0); PG8_STAGE(PG8_SA(0, 1), a2 + hA, voffA);
            PG8_WAIT_V(8); PG8_WAIT_L(0); PG8_BAR; PG8_MMA(0, 0, At, B0); PG8_MMA(0, 1, At, B1); PG8_BAR; PG8_SCHED;
            PG8_LDA(At, 1, 1); PG8_STAGE(PG8_SB(1, 0), b3, voffB); PG8_STAGE(PG8_SB(1, 1), b3 + hB, voffB); PG8_STAGE(PG8_SA(1, 0), a3, voffA);
            PG8_WAIT_V(8); PG8_WAIT_L(0); PG8_BAR; PG8_MMA(1, 0, At, B0); PG8_MMA(1, 1, At, B1); PG8_BAR; PG8_SCHED;
        }
        if (wr == 0) PG8_BAR;
        const int l2_ = lane_id(); const int fr_ = l2_ & 15, fq_ = l2_ >> 4;
        const bool keep = E(acc, cur, wr, wc, fr_, fq_);
        if (!has_next) break;
        if (!keep) {
#pragma unroll
        for (int a = 0; a < 2; ++a)
#pragma unroll
            for (int b = 0; b < 2; ++b)
#pragma unroll
                for (int m = 0; m < 4; ++m)
#pragma unroll
                    for (int n = 0; n < 2; ++n) acc[a][b][m][n] = (f32x4){0.f, 0.f, 0.f, 0.f};
        }
        cur = nxt; cA = nA; cB = nB; ++ui;
        if (wr == 1) PG8_BAR;
    }
    PG8_WAIT_V(0);
    PG8_BAR;
#undef PG8_SA
#undef PG8_SB
#undef PG8_STAGE
#undef PG8_LDA
#undef PG8_LDB
#undef PG8_MMA
#undef PG8_WAIT_V
#undef PG8_WAIT_L
#undef PG8_BAR
#undef PG8_SCHED
}
}
using pg8::Unit;
typedef f32x4 Acc[2][2][4][2];
#define EPI_ROWS(ai, m, row) _Pragma("unroll") for (int ai = 0; ai < 2; ++ai) _Pragma("unroll") for (int m = 0; m < 4; ++m) { const int row = u.pm * 256 + ai * 128 + wr * 64 + m * 16 + fr;
#define EPI_END asm volatile("" ::: "memory"); }
__device__ __forceinline__ void get8(const Acc& acc, int ai, int bj, int m, float* v) {
    const f32x4 a = acc[ai][bj][m][0], b = acc[ai][bj][m][1]; v[0] = a[0]; v[1] = a[1]; v[2] = a[2]; v[3] = a[3]; v[4] = b[0]; v[5] = b[1]; v[6] = b[2]; v[7] = b[3]; }

struct Args {
    const float *x_prompt, *x_sample, *g_mix, *w_in, *lb_param, *g_onorm, *g_qa, *w_uq, *g_kva, *w_ukv, *w_branch, *w_out, *g_ffn, *w_gate_up, *w_down, *g_final;
    float* out; unsigned char* ws;
    double inv_rev[16];
    int ph_lo, ph_hi;
};

struct SchedSimple {
    const char* A; const char* B; int nM, nN, G, c; size_t tA, tB;
    __device__ __forceinline__ bool next(int i, Unit& u) const { const long L = (long)i * G + c; if (L >= (long)nM * nN) return false; pg8::tile_of((int)L, nM, nN, u.pm, u.pn); u.tag = 0; u.a = A + u.pm * tA; u.b = B + u.pn * tB; return true; }
};
struct SchedUp {
    const char* LAT; const char* Wuq; const char* Wukv; int G, c;
    __device__ __forceinline__ bool next(int i, Unit& u) const { const long L = (long)i * G + c; if (L >= 256L * 7) return false; pg8::tile_of((int)L, 256, 7, u.pm, u.pn); u.tag = 0;
        u.a = LAT + (size_t)u.pm * 256 * 512 * 2 + (u.pn >= 3 ? 512 : 0); u.b = u.pn < 3 ? Wuq + (size_t)u.pn * 256 * 256 * 2 : Wukv + (size_t)(u.pn - 3) * 256 * 256 * 2; return true; }
};
struct SchedBranch {
    const char* OH; const char* OMm; const char* W0; const char* W1; int G, c;
    __device__ __forceinline__ bool next(int i, Unit& u) const { const long L = (long)(i >> 1) * G + c; if (L >= 256L * 4) return false; pg8::tile_of((int)L, 256, 4, u.pm, u.pn); u.tag = i & 1;
        u.a = ((i & 1) ? OMm : OH) + (size_t)u.pm * 256 * 512 * 2; u.b = ((i & 1) ? W1 : W0) + (size_t)u.pn * 256 * 512 * 2; return true; }
};

struct SchedPanel {
    const char* A; const char* B; int G, c; size_t tA, tB;
    __device__ __forceinline__ bool next(int i, Unit& u) const { const int p = c + (i >> 2) * G; if (p >= 256) return false; u.pm = p; u.pn = i & 3; u.tag = 0; u.a = A + p * tA; u.b = B + u.pn * tB; return true; }
};
struct EpiIn {
    unsigned char* ws; bf16_t *GATES; const float* lbp;
    __device__ __forceinline__ bool operator()(const Acc& acc, const Unit& u, int wr, int wc, int fr, int fq) const {
        const int pn = u.pn, cb = wc * 32 + 8 * fq;
        if (pn < 4 || (pn >= 8 && pn < 10)) {
            bf16_t* dst = (bf16_t*)(ws + (pn < 2 ? WS_HQ : (pn < 4 ? WS_HI : WS_SG))); const int c0 = (pn & 1) * 256; const bool act = (pn < 2 || pn >= 8);
            EPI_ROWS(ai, m, row)
#pragma unroll
                for (int bj = 0; bj < 2; ++bj) { float v[8]; get8(acc, ai, bj, m, v);
                    if (act) {
#pragma unroll
                        for (int i = 0; i < 8; ++i) v[i] = siluf_(v[i]); }
                    *(u32x4*)(dst + (size_t)row * 512 + c0 + bj * 128 + cb) = pack8(v); }
            EPI_END
        } else if (pn < 8) {
            const int dir = (pn >= 6); _Float16* dst = (_Float16*)(ws + (dir ? WS_GB : WS_GF)); const int c0 = (pn & 1) * 256;
            float lb[2][8];
#pragma unroll
            for (int bj = 0; bj < 2; ++bj)
#pragma unroll
                for (int i = 0; i < 8; ++i) { const int col = c0 + bj * 128 + cb + i; lb[bj][i] = sigmoidf_(lbp[dir * 512 + col] - lbp[1024 + dir * 512 + col]); }
            EPI_ROWS(ai, m, row)
#pragma unroll
                for (int bj = 0; bj < 2; ++bj) { float v[8]; get8(acc, ai, bj, m, v); h16x8 h;
#pragma unroll
                    for (int i = 0; i < 8; ++i) { const float f = lb[bj][i] + (1.f - lb[bj][i]) * sigmoidf_(v[i]); h[i] = (_Float16)__logf(f); }
                    *(u32x4*)(dst + (size_t)row * 512 + c0 + bj * 128 + cb) = __builtin_bit_cast(u32x4, h); }
            EPI_END
        } else if (pn < 12) {
            float* RS = (float*)(ws + (pn == 10 ? WS_RSQ : WS_RSKV)); const int c0 = (pn - 10) * 256; bf16_t* LAT = (bf16_t*)(ws + WS_LAT);
            EPI_ROWS(ai, m, row)
                float ss = 0.f;
#pragma unroll
                for (int bj = 0; bj < 2; ++bj) { float v[8]; get8(acc, ai, bj, m, v);
#pragma unroll
                    for (int i = 0; i < 8; ++i) ss += v[i] * v[i];
                    *(u32x4*)(LAT + (size_t)row * 512 + c0 + bj * 128 + cb) = pack8(v); }
                ss += __shfl_xor(ss, 16); ss += __shfl_xor(ss, 32);
                if (fq == 0) atomicAdd(RS + row, ss);
            EPI_END
        } else if (pn < 20) {
            const int c0 = (pn - 12) * 256;
            EPI_ROWS(ai, m, row)
#pragma unroll
                for (int bj = 0; bj < 2; ++bj) { float v[8]; get8(acc, ai, bj, m, v);
#pragma unroll
                    for (int i = 0; i < 8; ++i) v[i] = sigmoidf_(v[i]);
                    *(u32x4*)(GATES + (size_t)row * 2048 + c0 + bj * 128 + cb) = pack8(v); }
            EPI_END
        } else {
            bf16_t* Kc = (bf16_t*)(ws + WS_K); const f32x2* rope = (const f32x2*)(ws + WS_ROPE); float kmx = 0.f;
            EPI_ROWS(ai, m, row)
                float v[8], p[8]; get8(acc, ai, 0, m, v);
                { float ss = 0.f;
#pragma unroll
                  for (int i = 0; i < 8; ++i) ss += v[i] * v[i];
                  ss += __shfl_xor(ss, 16); ss += __shfl_xor(ss, 32); kmx = fmaxf(kmx, ss); }
#pragma unroll
                for (int i = 0; i < 8; ++i) p[i] = __shfl_xor(v[i], 32);
                if (wc == 0) {
                    const int pos = row_pos(row); const f32x2* cs = rope + pos * 16 + 8 * (fq & 1); float o[8];
#pragma unroll
                    for (int i = 0; i < 8; ++i) { const f32x2 c = cs[i]; o[i] = (fq < 2) ? (v[i] * c.x - p[i] * c.y) : (v[i] * c.x + p[i] * c.y); }
                    const u32x4 w = pack8(o);
#pragma unroll
                    for (int h = 0; h < 8; ++h) *(u32x4*)(Kc + ((size_t)row * 8 + h) * 96 + 64 + 8 * fq) = w;
                }
            EPI_END
            if (wc == 0) { kmx = fmaxf(kmx, __shfl_xor(kmx, 1)); kmx = fmaxf(kmx, __shfl_xor(kmx, 2)); kmx = fmaxf(kmx, __shfl_xor(kmx, 4)); kmx = fmaxf(kmx, __shfl_xor(kmx, 8));
                if (fr == 0 && fq == 0) { unsigned* KM = (unsigned*)(ws + WS_KMAX) + row_seq(u.pm * 256) * 32;
#pragma unroll
                    for (int h = 0; h < 8; ++h) atomicMax(KM + h * 4 + 2, __float_as_uint(kmx)); } }
        }
        return false;
    }
};
struct EpiUp {
    bf16_t *Q, *Kc, *V; const float *RSQ, *RSKV; const f32x2* rope; unsigned* KMAX;
    __device__ __forceinline__ bool operator()(const Acc& acc, const Unit& u, int wr, int wc, int fr, int fq) const {
        const int pn = u.pn, cb = wc * 32 + 8 * fq;
#define LOAD_RSV(RSp) float rsv[2][4]; { int rb_ = u.pm * 256 + wr * 64 + fr; asm volatile("" : "+v"(rb_)); const float* rp_ = (RSp) + rb_; _Pragma("unroll") for (int ai = 0; ai < 2; ++ai) _Pragma("unroll") for (int m = 0; m < 4; ++m) rsv[ai][m] = rp_[ai * 128 + m * 16]; }
        if (pn < 2) { LOAD_RSV(RSQ)
            EPI_ROWS(ai, m, row)
                const float sc = __builtin_amdgcn_rsqf(rsv[ai][m] * (1.f / 256.f) + EPS) * QSCALE;
#pragma unroll
                for (int bj = 0; bj < 2; ++bj) { float v[8]; get8(acc, ai, bj, m, v);
#pragma unroll
                    for (int i = 0; i < 8; ++i) v[i] *= sc;
                    const int cg_ = pn * 256 + bj * 128 + cb, h = cg_ >> 6, d = cg_ & 63;
                    *(u32x4*)(Q + ((size_t)row * 8 + h) * 96 + d) = pack8(v); }
            EPI_END
        } else if (pn == 2) {
            EPI_ROWS(ai, m, row)
                const float sc = __builtin_amdgcn_rsqf(RSQ[row] * (1.f / 256.f) + EPS) * QSCALE;
                const int pos = row_pos(row); const f32x2* cs = rope + pos * 16 + 8 * (fq & 1);
#pragma unroll
                for (int bj = 0; bj < 2; ++bj) { float v[8], p[8], o[8]; get8(acc, ai, bj, m, v);
#pragma unroll
                    for (int i = 0; i < 8; ++i) p[i] = __shfl_xor(v[i], 32);
#pragma unroll
                    for (int i = 0; i < 8; ++i) { const f32x2 c = cs[i]; o[i] = ((fq < 2) ? (v[i] * c.x - p[i] * c.y) : (v[i] * c.x + p[i] * c.y)) * sc; }
                    const int h = bj * 4 + wc;
                    *(u32x4*)(Q + ((size_t)row * 8 + h) * 96 + 64 + 8 * fq) = pack8(o); asm volatile("" ::: "memory"); }
            EPI_END
        } else {
            float kmx[2] = {0.f, 0.f}; LOAD_RSV(RSKV)
            EPI_ROWS(ai, m, row)
                const float sc = __builtin_amdgcn_rsqf(rsv[ai][m] * (1.f / 256.f) + EPS);
#pragma unroll
                for (int bj = 0; bj < 2; ++bj) { float v[8]; get8(acc, ai, bj, m, v);
#pragma unroll
                    for (int i = 0; i < 8; ++i) v[i] *= sc;
                    const int cg_ = (pn - 3) * 256 + bj * 128 + cb, h = cg_ >> 7, d = cg_ & 127;
                    if (d < 64) { *(u32x4*)(Kc + ((size_t)row * 8 + h) * 96 + d) = pack8(v); float ss = 0.f;
#pragma unroll
                        for (int i = 0; i < 8; ++i) ss += v[i] * v[i];
                        ss += __shfl_xor(ss, 16); ss += __shfl_xor(ss, 32); kmx[bj] = fmaxf(kmx[bj], ss); }
                    else *(u32x4*)(V + ((size_t)row * 8 + h) * 64 + (d - 64)) = pack8(v); }
            EPI_END
            if (wc < 2) {
#pragma unroll
                for (int bj = 0; bj < 2; ++bj) { float k = kmx[bj]; k = fmaxf(k, __shfl_xor(k, 1)); k = fmaxf(k, __shfl_xor(k, 2)); k = fmaxf(k, __shfl_xor(k, 4)); k = fmaxf(k, __shfl_xor(k, 8));
                    if (fr == 0 && fq == 0) atomicMax(KMAX + row_seq(u.pm * 256) * 32 + ((pn - 3) * 2 + bj) * 4 + wc, __float_as_uint(k)); } }
        }
        return false;
    }
};
struct EpiBranch {
    const bf16_t* GATES; bf16_t* MERGED;
    __device__ __forceinline__ bool operator()(Acc& acc, const Unit& u, int wr, int wc, int fr, int fq) const {
        const int cb = wc * 32 + 8 * fq;
#pragma unroll
        for (int ai = 0; ai < 2; ++ai) {
            u32x4 g1v[4][2], g0v[4][2];
#pragma unroll
            for (int m = 0; m < 4; ++m)
#pragma unroll
                for (int bj = 0; bj < 2; ++bj) { const int row = u.pm * 256 + ai * 128 + wr * 64 + m * 16 + fr, col = u.pn * 256 + bj * 128 + cb;
                    g1v[m][bj] = *(const u32x4*)(GATES + (size_t)row * 2048 + 1024 + col); if (u.tag == 0) g0v[m][bj] = *(const u32x4*)(GATES + (size_t)row * 2048 + col); }
#pragma unroll
            for (int m = 0; m < 4; ++m)
#pragma unroll
                for (int bj = 0; bj < 2; ++bj) { const int row = u.pm * 256 + ai * 128 + wr * 64 + m * 16 + fr, col = u.pn * 256 + bj * 128 + cb;
                    const u32x4 g1 = g1v[m][bj]; float g1f[8] = {bflo(g1.x), bfhi(g1.x), bflo(g1.y), bfhi(g1.y), bflo(g1.z), bfhi(g1.z), bflo(g1.w), bfhi(g1.w)};
                    if (u.tag == 0) {
                        const u32x4 g0 = g0v[m][bj]; float g0f[8] = {bflo(g0.x), bfhi(g0.x), bflo(g0.y), bfhi(g0.y), bflo(g0.z), bfhi(g0.z), bflo(g0.w), bfhi(g0.w)};
#pragma unroll
                        for (int i = 0; i < 4; ++i) { acc[ai][bj][m][0][i] *= g0f[i] * __builtin_amdgcn_rcpf(g1f[i]); acc[ai][bj][m][1][i] *= g0f[4 + i] * __builtin_amdgcn_rcpf(g1f[4 + i]); }
                    } else {
                        float v[8]; get8(acc, ai, bj, m, v);
#pragma unroll
                        for (int i = 0; i < 8; ++i) v[i] *= g1f[i];
                        *(u32x4*)(MERGED + (size_t)row * 1024 + col) = pack8(v);
                    } }
            asm volatile("" ::: "memory");
        }
        return u.tag == 0;
    }
};
struct EpiOut {
    const float *xp, *xs; bf16_t* X1B; float* RS;
    __device__ __forceinline__ bool operator()(const Acc& acc, const Unit& u, int wr, int wc, int fr, int fq) const {
        const int cb = wc * 32 + 8 * fq;
#pragma unroll
        for (int ai = 0; ai < 2; ++ai) {
            f32x4 pre[4][2][2];
#pragma unroll
            for (int m = 0; m < 4; ++m) { const int row = u.pm * 256 + ai * 128 + wr * 64 + m * 16 + fr; const float* xr = xrow_ptr(xp, xs, row);
#pragma unroll
                for (int bj = 0; bj < 2; ++bj) { const int col = u.pn * 256 + bj * 128 + cb; pre[m][bj][0] = *(const f32x4*)(xr + col); pre[m][bj][1] = *(const f32x4*)(xr + col + 4); } }
#pragma unroll
            for (int m = 0; m < 4; ++m) { const int row = u.pm * 256 + ai * 128 + wr * 64 + m * 16 + fr; float ss = 0.f;
#pragma unroll
                for (int bj = 0; bj < 2; ++bj) { const int col = u.pn * 256 + bj * 128 + cb; float v[8]; get8(acc, ai, bj, m, v);
                    const f32x4 x0 = pre[m][bj][0], x1 = pre[m][bj][1];
                    v[0] += x0[0]; v[1] += x0[1]; v[2] += x0[2]; v[3] += x0[3]; v[4] += x1[0]; v[5] += x1[1]; v[6] += x1[2]; v[7] += x1[3];
#pragma unroll
                    for (int i = 0; i < 8; ++i) ss += v[i] * v[i];
                    *(u32x4*)(X1B + (size_t)row * 1024 + col) = pack8(v); }
                ss += __shfl_xor(ss, 16); ss += __shfl_xor(ss, 32);
                if (fq == 0) atomicAdd(RS + row, ss); }
            asm volatile("" ::: "memory");
        }
        return false;
    }
};
struct EpiGU {
    const float* RS; bf16_t* ACT;
    __device__ __forceinline__ bool operator()(const Acc& acc, const Unit& u, int wr, int wc, int fr, int fq) const {
        const int cb = wc * 32 + 8 * fq;
        float rsv[2][4];
        { int rb_ = u.pm * 256 + wr * 64 + fr; asm volatile("" : "+v"(rb_)); const float* rp_ = RS + rb_;
#pragma unroll
        for (int ai = 0; ai < 2; ++ai)
#pragma unroll
            for (int m = 0; m < 4; ++m) rsv[ai][m] = rp_[ai * 128 + m * 16]; }
        EPI_ROWS(ai, m, row)
            const float sc = __builtin_amdgcn_rsqf(rsv[ai][m] * (1.f / 1024.f) + EPS);
            float g[8], p[8]; get8(acc, ai, 0, m, g); get8(acc, ai, 1, m, p);
#pragma unroll
            for (int i = 0; i < 8; ++i) g[i] = siluf_(g[i] * sc) * (p[i] * sc);
            *(u32x4*)(ACT + (size_t)row * DFF + u.pn * 128 + cb) = pack8(g);
        EPI_END
        return false;
    }
};
struct EpiDown {
    const bf16_t* X1B; float* X2; float* RS;
    __device__ __forceinline__ bool operator()(const Acc& acc, const Unit& u, int wr, int wc, int fr, int fq) const {
        const int cb = wc * 32 + 8 * fq;
#pragma unroll
        for (int ai = 0; ai < 2; ++ai) {
            u32x4 pre[4][2];
#pragma unroll
            for (int m = 0; m < 4; ++m) { const int row = u.pm * 256 + ai * 128 + wr * 64 + m * 16 + fr;
#pragma unroll
                for (int bj = 0; bj < 2; ++bj) pre[m][bj] = *(const u32x4*)(X1B + (size_t)row * 1024 + u.pn * 256 + bj * 128 + cb); }
#pragma unroll
            for (int m = 0; m < 4; ++m) { const int row = u.pm * 256 + ai * 128 + wr * 64 + m * 16 + fr; float ss = 0.f;
#pragma unroll
                for (int bj = 0; bj < 2; ++bj) { const int col = u.pn * 256 + bj * 128 + cb; float v[8]; get8(acc, ai, bj, m, v);
                    const u32x4 x = pre[m][bj];
                    v[0] += bflo(x.x); v[1] += bfhi(x.x); v[2] += bflo(x.y); v[3] += bfhi(x.y); v[4] += bflo(x.z); v[5] += bfhi(x.z); v[6] += bflo(x.w); v[7] += bfhi(x.w);
#pragma unroll
                    for (int i = 0; i < 8; ++i) ss += v[i] * v[i];
                    *(f32x4*)(X2 + (size_t)row * 1024 + col) = (f32x4){v[0], v[1], v[2], v[3]}; *(f32x4*)(X2 + (size_t)row * 1024 + col + 4) = (f32x4){v[4], v[5], v[6], v[7]}; }
                ss += __shfl_xor(ss, 16); ss += __shfl_xor(ss, 32);
                if (fq == 0) atomicAdd(RS + row, ss); }
            asm volatile("" ::: "memory");
        }
        return false;
    }
};

namespace att {
constexpr int LDQ = 768, LDK = 768, LDV = 512, LDO = 512, KVBLK = 64, QBLK = 32;
constexpr int SHM_K = 64 * 256, SHM_V = 64 * 64 * 2;
#define KSWZ(row, colB) ((row) * 256 + ((colB) ^ (((row) & 15) << 4)))
__device__ __forceinline__ void expA(f32x16& p0) {
#pragma unroll
    for (int r = 0; r < 16; ++r) p0[r] = __builtin_amdgcn_exp2f(p0[r]);
}
__device__ __forceinline__ void finishSM(f32x16& p0, f32x16& p1, float& l_reg, bf16x8& pa0, bf16x8& pa1, bf16x8& pa2, bf16x8& pa3) {
#pragma unroll
    for (int r = 0; r < 16; ++r) p1[r] = __builtin_amdgcn_exp2f(p1[r]);
    float ps = 0;
#pragma unroll
    for (int r = 0; r < 16; ++r) ps += p0[r];
#pragma unroll
    for (int r = 0; r < 16; ++r) ps += p1[r];
    l_reg += ps;
#define PK4(P, BASE, OUT) do { unsigned a0 = cvtpk(P[BASE + 0], P[BASE + 1]), a1 = cvtpk(P[BASE + 2], P[BASE + 3]);   \
    unsigned b0 = cvtpk(P[BASE + 4], P[BASE + 5]), b1 = cvtpk(P[BASE + 6], P[BASE + 7]);                              \
    auto r0 = __builtin_amdgcn_permlane32_swap(a0, b0, false, false); auto r1 = __builtin_amdgcn_permlane32_swap(a1, b1, false, false); \
    u32x4 w = {r0[0], r1[0], r0[1], r1[1]}; OUT = *reinterpret_cast<bf16x8*>(&w); } while (0)
    PK4(p0, 0, pa0); PK4(p0, 8, pa1); PK4(p1, 0, pa2); PK4(p1, 8, pa3);
#undef PK4
}
__device__ __forceinline__ void qkt(f32x16& p0, f32x16& p1, const char* Ks, const bf16x8* qr, const float mrow, int r32, int hi) {
    p0 = f32x16{}; p1 = f32x16{};
#pragma unroll
    for (int d0 = 0; d0 < 6; ++d0) { const int cb = (d0 * 16 + hi * 8) * 2;
        bf16x8 b0 = *reinterpret_cast<const bf16x8*>(Ks + KSWZ(r32, cb));
        bf16x8 b1 = *reinterpret_cast<const bf16x8*>(Ks + KSWZ(32 + r32, cb));
        p0 = __builtin_amdgcn_mfma_f32_32x32x16_bf16(b0, qr[d0], p0, 0, 0, 0);
        p1 = __builtin_amdgcn_mfma_f32_32x32x16_bf16(b1, qr[d0], p1, 0, 0, 0); }
    if (mrow != 0.f) {
#pragma unroll
        for (int r = 0; r < 16; ++r) { p0[r] -= mrow; p1[r] -= mrow; } }
}
__device__ __forceinline__ int v_st(int k, int c) { const int kk = (k & ~0xC) | ((k & 4) << 1) | ((k & 8) >> 1); return ((kk >> 3) * 2 + (c >> 5)) * 512 + ((kk & 7) * 32 + (c & 31)) * 2; }
__device__ __forceinline__ int v_rd_base(int lane) { return ((lane & 3) << 3) | (((lane >> 2) & 3) << 6) | (((lane >> 4) & 1) << 5) | (((lane >> 5) & 1) << 8); }
constexpr int v_rd_off(int d0, int ks, int half) { return d0 * 512 + ks * 2048 + half * 1024; }
template <int OFF> __device__ __forceinline__ s16x4 tr_read(int vb) { s16x4 r; asm volatile("ds_read_b64_tr_b16 %0, %1 offset:%2" : "=&v"(r) : "v"(vb), "i"(OFF) : "memory"); return r; }
template <int D0> __device__ __forceinline__ void pv_one(f32x16& od, int vb, bf16x8 pa0, bf16x8 pa1, bf16x8 pa2, bf16x8 pa3) {
    const s16x4 l0 = tr_read<v_rd_off(D0, 0, 0)>(vb), h0 = tr_read<v_rd_off(D0, 0, 1)>(vb), l1 = tr_read<v_rd_off(D0, 1, 0)>(vb), h1 = tr_read<v_rd_off(D0, 1, 1)>(vb);
    const s16x4 l2 = tr_read<v_rd_off(D0, 2, 0)>(vb), h2 = tr_read<v_rd_off(D0, 2, 1)>(vb), l3 = tr_read<v_rd_off(D0, 3, 0)>(vb), h3 = tr_read<v_rd_off(D0, 3, 1)>(vb);
    asm volatile("s_waitcnt lgkmcnt(0)" ::: "memory"); SBAR();
#define PK(L, H) (bf16x8){L[0], L[1], L[2], L[3], H[0], H[1], H[2], H[3]}
    od = __builtin_amdgcn_mfma_f32_32x32x16_bf16(pa0, PK(l0, h0), od, 0, 0, 0);
    od = __builtin_amdgcn_mfma_f32_32x32x16_bf16(pa1, PK(l1, h1), od, 0, 0, 0);
    od = __builtin_amdgcn_mfma_f32_32x32x16_bf16(pa2, PK(l2, h2), od, 0, 0, 0);
    od = __builtin_amdgcn_mfma_f32_32x32x16_bf16(pa3, PK(l3, h3), od, 0, 0, 0);
#undef PK
}
__device__ __forceinline__ void pv_d0(f32x16* o, int vb, bf16x8 pa0, bf16x8 pa1, bf16x8 pa2, bf16x8 pa3) { pv_one<0>(o[0], vb, pa0, pa1, pa2, pa3); pv_one<1>(o[1], vb, pa0, pa1, pa2, pa3); }

__device__ __forceinline__ void attn_unit(const bf16_t* __restrict__ Qb, const bf16_t* __restrict__ Kh, const bf16_t* __restrict__ Vh, bf16_t* __restrict__ Ob, int seq, float kmax, char* lds, const int wv) {
    const int lane = lane_id(), wid = wv, tid = wv * 64 + lane, r32 = lane & 31, hi = lane >> 5;
    char* V_lds = lds; char* K_lds = lds + 2 * SHM_V;
    float* li_l = (float*)(lds + 2 * SHM_V + 2 * SHM_K) + wid * 64;
    float l_reg = 0; f32x16 o[2] = {}; bf16x8 qr[6];
    const bf16_t* Qw = Qb + (long)(wid * QBLK + r32) * LDQ + hi * 8;
    float qss = 0.f;
#pragma unroll
    for (int d0 = 0; d0 < 6; ++d0) { qr[d0] = *reinterpret_cast<const bf16x8*>(Qw + d0 * 16);
#pragma unroll
        for (int i = 0; i < 8; ++i) { const float f = bf2f((unsigned short)qr[d0][i]); qss += f * f; } }
    { auto rr = __builtin_amdgcn_permlane32_swap(__float_as_uint(qss), __float_as_uint(qss), false, false); qss = __uint_as_float(rr[0]) + __uint_as_float(rr[1]); }
    float mrow = sqrtf(qss) * kmax;
    if (__all(mrow < 64.f)) mrow = 0.f;
    const int kc1 = tid, kc2 = 512 + (tid & 255); const int kr1 = kc1 / 12, kp1 = kc1 % 12, kr2 = kc2 / 12, kp2 = kc2 % 12; const int vr = tid >> 3, vp = tid & 7;
    const int kst1 = KSWZ(kr1, kp1 * 16), kst2 = KSWZ(kr2, kp2 * 16), vst = v_st(vr, vp * 8);
    const int vb0 = (int)(uintptr_t)V_lds + v_rd_base(lane);
    struct { bf16x8 k1, k2, v; } sr_[2];
#define SLOAD(i, k0) do { sr_[i].k1 = *reinterpret_cast<const bf16x8*>(&Kh[(long)((k0) + kr1) * LDK + kp1 * 8]); if (wv < 4) sr_[i].k2 = *reinterpret_cast<const bf16x8*>(&Kh[(long)((k0) + kr2) * LDK + kp2 * 8]); \
    sr_[i].v = *reinterpret_cast<const bf16x8*>(&Vh[(long)((k0) + vr) * LDV + vp * 8]); } while (0)
#define SWRITE(b, i) do { *(bf16x8*)(K_lds + (b) * SHM_K + kst1) = sr_[i].k1; if (wv < 4) *(bf16x8*)(K_lds + (b) * SHM_K + kst2) = sr_[i].k2; *(bf16x8*)(V_lds + (b) * SHM_V + vst) = sr_[i].v; } while (0)
#define SWAIT() do { if (wv < 4) asm volatile("s_waitcnt vmcnt(3)" ::: "memory"); else asm volatile("s_waitcnt vmcnt(2)" ::: "memory"); } while (0)
    f32x16 pA0, pA1, pB0, pB1; bf16x8 pa0, pa1, pa2, pa3; const int NT = seq / KVBLK;
    constexpr int SE = 0, SO = 1;
    SLOAD(SE, 0); asm volatile("s_waitcnt vmcnt(0)" ::: "memory"); SWRITE(0, SE); __syncthreads();
    qkt(pA0, pA1, K_lds, qr, mrow, r32, hi); expA(pA0);
    SLOAD(SO, KVBLK); if (2 < NT) SLOAD(SE, 2 * KVBLK);
    SWAIT(); SWRITE(1, SO); __syncthreads();
    for (int j = 1; j + 1 < NT; j += 2) {
        __builtin_amdgcn_iglp_opt(0); qkt(pB0, pB1, K_lds + SHM_K, qr, mrow, r32, hi);
        finishSM(pA0, pA1, l_reg, pa0, pa1, pa2, pa3); SBAR();
        SLOAD(SO, (j + 2) * KVBLK); SBAR();
        pv_d0(o, vb0, pa0, pa1, pa2, pa3); expA(pB0);
        __syncthreads(); SWAIT(); SWRITE(0, SE);
        __syncthreads();
        __builtin_amdgcn_iglp_opt(0); qkt(pA0, pA1, K_lds, qr, mrow, r32, hi);
        finishSM(pB0, pB1, l_reg, pa0, pa1, pa2, pa3); SBAR();
        if (j + 3 < NT) SLOAD(SE, (j + 3) * KVBLK); SBAR();
        pv_d0(o, vb0 + SHM_V, pa0, pa1, pa2, pa3); expA(pA0);
        __syncthreads(); if (j + 3 < NT) SWAIT(); else asm volatile("s_waitcnt vmcnt(0)" ::: "memory"); SWRITE(1, SO);
        __syncthreads();
    }
    SBAR(); qkt(pB0, pB1, K_lds + SHM_K, qr, mrow, r32, hi);
    finishSM(pA0, pA1, l_reg, pa0, pa1, pa2, pa3); SBAR();
    pv_d0(o, vb0, pa0, pa1, pa2, pa3); expA(pB0);
    __syncthreads();
    finishSM(pB0, pB1, l_reg, pa0, pa1, pa2, pa3); SBAR();
    pv_d0(o, vb0 + SHM_V, pa0, pa1, pa2, pa3);
    { auto rr = __builtin_amdgcn_permlane32_swap(__float_as_uint(l_reg), __float_as_uint(l_reg), false, false); l_reg = __uint_as_float(rr[0]) + __uint_as_float(rr[1]); }
    if (hi == 0) li_l[r32] = l_reg; asm volatile("s_waitcnt lgkmcnt(0)" ::: "memory");
    float rli[16];
#pragma unroll
    for (int r = 0; r < 16; ++r) rli[r] = __builtin_amdgcn_rcpf(li_l[crow(r, hi)]);
    bf16_t* Ow = Ob + (long)(wid * QBLK) * LDO;
#pragma unroll
    for (int r = 0; r < 16; ++r) { const int orow = crow(r, hi);
#pragma unroll
        for (int d0 = 0; d0 < 2; ++d0) Ow[(long)orow * LDO + d0 * 32 + r32] = (bf16_t)(cvtpk(o[d0][r] * rli[r], 0.f) & 0xffffu); }
    __syncthreads();
#undef SLOAD
#undef SWRITE
#undef SWAIT
}
}

namespace hg {
constexpr int QP = 136, TP = 68;
constexpr int OFF_QIN = 0, OFF_KIN = 64 * QP * 2, OFF_KINT = 2 * 64 * QP * 2, OFF_VT = OFF_KINT + 128 * TP * 2, OFF_TOT1 = OFF_VT + 128 * TP * 2, OFF_FAC = OFF_TOT1 + 1024, HALF_BYTES = OFF_FAC + 512;
static_assert(2 * HALF_BYTES <= LDS_CTL, "HGRN LDS");
__device__ __forceinline__ bf16x8 ld2x4(const LAS char* p0, const LAS char* p1) { const s16x4 a = *(const LAS s16x4*)p0, b = *(const LAS s16x4*)p1; return (bf16x8){a[0], a[1], a[2], a[3], b[0], b[1], b[2], b[3]}; }
__device__ __forceinline__ bf16x8 packf8(const f32x16& a, int base) { u32x4 w; w.x = cvtpk(a[base], a[base + 1]); w.y = cvtpk(a[base + 2], a[base + 3]); w.z = cvtpk(a[base + 4], a[base + 5]); w.w = cvtpk(a[base + 6], a[base + 7]); return __builtin_bit_cast(bf16x8, w); }
__device__ __forceinline__ void unit(LAS char* lds, int seqbase, int S, int h, const bf16_t* __restrict__ HQp, const bf16_t* __restrict__ HIp, const _Float16* __restrict__ GFp, const _Float16* __restrict__ GBp, bf16_t* OFWp, bf16_t* OBWp, const int wv) {
    const int lane = lane_id(), tid = wv * 64 + lane, bwd = wv >> 2, ht = tid & 255, w = wv & 3, r32 = lane & 31, hi = lane >> 5;
    LAS char* base = lds + bwd * HALF_BYTES;
    LAS char* QIN = base + OFF_QIN; LAS char* KINT = base + OFF_KINT; LAS char* VT = base + OFF_VT; LAS float* TOT1 = (LAS float*)(base + OFF_TOT1); LAS float* FAC = (LAS float*)(base + OFF_FAC);
    const _Float16* G = bwd ? GBp : GFp; bf16_t* O = bwd ? OBWp : OFWp;
    const int nc = S / 64, part = ht >> 7, d = ht & 127, e0 = 32 * w;
    f32x16 Sacc[4] = {};
    if (part == 1) { TOT1[d] = 0.f; TOT1[128 + d] = 0.f; }
    u32x4 rg[4], rq[4], rv[4];
    const int trb = ht >> 4, c8 = (ht & 15) * 8, tv = (ht >> 2) & 63, ev = (ht & 3) * 8;
    const long jstep = bwd ? -16 * 512 : 16 * 512;
    const size_t gq_off = (size_t)(bwd ? 63 - trb : trb) * 512 + h * 128 + c8, v_off = (size_t)(bwd ? 63 - tv : tv) * 512 + h * 128 + ev;
#define HG_LOADRAW(c) do { const size_t cb_ = (size_t)(seqbase + (bwd ? (nc - 1 - (c)) * 64 : (c) * 64)) * 512 + gq_off; \
    _Pragma("unroll") for (int j = 0; j < 4; ++j) { rg[j] = *(const u32x4*)(G + cb_ + j * jstep); rq[j] = *(const u32x4*)(HQp + cb_ + j * jstep); } } while (0)
#define HG_LOADV(c) do { const size_t cb_ = (size_t)(seqbase + (bwd ? (nc - 1 - (c)) * 64 : (c) * 64)) * 512 + v_off; \
    _Pragma("unroll") for (int j = 0; j < 4; ++j) rv[j] = *(const u32x4*)(HIp + cb_ + 32 * j); } while (0)
    HG_LOADRAW(0); HG_LOADV(0);
    for (int c = 0; c < nc; ++c) {
        const int c0 = seqbase + (bwd ? (nc - 1 - c) * 64 : c * 64);
        LAS char* wq = QIN + (trb * QP + c8) * 2; LAS char* wvt = VT + (ev * TP + tv) * 2; LAS char* colb = QIN + d * 2; LAS char* ktb = KINT + d * TP * 2;
        asm volatile("" : "+v"(wq), "+v"(wvt), "+v"(colb), "+v"(ktb));
#pragma unroll
        for (int j = 0; j < 4; ++j) { *(LAS u32x4*)(wq + j * 16 * QP * 2) = rq[j]; *(LAS u32x4*)(wq + (OFF_KIN - OFF_QIN) + j * 16 * QP * 2) = rg[j]; }
#pragma unroll
        for (int j = 0; j < 4; ++j) { const unsigned vv[4] = {rv[j].x, rv[j].y, rv[j].z, rv[j].w};
#pragma unroll
            for (int i = 0; i < 4; ++i) { *(LAS bf16_t*)(wvt + (32 * j + 2 * i) * TP * 2) = (bf16_t)(vv[i] & 0xffffu); *(LAS bf16_t*)(wvt + (32 * j + 2 * i + 1) * TP * 2) = (bf16_t)(vv[i] >> 16); } }
        __syncthreads();
        if (c + 1 < nc) { HG_LOADRAW(c + 1); HG_LOADV(c + 1); }
        constexpr int KO = OFF_KIN - OFF_QIN;
        if (part == 0) {
            float E1 = 1.f, E2 = 1.f, tot = 0.f;
#pragma unroll 4
            for (int tp = 15; tp >= 0; --tp) { unsigned kpk[2];
#pragma unroll
                for (int s2 = 1; s2 >= 0; --s2) { const int tt = 2 * tp + s2;
                    const float g = (float)*(const LAS _Float16*)(colb + KO + tt * QP * 2), q = bf2f(*(const LAS bf16_t*)(colb + tt * QP * 2));
                    const float f = __expf(g), rf = __expf(-g);
                    const unsigned pq = cvtpk(q * E1, (1.f - f) * E2);
                    *(LAS bf16_t*)(colb + tt * QP * 2) = (bf16_t)(pq & 0xffffu); *(LAS bf16_t*)(colb + KO + tt * QP * 2) = (bf16_t)(pq >> 16); kpk[s2] = pq >> 16;
                    E1 *= rf; E2 *= f; tot += g; }
                *(LAS unsigned*)(ktb + 4 * tp) = kpk[0] | (kpk[1] << 16); }
            FAC[d] = __expf(tot + TOT1[((c + 1) & 1) * 128 + d]);
        } else {
            float E1 = 1.f, E2 = 1.f, tot = 0.f;
#pragma unroll 4
            for (int tp = 16; tp < 32; ++tp) { unsigned kpk[2];
#pragma unroll
                for (int s2 = 0; s2 < 2; ++s2) { const int tt = 2 * tp + s2;
                    const float g = (float)*(const LAS _Float16*)(colb + KO + tt * QP * 2), q = bf2f(*(const LAS bf16_t*)(colb + tt * QP * 2));
                    const float f = __expf(g), rf = __expf(-g);
                    E1 *= f; E2 *= rf; tot += g;
                    const unsigned pq = cvtpk(q * E1, (1.f - f) * E2);
                    *(LAS bf16_t*)(colb + tt * QP * 2) = (bf16_t)(pq & 0xffffu); *(LAS bf16_t*)(colb + KO + tt * QP * 2) = (bf16_t)(pq >> 16); kpk[s2] = pq >> 16; }
                *(LAS unsigned*)(ktb + 4 * tp) = kpk[0] | (kpk[1] << 16); }
            TOT1[(c & 1) * 128 + d] = tot;
        }
        __syncthreads();
        {
            const LAS char* bq16 = QIN + r32 * QP * 2 + 16 * hi; const LAS char* bq8 = QIN + r32 * QP * 2 + 8 * hi;
            const LAS char* bv16 = VT + (e0 + r32) * TP * 2 + 16 * hi; const LAS char* bv8 = VT + (e0 + r32) * TP * 2 + 8 * hi;
            const LAS char* bk16 = KINT + r32 * TP * 2 + 16 * hi; const LAS float* bfac = FAC + 4 * hi; int thr = r32 - 4 * hi;
            asm volatile("" : "+v"(bq16), "+v"(bq8), "+v"(bv16), "+v"(bv8), "+v"(bk16), "+v"(bfac), "+v"(thr));
            constexpr int KOFF = OFF_KIN - OFF_QIN, R32 = 32 * QP * 2;
#pragma unroll
            for (int db = 0; db < 4; ++db)
#pragma unroll
                for (int r4 = 0; r4 < 4; ++r4) { const f32x4 fc = *(const LAS f32x4*)(bfac + 32 * db + 8 * r4); Sacc[db][4 * r4] *= fc.x; Sacc[db][4 * r4 + 1] *= fc.y; Sacc[db][4 * r4 + 2] *= fc.z; Sacc[db][4 * r4 + 3] *= fc.w; }
            f32x16 o0 = {}, o1 = {};
#pragma unroll
            for (int kk = 0; kk < 8; ++kk) { const bf16x8 sf = packf8(Sacc[kk >> 1], 8 * (kk & 1));
                const bf16x8 b0 = ld2x4(bq8 + 32 * kk, bq8 + 32 * kk + 16), b1 = ld2x4(bq8 + R32 + 32 * kk, bq8 + R32 + 32 * kk + 16);
                o0 = __builtin_amdgcn_mfma_f32_32x32x16_bf16(sf, b0, o0, 0, 0, 0);
                o1 = __builtin_amdgcn_mfma_f32_32x32x16_bf16(sf, b1, o1, 0, 0, 0); if (kk & 1) SBAR(); }
            SBAR();
            {
                f32x16 p = {};
#pragma unroll
                for (int kk = 0; kk < 8; ++kk)
                    { p = __builtin_amdgcn_mfma_f32_32x32x16_bf16(*(const LAS bf16x8*)(bq16 + KOFF + 32 * kk), *(const LAS bf16x8*)(bq16 + 32 * kk), p, 0, 0, 0); if ((kk & 3) == 3) SBAR(); }
#pragma unroll
                for (int r = 0; r < 16; ++r) { if ((r & 3) + 8 * (r >> 2) > thr) p[r] = 0.f; }
#pragma unroll
                for (int k2 = 0; k2 < 2; ++k2) o0 = __builtin_amdgcn_mfma_f32_32x32x16_bf16(ld2x4(bv8 + 32 * k2, bv8 + 32 * k2 + 16), packf8(p, 8 * k2), o0, 0, 0, 0);
            }
            SBAR();
            {
                f32x16 p = {};
#pragma unroll
                for (int kk = 0; kk < 8; ++kk)
                    { p = __builtin_amdgcn_mfma_f32_32x32x16_bf16(*(const LAS bf16x8*)(bq16 + KOFF + 32 * kk), *(const LAS bf16x8*)(bq16 + R32 + 32 * kk), p, 0, 0, 0); if ((kk & 3) == 3) SBAR(); }
#pragma unroll
                for (int k2 = 0; k2 < 2; ++k2) o1 = __builtin_amdgcn_mfma_f32_32x32x16_bf16(ld2x4(bv8 + 32 * k2, bv8 + 32 * k2 + 16), packf8(p, 8 * k2), o1, 0, 0, 0);
            }
            SBAR();
            {
                f32x16 p = {};
#pragma unroll
                for (int kk = 0; kk < 8; ++kk)
                    { p = __builtin_amdgcn_mfma_f32_32x32x16_bf16(*(const LAS bf16x8*)(bq16 + KOFF + R32 + 32 * kk), *(const LAS bf16x8*)(bq16 + R32 + 32 * kk), p, 0, 0, 0); if ((kk & 3) == 3) SBAR(); }
#pragma unroll
                for (int r = 0; r < 16; ++r) { if ((r & 3) + 8 * (r >> 2) > thr) p[r] = 0.f; }
#pragma unroll
                for (int k2 = 0; k2 < 2; ++k2) o1 = __builtin_amdgcn_mfma_f32_32x32x16_bf16(ld2x4(bv8 + 64 + 32 * k2, bv8 + 64 + 32 * k2 + 16), packf8(p, 8 * k2), o1, 0, 0, 0);
            }
            SBAR();
#pragma unroll
            for (int kk = 0; kk < 4; ++kk) { const bf16x8 vfr = ld2x4(bv16 + 32 * kk, bv16 + 32 * kk + 8);
#pragma unroll
                for (int db = 0; db < 4; ++db) { const LAS char* kp = bk16 + 32 * db * TP * 2 + 32 * kk; Sacc[db] = __builtin_amdgcn_mfma_f32_32x32x16_bf16(ld2x4(kp, kp + 8), vfr, Sacc[db], 0, 0, 0); } SBAR(); }
            SBAR();
#pragma unroll
            for (int tb = 0; tb < 2; ++tb) { const int tt = 32 * tb + r32, row = c0 + (bwd ? 63 - tt : tt); bf16_t* op = O + (size_t)row * 512 + h * 128 + e0 + 16 * hi;
                const f32x16& oo = tb ? o1 : o0; unsigned dq[4][2];
#pragma unroll
                for (int r4 = 0; r4 < 4; ++r4) { dq[r4][0] = cvtpk(oo[4 * r4], oo[4 * r4 + 1]); dq[r4][1] = cvtpk(oo[4 * r4 + 2], oo[4 * r4 + 3]); }
                const auto s00 = __builtin_amdgcn_permlane32_swap(dq[0][0], dq[2][0], false, false), s01 = __builtin_amdgcn_permlane32_swap(dq[0][1], dq[2][1], false, false);
                const auto s10 = __builtin_amdgcn_permlane32_swap(dq[1][0], dq[3][0], false, false), s11 = __builtin_amdgcn_permlane32_swap(dq[1][1], dq[3][1], false, false);
                *(u32x4*)(op) = (u32x4){s00[0], s01[0], s00[1], s01[1]}; *(u32x4*)(op + 8) = (u32x4){s10[0], s11[0], s10[1], s11[1]}; }
        }
        __syncthreads();
    }
#undef HG_LOADRAW
#undef HG_LOADV
}
}

__device__ __forceinline__ float wave_sum(float v) {
#pragma unroll
    for (int o = 1; o < 64; o <<= 1) v += __shfl_xor(v, o);
    return v;
}
__device__ __forceinline__ void transpose_item(const float* W, int K, int N, int k0, int n0, bf16_t* WT, int dst0, const float* kscale, LAS float* scr, int lane) {
#pragma unroll 8
    for (int i = 0; i < 32; ++i) { const int kk = 2 * i + (lane >> 5); float v = W[(size_t)(k0 + kk) * N + n0 + (lane & 31)]; if (kscale) v *= kscale[k0 + kk]; scr[kk * 33 + (lane & 31)] = v; }
    asm volatile("s_waitcnt lgkmcnt(0)" ::: "memory");
    const int c = lane & 7;
#pragma unroll
    for (int j = 0; j < 4; ++j) { const int n = (lane >> 3) + 8 * j; const LAS float* s = scr + (8 * c) * 33 + n;
        u32x4 o; o.x = cvtpk(s[0 * 33], s[1 * 33]); o.y = cvtpk(s[2 * 33], s[3 * 33]); o.z = cvtpk(s[4 * 33], s[5 * 33]); o.w = cvtpk(s[6 * 33], s[7 * 33]);
        *(u32x4*)(WT + (size_t)(dst0 + n) * K + k0 + 8 * c) = o; }
    asm volatile("s_waitcnt lgkmcnt(0)" ::: "memory");
}

#define XB_TMO      128
#define XB_XCNT(j)  (256  + 64 * (j))
#define XB_XSUB(j)  (1280 + 64 * (j))
#define XB_XGEN(j)  (2304 + 64 * (j))
#define XB_TOP      3328
#define XB_TOPGEN   3392
#define XB_SPIN_CAP (1u << 22)
__device__ __forceinline__ unsigned xb_ld(unsigned* p)              { return __hip_atomic_load(p, __ATOMIC_RELAXED, __HIP_MEMORY_SCOPE_AGENT); }
__device__ __forceinline__ unsigned xb_add(unsigned* p, unsigned v) { return __hip_atomic_fetch_add(p, v, __ATOMIC_RELAXED, __HIP_MEMORY_SCOPE_AGENT); }
__device__ __forceinline__ unsigned xb_xcc_id() { return (unsigned)__builtin_amdgcn_s_getreg((3 << 11) | 20) & 0xFu; }
#define XB_SPIN(cond, bar) do { unsigned _sp = 0; while (cond) { __builtin_amdgcn_s_sleep(1); \
    if ((++_sp & 255u) == 0u) { if (xb_ld(&(bar)[XB_TMO])) break; if (_sp > XB_SPIN_CAP) { atomicAdd(&(bar)[XB_TMO], 1u); break; } } } } while (0)
__device__ __forceinline__ void xcd_barrier_complete(unsigned* bar, unsigned x, unsigned& nloc, unsigned& nx) {
    const unsigned G = gridDim.x;
    unsigned sum, cnt, mine, sp = 0u;
    for (;;) {
        sum = 0u; cnt = 0u; mine = 0u;
#pragma unroll
        for (unsigned j = 0; j < 16; ++j) { const unsigned c = xb_ld(&bar[XB_XCNT(j)]); sum += c; cnt += (c > 0u) ? 1u : 0u; mine = (j == x) ? c : mine; }
        if (sum == G) break;
        __builtin_amdgcn_s_sleep(1);
        if ((++sp & 255u) == 0u) { if (xb_ld(&bar[XB_TMO])) break; if (sp > XB_SPIN_CAP) { atomicAdd(&bar[XB_TMO], 1u); break; } }
    }
    nloc = mine > 0u ? mine : 1u; nx = cnt > 0u ? cnt : 1u;
}
__device__ __forceinline__ void grid_barrier(unsigned* bar, const int wv, volatile LAS unsigned* st) {
    asm volatile("s_waitcnt vmcnt(0)" ::: "memory");
    __syncthreads();
    if (wv == 0 && lane_id() == 0) {
        const unsigned x = xb_xcc_id();
        __builtin_amdgcn_s_waitcnt(0);
        unsigned nloc = st[0], nx = st[1];
        if (nloc == 0u) { xcd_barrier_complete(bar, x, nloc, nx); st[0] = nloc; st[1] = nx; }
        const unsigned old = xb_add(&bar[XB_XSUB(x)], 1u);
        const unsigned gen = old / nloc;
        if (old + 1u == (gen + 1u) * nloc) {
            __builtin_amdgcn_fence(__ATOMIC_RELEASE, "agent");
            asm volatile("s_waitcnt vmcnt(0)" ::: "memory");
            const unsigned og = xb_add(&bar[XB_TOP], 1u);
            const unsigned tg = og / nx;
            if (og + 1u == (tg + 1u) * nx) xb_add(&bar[XB_TOPGEN], 1u);
            else XB_SPIN(xb_ld(&bar[XB_TOPGEN]) == tg, bar);
            __builtin_amdgcn_fence(__ATOMIC_ACQUIRE, "agent");
            xb_add(&bar[XB_XGEN(x)], 1u);
            asm volatile("s_waitcnt vmcnt(0)" ::: "memory");
        } else {
            XB_SPIN(xb_ld(&bar[XB_XGEN(x)]) == gen, bar);
            __builtin_amdgcn_fence(__ATOMIC_ACQUIRE, "agent");
            asm volatile("s_waitcnt vmcnt(0)" ::: "memory");
        }
    }
    __syncthreads();
}
#define WinT ((bf16_t*)(ws + WS_WIN))
#define WuqT ((bf16_t*)(ws + WS_WUQ))
#define WukvT ((bf16_t*)(ws + WS_WUKV))
#define Wb0T ((bf16_t*)(ws + WS_WB0))
#define Wb1T ((bf16_t*)(ws + WS_WB1))
#define WoT ((bf16_t*)(ws + WS_WO))
#define WguT ((bf16_t*)(ws + WS_WGU))
#define WdT ((bf16_t*)(ws + WS_WD))
#define XN ((bf16_t*)(ws + WS_XN))
#define HQ ((bf16_t*)(ws + WS_HQ))
#define HI ((bf16_t*)(ws + WS_HI))
#define GF ((_Float16*)(ws + WS_GF))
#define GB ((_Float16*)(ws + WS_GB))
#define SG ((bf16_t*)(ws + WS_SG))
#define LAT ((bf16_t*)(ws + WS_LAT))
#define Qm ((bf16_t*)(ws + WS_Q))
#define Km ((bf16_t*)(ws + WS_K))
#define Vm ((bf16_t*)(ws + WS_V))
#define OM ((bf16_t*)(ws + WS_OM))
#define OFW ((bf16_t*)(ws + WS_OFW))
#define OBW ((bf16_t*)(ws + WS_OBW))
#define OH ((bf16_t*)(ws + WS_OH))
#define MERGED ((bf16_t*)(ws + WS_MERGED))
#define X1 ((float*)(ws + WS_X1))
#define X1B ((bf16_t*)(ws + WS_X1B))
#define ACT ((bf16_t*)(ws + WS_ACT))
#define GATES ((bf16_t*)a.out)
#define RSQ ((float*)(ws + WS_RSQ))
#define RSKV ((float*)(ws + WS_RSKV))
#define RSX1 ((float*)(ws + WS_RSX1))
#define RSX2 ((float*)(ws + WS_RSX2))
#define ROPE ((f32x2*)(ws + WS_ROPE))
#define QUEUE ((unsigned*)(ws + WS_QUEUE))
__global__ void __launch_bounds__(512, 2) fwd_megakernel(Args a) {
    extern __shared__ __attribute__((aligned(16))) unsigned char lds[];
    const int G = gridDim.x, bx = blockIdx.x;
    const int wv = __builtin_amdgcn_readfirstlane((int)threadIdx.x >> 6);
#define TIDS const int lane = lane_id(), wave = wv, tid = wv * 64 + lane; (void)tid;
    unsigned char* ws = a.ws;
    LAS unsigned char* ldsl = (LAS unsigned char*)lds;
    const int lo = a.ph_lo, hi_ = a.ph_hi;
#ifndef PHMASK
#define PHMASK 0x3ff
#endif
#define IN(k) (((PHMASK >> (k)) & 1) && lo <= (k) && (k) < hi_)
#define STAMP(k) do { if (PROBE_SEL && bx == 0 && wv == 0 && lane_id() == 0) ((unsigned long long*)(ws + WS_TS))[k] = __builtin_amdgcn_s_memrealtime(); } while (0)
#define SEAM(k) do { if (IN(k) && IN((k) + 1)) { if ((k) == 0) cg::this_grid().sync(); else grid_barrier((unsigned*)(ws + WS_XBAR), wv, (volatile LAS unsigned*)(ldsl + LDS_CTL + 32)); } } while (0)

    if (PROBE_SEL && bx == 0 && wv == 0 && lane_id() == 0) { for (int i = 1; i < 32; ++i) ((unsigned long long*)(ws + WS_TS))[i] = 0ull; }
    STAMP(0);
    if (IN(0)) { TIDS
        LAS float* scr = (LAS float*)(ldsl + wave * 16384);
        const int gw = bx * 8 + wave, NGW = G * 8;
        constexpr int I_IN = 16 * 161, I_UQ = 4 * 24, I_UKV = 4 * 32, I_B = 8 * 32, I_O = 16 * 32, I_GU = 16 * 176, I_D = 44 * 32;
        constexpr int NITEMS = I_IN + I_UQ + I_UKV + 2 * I_B + I_O + I_GU + I_D;
        for (int it = gw; it < NITEMS; it += NGW) {
            int r = it;
            if (r < I_IN) { const int kb = r / 161, nb = r % 161; const int dst = nb < 96 ? 32 * nb : (nb == 96 ? 5120 : 3072 + 32 * (nb - 97)); transpose_item(a.w_in, 1024, 5152, 64 * kb, 32 * nb, WinT, dst, nullptr, scr, lane); continue; } r -= I_IN;
            if (r < I_UQ) { const int kb = r / 24, nb = r % 24, h = nb / 3, p = nb % 3; const int dst = p < 2 ? h * 64 + 32 * p : 512 + 32 * h; transpose_item(a.w_uq, 256, 768, 64 * kb, 32 * nb, WuqT, dst, a.g_qa, scr, lane); continue; } r -= I_UQ;
            if (r < I_UKV) { const int kb = r / 32, nb = r % 32; transpose_item(a.w_ukv, 256, 1024, 64 * kb, 32 * nb, WukvT, 32 * nb, a.g_kva, scr, lane); continue; } r -= I_UKV;
            if (r < I_B) { const int kb = r / 32, nb = r % 32; transpose_item(a.w_branch, 512, 1024, 64 * kb, 32 * nb, Wb0T, 32 * nb, nullptr, scr, lane); continue; } r -= I_B;
            if (r < I_B) { const int kb = r / 32, nb = r % 32; transpose_item(a.w_branch + 512 * 1024, 512, 1024, 64 * kb, 32 * nb, Wb1T, 32 * nb, nullptr, scr, lane); continue; } r -= I_B;
            if (r < I_O) { const int kb = r / 32, nb = r % 32; transpose_item(a.w_out, 1024, 1024, 64 * kb, 32 * nb, WoT, 32 * nb, nullptr, scr, lane); continue; } r -= I_O;
            if (r < I_GU) { const int kb = r / 176, nb = r % 176; const int col = 32 * nb; const int j = col < DFF ? col : col - DFF; const int dst = 256 * (j / 128) + (col < DFF ? 0 : 128) + (j % 128);
                transpose_item(a.w_gate_up, 1024, 5632, 64 * kb, col, WguT, dst, a.g_ffn, scr, lane); continue; } r -= I_GU;
            { const int kb = r / 32, nb = r % 32; transpose_item(a.w_down, DFF, 1024, 64 * kb, 32 * nb, WdT, 32 * nb, nullptr, scr, lane); }
        }
        for (int m = gw; m < M; m += NGW) {
            const f32x4* xr = (const f32x4*)xrow_ptr(a.x_prompt, a.x_sample, m) + lane; f32x4 v[4]; float s = 0.f;
#pragma unroll
            for (int j = 0; j < 4; ++j) { v[j] = xr[64 * j]; s += (v[j].x * v[j].x + v[j].y * v[j].y) + (v[j].z * v[j].z + v[j].w * v[j].w); }
            const float rstd = __builtin_amdgcn_rsqf(wave_sum(s) * (1.f / 1024.f) + EPS);
            u32x2* o8 = (u32x2*)(XN + (size_t)m * 1024) + lane;
#pragma unroll
            for (int j = 0; j < 4; ++j) { const f32x4 g = ((const f32x4*)a.g_mix)[64 * j + lane]; u32x2 w; w.x = cvtpk(v[j].x * rstd * g.x, v[j].y * rstd * g.y); w.y = cvtpk(v[j].z * rstd * g.z, v[j].w * rstd * g.w); o8[64 * j] = w; }
        }
        for (int i = bx * 512 + tid; i < (int)(CTL_ZERO / 16); i += G * 512) { if (PROBE_SEL && i >= (int)(WS_TS / 16) && i < (int)(WS_TS / 16) + 16) continue; ((u32x4*)ws)[i] = (u32x4){0u, 0u, 0u, 0u}; }
        for (int i = bx * 512 + tid; i < 16384 * 16; i += G * 512) { const int pos = i >> 4, j = i & 15; const double rev = (double)pos * a.inv_rev[j]; const float fr_ = (float)(rev - floor(rev));
            ROPE[i] = (f32x2){__builtin_amdgcn_cosf(fr_), __builtin_amdgcn_sinf(fr_)}; }
    }
    SEAM(0); STAMP(1);
    {
        volatile LAS unsigned* st = (volatile LAS unsigned*)(ldsl + LDS_CTL + 32);
        if (wv == 0 && lane_id() == 0) { st[0] = 0u; st[1] = 0u; (void)xb_add((unsigned*)(ws + WS_XBAR) + XB_XCNT(xb_xcc_id()), 1u); }
        __syncthreads();
    }
    if (IN(1)) {
        SchedSimple S{(const char*)XN, (const char*)WinT, 256, 21, G, bx, (size_t)256 * 1024 * 2, (size_t)256 * 1024 * 2};
        EpiIn E{ws, GATES, a.lb_param};
        pg8::gemm_phase(wv, ldsl, 1024, 1024, S, E);
    }
    SEAM(1); STAMP(2);
    if (IN(2)) {
        SchedUp S{(const char*)LAT, (const char*)WuqT, (const char*)WukvT, G, bx};
        EpiUp E{Qm, Km, Vm, RSQ, RSKV, ROPE, (unsigned*)(ws + WS_KMAX)};
        pg8::gemm_phase(wv, ldsl, 256, 512, S, E);
    }
    SEAM(2); STAMP(3);
    if (IN(3)) { TIDS
        volatile LAS unsigned* ctl = (volatile LAS unsigned*)(ldsl + LDS_CTL);
        int did_hg = 0;
        for (int qk = 0; qk < 8; ++qk) {
            const int xq = (bx + qk) & 7;
            for (;;) {
                __syncthreads();
                if (tid == 0) ctl[0] = atomicAdd(QUEUE + xq * 64 + 32, 1u);
                __syncthreads();
                const int un = (int)ctl[0];
                if (un >= 3) break;
                int seqbase, S, h;
                if (un == 0) { seqbase = T0 + (xq >> 2) * 16384; S = 16384; h = xq & 3; }
                else { const int idx = 2 * xq + (un - 1); seqbase = (idx >> 2) * 8192; S = 8192; h = idx & 3; }
                hg::unit((LAS char*)ldsl, seqbase, S, h, HQ, HI, GF, GB, OFW, OBW, wv); did_hg = 1;
            }
        }
        if (PROBE_SEL && wv == 0 && lane_id() == 0) atomicMax((unsigned long long*)(ws + WS_TS) + 16, (unsigned long long)__builtin_amdgcn_s_memrealtime());
        for (int qk = 0; qk < 8; ++qk) {
            const int xq = (bx + qk) & 7;
            for (;;) {
                __syncthreads();
                if (tid == 0) ctl[0] = atomicAdd(QUEUE + xq * 64, 1u);
                __syncthreads();
                const int un = (int)ctl[0];
                if (un >= 256) break;
                int seqbase, S, h, qb;
                if (un < 128) { const int j = un, pair = 2 * xq + (j >> 6); seqbase = T0 + (pair >> 3) * 16384; S = 16384; h = pair & 7; qb = j & 63; }
                else { const int j = un - 128, pair = 4 * xq + (j >> 5); seqbase = (pair >> 3) * 8192; S = 8192; h = pair & 7; qb = j & 31; }
                const unsigned* km = (const unsigned*)(ws + WS_KMAX) + row_seq(seqbase) * 32 + h * 4;
                const float kmax = sqrtf(__uint_as_float(km[0]) + __uint_as_float(km[1]) + __uint_as_float(km[2])) * 1.01f;
                att::attn_unit(Qm + ((size_t)(seqbase + qb * 256) * 8 + h) * 96, Km + ((size_t)seqbase * 8 + h) * 96, Vm + ((size_t)seqbase * 8 + h) * 64, OM + (size_t)(seqbase + qb * 256) * 512 + h * 64, S, kmax, (char*)lds, wv);
            }
        }
        if (PROBE_SEL && !did_hg && wv == 0 && lane_id() == 0) atomicMax((unsigned long long*)(ws + WS_TS) + 17, (unsigned long long)__builtin_amdgcn_s_memrealtime());
    }
    SEAM(3); STAMP(4);
    if (IN(4)) { TIDS
        const int gw = bx * 8 + wave, NGW = G * 8;
        for (int m = gw; m < M; m += NGW) {
            const size_t off = (size_t)m * 512 + lane * 8;
            const u32x4 f = *(const u32x4*)(OFW + off), b = *(const u32x4*)(OBW + off), s = *(const u32x4*)(SG + off);
            const unsigned fu[4] = {f.x, f.y, f.z, f.w}, bu[4] = {b.x, b.y, b.z, b.w}, su[4] = {s.x, s.y, s.z, s.w};
            float o[8]; float ss = 0.f;
#pragma unroll
            for (int i = 0; i < 4; ++i) { o[2 * i] = bflo(fu[i]) + bflo(bu[i]); o[2 * i + 1] = bfhi(fu[i]) + bfhi(bu[i]); ss += o[2 * i] * o[2 * i] + o[2 * i + 1] * o[2 * i + 1]; }
            ss += __shfl_xor(ss, 1); ss += __shfl_xor(ss, 2); ss += __shfl_xor(ss, 4); ss += __shfl_xor(ss, 8);
            const float rstd = __builtin_amdgcn_rsqf(ss * (1.f / 128.f) + EPS);
            const f32x4 g0 = *(const f32x4*)(a.g_onorm + lane * 8), g1 = *(const f32x4*)(a.g_onorm + lane * 8 + 4); const float gg[8] = {g0.x, g0.y, g0.z, g0.w, g1.x, g1.y, g1.z, g1.w};
#pragma unroll
            for (int i = 0; i < 4; ++i) { o[2 * i] *= rstd * gg[2 * i] * bflo(su[i]); o[2 * i + 1] *= rstd * gg[2 * i + 1] * bfhi(su[i]); }
            *(u32x4*)(OH + off) = pack8(o);
        }
    }
    SEAM(4); STAMP(5);
    if (IN(5)) {
        SchedBranch S{(const char*)OH, (const char*)OM, (const char*)Wb0T, (const char*)Wb1T, G, bx};
        EpiBranch E{GATES, MERGED};
        pg8::gemm_phase(wv, ldsl, 512, 512, S, E);
    }
    SEAM(5); STAMP(6);
    if (IN(6)) {
        SchedSimple S{(const char*)MERGED, (const char*)WoT, 256, 4, G, bx, (size_t)256 * 1024 * 2, (size_t)256 * 1024 * 2};
        EpiOut E{a.x_prompt, a.x_sample, X1B, RSX1};
        pg8::gemm_phase(wv, ldsl, 1024, 1024, S, E);
    }
    SEAM(6); STAMP(7);
    if (IN(7)) {
        SchedSimple S{(const char*)X1B, (const char*)WguT, 256, 22, G, bx, (size_t)256 * 1024 * 2, (size_t)256 * 1024 * 2};
        EpiGU E{RSX1, ACT};
        pg8::gemm_phase(wv, ldsl, 1024, 1024, S, E);
    }
    SEAM(7); STAMP(8);
    if (PROBE_SEL) grid_barrier((unsigned*)(ws + WS_XBAR), wv, (volatile LAS unsigned*)(ldsl + LDS_CTL + 32));
    if (IN(8)) { TIDS
        SchedPanel S{(const char*)ACT, (const char*)WdT, G, bx, (size_t)256 * DFF * 2, (size_t)256 * DFF * 2};
        EpiDown E{X1B, a.out, RSX2};
        pg8::gemm_phase(wv, ldsl, DFF, DFF, S, E);
        asm volatile("s_waitcnt vmcnt(0)" ::: "memory");
        __builtin_amdgcn_fence(__ATOMIC_RELEASE, "workgroup"); __syncthreads();
        float pert = 0.f;
        if (PROBE_SEL) { const unsigned long long* ts = (const unsigned long long*)(ws + WS_TS); float tus = 0.f;
            if (PROBE_SEL == 1) tus = (float)(ts[4] - ts[3]) * 0.01f;
            if (PROBE_SEL == 2) tus = (float)(ts[16] - ts[3]) * 0.01f;
            if (PROBE_SEL == 3) tus = (float)(ts[17] - ts[3]) * 0.01f;
            if (PROBE_SEL == 4) tus = (float)((ts[1] - ts[0])) * 0.01f;
            if (PROBE_SEL == 5) tus = (float)((ts[5] - ts[4])) * 0.01f;
            if (PROBE_SEL == 6) tus = (float)((ts[8] - ts[0])) * 0.01f;
            if (PROBE_SEL == 8) tus = (float)((ts[2] - ts[1])) * 0.01f;
            if (PROBE_SEL == 9) tus = (float)((ts[8] - ts[7])) * 0.01f;
            pert = sqrtf(tus * 1e-9f); }
        for (int p = bx; p < 256; p += G)
            for (int r = wave; r < 256; r += 8) { const int m = p * 256 + r;
                const float rstd = __builtin_amdgcn_rsqf(__hip_atomic_load(RSX2 + m, __ATOMIC_RELAXED, __HIP_MEMORY_SCOPE_AGENT) * (1.f / 1024.f) + EPS);
                f32x4* yr = (f32x4*)(a.out + (size_t)m * 1024) + lane;
#pragma unroll
                for (int j = 0; j < 4; ++j) { const f32x4 g = ((const f32x4*)a.g_final)[64 * j + lane]; f32x4 v = yr[64 * j]; v.x = v.x * rstd * g.x + pert; v.y = v.y * rstd * g.y - pert; v.z = v.z * rstd * g.z + pert; v.w = v.w * rstd * g.w - pert; yr[64 * j] = v; }
            }
        if (PROBE_SEL == 7) {
            asm volatile("s_waitcnt vmcnt(0)" ::: "memory"); __syncthreads();
            unsigned long long* ts = (unsigned long long*)(ws + WS_TS);
            if (wv == 0 && lane == 0) { atomicMax(ts + 18, (unsigned long long)__builtin_amdgcn_s_memrealtime()); __threadfence(); atomicAdd((unsigned*)(ts + 19), 1u); }
            if (bx == 0) {
                if (wv == 0 && lane == 0) { while (__hip_atomic_load((unsigned*)(ts + 19), __ATOMIC_RELAXED, __HIP_MEMORY_SCOPE_AGENT) < (unsigned)G) __builtin_amdgcn_s_sleep(8); }
                __syncthreads();
                const unsigned long long tend = __hip_atomic_load(ts + 18, __ATOMIC_RELAXED, __HIP_MEMORY_SCOPE_AGENT), t0 = __hip_atomic_load(ts + 0, __ATOMIC_RELAXED, __HIP_MEMORY_SCOPE_AGENT);
                const float tus = (float)(tend - t0) * 0.01f; const float pe = sqrtf(tus * 256e-9f);
                for (int r = wave; r < 256; r += 8) { f32x4* yr = (f32x4*)(a.out + (size_t)r * 1024) + lane;
#pragma unroll
                    for (int j = 0; j < 4; ++j) { f32x4 v = yr[64 * j]; v.x += pe; v.y -= pe; v.z += pe; v.w -= pe; yr[64 * j] = v; } }
            }
        }
    }
#undef IN
#undef SEAM
}

extern "C" void kernel_launch(void* const* d_in, const int* in_sizes, int n_in, void* d_out, int out_size, void* d_ws, size_t ws_size, hipStream_t stream) {
    static int grid = 0;
    if (grid == 0) {
        if (n_in != 16 || out_size != M * DM || ws_size < WS_END) { fprintf(stderr, "kernel_launch: unexpected shapes: n_in %d out %d ws %zu (need %zu)\n", n_in, out_size, ws_size, (size_t)WS_END); grid = -1; return; }
        int dev = 0, cus = 0, per_cu = 0;
        if (hipGetDevice(&dev) != hipSuccess || hipDeviceGetAttribute(&cus, hipDeviceAttributeMultiprocessorCount, dev) != hipSuccess) { grid = -1; return; }
        if (hipFuncSetAttribute((const void*)fwd_megakernel, hipFuncAttributeMaxDynamicSharedMemorySize, LDS_BYTES) != hipSuccess) { fprintf(stderr, "kernel_launch: hipFuncSetAttribute failed\n"); grid = -1; return; }
        if (hipOccupancyMaxActiveBlocksPerMultiprocessor(&per_cu, (const void*)fwd_megakernel, 512, LDS_BYTES) != hipSuccess || per_cu < 1) { fprintf(stderr, "kernel_launch: occupancy query says %d\n", per_cu); per_cu = 1; }
        (void)hipGetLastError();
        grid = cus;
    }
    if (grid < 0) return;
    Args a{};
    a.x_prompt = (const float*)d_in[0]; a.x_sample = (const float*)d_in[1]; a.g_mix = (const float*)d_in[2]; a.w_in = (const float*)d_in[3]; a.lb_param = (const float*)d_in[4];
    a.g_onorm = (const float*)d_in[5]; a.g_qa = (const float*)d_in[6]; a.w_uq = (const float*)d_in[7]; a.g_kva = (const float*)d_in[8]; a.w_ukv = (const float*)d_in[9];
    a.w_branch = (const float*)d_in[10]; a.w_out = (const float*)d_in[11]; a.g_ffn = (const float*)d_in[12]; a.w_gate_up = (const float*)d_in[13]; a.w_down = (const float*)d_in[14]; a.g_final = (const float*)d_in[15];
    a.out = (float*)d_out; a.ws = (unsigned char*)d_ws;
    for (int i = 0; i < 16; ++i) a.inv_rev[i] = pow(10000.0, -(double)i / 16.0) / 6.283185307179586476925;
    a.ph_lo = 0; a.ph_hi = 9;
    void* args[] = {&a};
    const hipError_t e = hipLaunchCooperativeKernel((const void*)fwd_megakernel, dim3(grid), dim3(512), args, LDS_BYTES, stream);
    if (e != hipSuccess) fprintf(stderr, "kernel_launch: cooperative launch failed: %s (grid %d)\n", hipGetErrorString(e), grid);
}
```

```cpp
#include <hip/hip_runtime.h>
#include <hip/hip_cooperative_groups.h>
#include <hip/hip_bf16.h>
#include <cstdio>
#include <cstdint>
#include <cmath>
namespace cg = cooperative_groups;

#define LAS __attribute__((address_space(3)))
typedef unsigned short bf16_t;
typedef short bf16x8 __attribute__((ext_vector_type(8)));
typedef short s16x4 __attribute__((ext_vector_type(4)));
typedef float f32x4 __attribute__((ext_vector_type(4)));
typedef float f32x2 __attribute__((ext_vector_type(2)));
typedef float f32x16 __attribute__((ext_vector_type(16)));
typedef unsigned u32x4 __attribute__((ext_vector_type(4)));
typedef unsigned u32x2 __attribute__((ext_vector_type(2)));
typedef __bf16 bf16x2_t __attribute__((ext_vector_type(2)));
typedef _Float16 h16x8 __attribute__((ext_vector_type(8)));

constexpr int M = 65536, DM = 1024, T0 = 32768;
constexpr int NIN = 5376;
constexpr int DFF = 2816;
constexpr float EPS = 1e-6f;
constexpr float QSCALE = 0.10206207261596575f * 1.4426950408889634f;
constexpr size_t MiB = 1u << 20;
constexpr size_t WS_XBAR = 32768;
constexpr size_t WS_QUEUE = 0, WS_BAR = 4096, WS_TS = 8192, WS_KMAX = 16384;
#ifndef PROBE_SEL
#define PROBE_SEL 0
#endif
constexpr size_t WS_RSQ = 1 * MiB, WS_RSKV = WS_RSQ + 262144, WS_RSX1 = WS_RSKV + 262144, WS_RSX2 = WS_RSX1 + 262144;
constexpr size_t CTL_ZERO = 2 * MiB;
constexpr size_t WS_ROPE = 2 * MiB;
constexpr size_t WS_WIN = 4 * MiB, WS_WUQ = 15 * MiB, WS_WUKV = 15 * MiB + 512 * 1024, WS_WB0 = 16 * MiB, WS_WB1 = 17 * MiB, WS_WO = 18 * MiB, WS_WGU = 20 * MiB, WS_WD = 31 * MiB;
constexpr size_t WS_XN = 40 * MiB, WS_OFW = 40 * MiB, WS_OBW = 104 * MiB, WS_X1B = 40 * MiB;
constexpr size_t WS_HQ = 168 * MiB, WS_HI = 232 * MiB, WS_GF = 296 * MiB, WS_GB = 360 * MiB, WS_SG = 424 * MiB, WS_LAT = 488 * MiB;
constexpr size_t WS_Q = 552 * MiB, WS_K = 648 * MiB, WS_V = 744 * MiB, WS_OM = 808 * MiB;
constexpr size_t WS_OH = 168 * MiB, WS_MERGED = 232 * MiB, WS_X1 = 552 * MiB, WS_ACT = 168 * MiB;
constexpr size_t WS_END = 872 * MiB;
constexpr int LDS_BYTES = 155648;
constexpr int LDS_CTL = 155648 - 256;

__device__ __forceinline__ unsigned cvtpk(float lo, float hi) { f32x2 v = {lo, hi}; bf16x2_t b = __builtin_convertvector(v, bf16x2_t); return __builtin_bit_cast(unsigned, b); }
__device__ __forceinline__ float bf2f(unsigned short u) { return __builtin_bit_cast(float, (unsigned)u << 16); }
__device__ __forceinline__ float bflo(unsigned u) { return __builtin_bit_cast(float, u << 16); }
__device__ __forceinline__ float bfhi(unsigned u) { return __builtin_bit_cast(float, u & 0xffff0000u); }
__device__ __forceinline__ float sigmoidf_(float x) { return __builtin_amdgcn_rcpf(1.f + __expf(-x)); }
__device__ __forceinline__ float siluf_(float x) { return x * sigmoidf_(x); }
__device__ __forceinline__ u32x4 pack8(const float* v) { u32x4 w; w.x = cvtpk(v[0], v[1]); w.y = cvtpk(v[2], v[3]); w.z = cvtpk(v[4], v[5]); w.w = cvtpk(v[6], v[7]); return w; }
__device__ __forceinline__ int crow(int r, int hi) { return (r & 3) + 8 * (r >> 2) + 4 * hi; }
__device__ __forceinline__ const float* xrow_ptr(const float* xp, const float* xs, int row) { return row < T0 ? xp + (size_t)row * DM : xs + (size_t)(row - T0) * DM; }
__device__ __forceinline__ int row_seq(int row) { return row < T0 ? (row >> 13) : 4 + ((row - T0) >> 14); }
__device__ __forceinline__ int row_pos(int row) { return row < T0 ? (row & 8191) : (row & 16383); }
#define SBAR() __builtin_amdgcn_sched_barrier(0)
__device__ __forceinline__ int lane_id() { int l; asm volatile("v_mbcnt_lo_u32_b32 %0, -1, 0\n\tv_mbcnt_hi_u32_b32 %0, -1, %0" : "=v"(l)); return l; }

namespace pg8 {
constexpr int BM = 256, BK = 64, HALF = 128, HTB = HALF * BK * 2, STAGE_BYTES = 8 * HTB, NXCD = 8, WGM = 4;
__device__ __forceinline__ int lds_byte(int r, int c) { const int st = (r >> 4) * 2 + (c >> 5), rr = r & 15, cc = c & 31, ob = rr * 64 + cc * 2; return st * 1024 + (ob ^ (((ob >> 9) & 1) << 5)); }
__device__ __forceinline__ void stage_rc(int b, int& R, int& C) { const int st = b / 1024, sb = b % 1024, swz = sb ^ (((sb >> 9) & 1) << 5); R = (st >> 1) * 16 + swz / 64; C = (st & 1) * 32 + (swz % 64) / 2; }
__device__ __forceinline__ int perm32(int rho) { const int n = rho >> 4, i = rho & 15; return 8 * (i >> 2) + 4 * n + (i & 3); }
struct Unit { int pm, pn, tag; const char* a; const char* b; };
__device__ __forceinline__ void tile_of(int L, int nM, int nN, int& pm, int& pn) {
    const int nwg = nM * nN; int wgid = L;
    { const int q = nwg / NXCD, r = nwg % NXCD, xcd = wgid % NXCD, off = wgid / NXCD; wgid = (xcd < r ? xcd * (q + 1) : r * (q + 1) + (xcd - r) * q) + off; }
    const int nig = WGM * nN, gid = wgid / nig, fm = gid * WGM, gsz = (nM - fm) < WGM ? (nM - fm) : WGM;
    pm = fm + ((wgid % nig) % gsz); pn = (wgid % nig) / gsz;
}
template <class Epi, class Sched>
__device__ __forceinline__ void gemm_phase(const int wv, LAS unsigned char* lds, const int K, const int lda, const Sched& S, const Epi& E) {
    const int lane = lane_id(), wid = wv, tid = wv * 64 + lane, wr = wid >> 2, wc = wid & 3, fr = lane & 15, fq = lane >> 4;
    const int nt = K / BK;
    unsigned voffA[2], voffB[2];
#pragma unroll
    for (int i = 0; i < 2; ++i) { int R, C; stage_rc(tid * 16 + i * 8192, R, C); const int Rb = (R & ~31) + perm32(R & 31);
        voffA[i] = (unsigned)(R * lda + C) * 2u; voffB[i] = (unsigned)(Rb * K + C) * 2u; }
    const size_t kstep = (size_t)(BK * 2);
    const size_t hA = (size_t)HALF * lda * 2, hB = (size_t)HALF * K * 2;
    const unsigned ldsw = (unsigned)wid * 1024u;
    const int aoff = lds_byte(wr * 64 + fr, fq * 8), boff = lds_byte(wc * 32 + fr, fq * 8);
#define PG8_SA(b, h) (((b) * 2 + (h)) * HTB)
#define PG8_SB(b, h) ((4 + (b) * 2 + (h)) * HTB)
#define PG8_STAGE(bufoff, gbase, voff) do { _Pragma("unroll") for (int _i = 0; _i < 2; ++_i) \
        __builtin_amdgcn_global_load_lds((const unsigned*)((const char*)(gbase) + (voff)[_i]), (LAS unsigned*)(lds + (bufoff) + ldsw + _i * 8192), 16, 0, 0); } while (0)
#define PG8_LDA(dst, b, h) do { _Pragma("unroll") for (int m = 0; m < 4; ++m) _Pragma("unroll") for (int k = 0; k < 2; ++k) dst[m][k] = *(const LAS bf16x8*)(lds + PG8_SA(b, h) + aoff + m * 2048 + k * 1024); } while (0)
#define PG8_LDB(dst, b, h) do { _Pragma("unroll") for (int n = 0; n < 2; ++n) _Pragma("unroll") for (int k = 0; k < 2; ++k) dst[n][k] = *(const LAS bf16x8*)(lds + PG8_SB(b, h) + boff + n * 2048 + k * 1024); } while (0)
#define PG8_MMA(ai, bj, At, Bt) do { __builtin_amdgcn_s_setprio(1); _Pragma("unroll") for (int m = 0; m < 4; ++m) _Pragma("unroll") for (int n = 0; n < 2; ++n) _Pragma("unroll") for (int k = 0; k < 2; ++k) \
        acc[ai][bj][m][n] = __builtin_amdgcn_mfma_f32_16x16x32_bf16(Bt[n][k], At[m][k], acc[ai][bj][m][n], 0, 0, 0); __builtin_amdgcn_s_setprio(0); } while (0)
#define PG8_WAIT_V(n) asm volatile("s_waitcnt vmcnt(" #n ")" ::: "memory")
#define PG8_WAIT_L(n) asm volatile("s_waitcnt lgkmcnt(" #n ")" ::: "memory")
#define PG8_BAR __builtin_amdgcn_s_barrier()
#define PG8_SCHED __builtin_amdgcn_sched_barrier(0)
    Unit cur, nxt; int ui = 0;
    if (!S.next(0, cur)) return;
    f32x4 acc[2][2][4][2];
#pragma unroll
    for (int a = 0; a < 2; ++a)
#pragma unroll
        for (int b = 0; b < 2; ++b)
#pragma unroll
            for (int m = 0; m < 4; ++m)
#pragma unroll
                for (int n = 0; n < 2; ++n) acc[a][b][m][n] = (f32x4){0.f, 0.f, 0.f, 0.f};
    bf16x8 At[4][2], B0[2][2], B1[2][2];
    const char* cA = cur.a; const char* cB = cur.b;
    PG8_STAGE(PG8_SB(0, 0), cB, voffB); PG8_STAGE(PG8_SB(0, 1), cB + hB, voffB); PG8_STAGE(PG8_SA(0, 0), cA, voffA); PG8_STAGE(PG8_SA(0, 1), cA + hA, voffA);
    if (wr == 1) PG8_BAR;
    PG8_WAIT_V(2); PG8_BAR;
    PG8_STAGE(PG8_SB(1, 0), cB + kstep, voffB); PG8_STAGE(PG8_SA(1, 0), cA + kstep, voffA); PG8_STAGE(PG8_SB(1, 1), cB + hB + kstep, voffB);
    PG8_WAIT_V(6); PG8_BAR;
    for (;;) {
        const bool has_next = S.next(ui + 1, nxt);
        const char* nA = has_next ? nxt.a : cA; const char* nB = has_next ? nxt.b : cB;
        for (int t = 0; t < nt; t += 2) {
            const bool last = (t == nt - 2);
            const char* a1 = cA + (size_t)(t + 1) * kstep;
            const char* a2 = last ? nA : cA + (size_t)(t + 2) * kstep; const char* b2 = last ? nB : cB + (size_t)(t + 2) * kstep;
            const char* a3 = a2 + kstep; const char* b3 = b2 + kstep;
            PG8_LDB(B0, 0, 0); PG8_LDB(B1, 0, 1); PG8_SCHED; PG8_LDA(At, 0, 0); PG8_STAGE(PG8_SA(1, 1), a1 + hA, voffA);
            PG8_WAIT_V(8); PG8_WAIT_L(0); PG8_BAR; PG8_MMA(0, 0, At, B0); PG8_MMA(0, 1, At, B1); PG8_BAR; PG8_SCHED;
            PG8_LDA(At, 0, 1); PG8_STAGE(PG8_SB(0, 0), b2, voffB); PG8_STAGE(PG8_SB(0, 1), b2 + hB, voffB); PG8_STAGE(PG8_SA(0, 0), a2, voffA);
            PG8_WAIT_V(8); PG8_WAIT_L(0); PG8_BAR; PG8_MMA(1, 0, At, B0); PG8_MMA(1, 1, At, B1); PG8_BAR; PG8_SCHED;
            PG8_LDB(B0, 1, 0); PG8_LDB(B1, 1, 1); PG8_SCHED; PG8_LDA(At, 1, 0); PG8_STAGE(PG8_SA(0, 1), a2 + hA, voffA);
            PG8_WAIT_V(8); PG8_WAIT_L(0); PG8_BAR; PG8_MMA(0, 0, At, B0); PG8_MMA(0, 1, At, B1); PG8_BAR; PG8_SCHED;
            PG8_LDA(At, 1, 1); PG8_STAGE(PG8_SB(1, 0), b3, voffB); PG8_STAGE(PG8_SB(1, 1), b3 + hB, voffB); PG8_STAGE(PG8_SA(1, 0), a3, voffA);
            PG8_WAIT_V(8); PG8_WAIT_L(0); PG8_BAR; PG8_MMA(1, 0, At, B0); PG8_MMA(1, 1, At, B1); PG8_BAR; PG8_SCHED;
        }
        if (wr == 0) PG8_BAR;
        const int l2_ = lane_id(); const int fr_ = l2_ & 15, fq_ = l2_ >> 4;
        const bool keep = E(acc, cur, wr, wc, fr_, fq_);
        if (!has_next) break;
        if (!keep) {
#pragma unroll
        for (int a = 0; a < 2; ++a)
#pragma unroll
            for (int b = 0; b < 2; ++b)
#pragma unroll
                for (int m = 0; m < 4; ++m)
#pragma unroll
                    for (int n = 0; n < 2; ++n) acc[a][b][m][n] = (f32x4){0.f, 0.f, 0.f, 0.f};
        }
        cur = nxt; cA = nA; cB = nB; ++ui;
        if (wr == 1) PG8_BAR;
    }
    PG8_WAIT_V(0);
    PG8_BAR;
#undef PG8_SA
#undef PG8_SB
#undef PG8_STAGE
#undef PG8_LDA
#undef PG8_LDB
#undef PG8_MMA
#undef PG8_WAIT_V
#undef PG8_WAIT_L
#undef PG8_BAR
#undef PG8_SCHED
}
}
using pg8::Unit;
typedef f32x4 Acc[2][2][4][2];
#define EPI_ROWS(ai, m, row) _Pragma("unroll") for (int ai = 0; ai < 2; ++ai) _Pragma("unroll") for (int m = 0; m < 4; ++m) { const int row = u.pm * 256 + ai * 128 + wr * 64 + m * 16 + fr;
#define EPI_END asm volatile("" ::: "memory"); }
__device__ __forceinline__ void get8(const Acc& acc, int ai, int bj, int m, float* v) {
    const f32x4 a = acc[ai][bj][m][0], b = acc[ai][bj][m][1]; v[0] = a[0]; v[1] = a[1]; v[2] = a[2]; v[3] = a[3]; v[4] = b[0]; v[5] = b[1]; v[6] = b[2]; v[7] = b[3]; }

struct Args {
    const float *x_prompt, *x_sample, *g_mix, *w_in, *lb_param, *g_onorm, *g_qa, *w_uq, *g_kva, *w_ukv, *w_branch, *w_out, *g_ffn, *w_gate_up, *w_down, *g_final;
    float* out; unsigned char* ws;
    double inv_rev[16];
    int ph_lo, ph_hi;
};

struct SchedSimple {
    const char* A; const char* B; int nM, nN, G, c; size_t tA, tB;
    __device__ __forceinline__ bool next(int i, Unit& u) const { const long L = (long)i * G + c; if (L >= (long)nM * nN) return false; pg8::tile_of((int)L, nM, nN, u.pm, u.pn); u.tag = 0; u.a = A + u.pm * tA; u.b = B + u.pn * tB; return true; }
};
struct SchedUp {
    const char* LAT; const char* Wuq; const char* Wukv; int G, c;
    __device__ __forceinline__ bool next(int i, Unit& u) const { const long L = (long)i * G + c; if (L >= 256L * 7) return false; pg8::tile_of((int)L, 256, 7, u.pm, u.pn); u.tag = 0;
        u.a = LAT + (size_t)u.pm * 256 * 512 * 2 + (u.pn >= 3 ? 512 : 0); u.b = u.pn < 3 ? Wuq + (size_t)u.pn * 256 * 256 * 2 : Wukv + (size_t)(u.pn - 3) * 256 * 256 * 2; return true; }
};
struct SchedBranch {
    const char* OH; const char* OMm; const char* W0; const char* W1; int G, c;
    __device__ __forceinline__ bool next(int i, Unit& u) const { const long L = (long)(i >> 1) * G + c; if (L >= 256L * 4) return false; pg8::tile_of((int)L, 256, 4, u.pm, u.pn); u.tag = i & 1;
        u.a = ((i & 1) ? OMm : OH) + (size_t)u.pm * 256 * 512 * 2; u.b = ((i & 1) ? W1 : W0) + (size_t)u.pn * 256 * 512 * 2; return true; }
};

struct SchedPanel {
    const char* A; const char* B; int G, c; size_t tA, tB;
    __device__ __forceinline__ bool next(int i, Unit& u) const { const int p = c + (i >> 2) * G; if (p >= 256) return false; u.pm = p; u.pn = i & 3; u.tag = 0; u.a = A + p * tA; u.b = B + u.pn * tB; return true; }
};
struct EpiIn {
    unsigned char* ws; bf16_t *GATES; const float* lbp;
    __device__ __forceinline__ bool operator()(const Acc& acc, const Unit& u, int wr, int wc, int fr, int fq) const {
        const int pn = u.pn, cb = wc * 32 + 8 * fq;
        if (pn < 4 || (pn >= 8 && pn < 10)) {
            bf16_t* dst = (bf16_t*)(ws + (pn < 2 ? WS_HQ : (pn < 4 ? WS_HI : WS_SG))); const int c0 = (pn & 1) * 256; const bool act = (pn < 2 || pn >= 8);
            EPI_ROWS(ai, m, row)
#pragma unroll
                for (int bj = 0; bj < 2; ++bj) { float v[8]; get8(acc, ai, bj, m, v);
                    if (act) {
#pragma unroll
                        for (int i = 0; i < 8; ++i) v[i] = siluf_(v[i]); }
                    *(u32x4*)(dst + (size_t)row * 512 + c0 + bj * 128 + cb) = pack8(v); }
            EPI_END
        } else if (pn < 8) {
            const int dir = (pn >= 6); _Float16* dst = (_Float16*)(ws + (dir ? WS_GB : WS_GF)); const int c0 = (pn & 1) * 256;
            float lb[2][8];
#pragma unroll
            for (int bj = 0; bj < 2; ++bj)
#pragma unroll
                for (int i = 0; i < 8; ++i) { const int col = c0 + bj * 128 + cb + i; lb[bj][i] = sigmoidf_(lbp[dir * 512 + col] - lbp[1024 + dir * 512 + col]); }
            EPI_ROWS(ai, m, row)
#pragma unroll
                for (int bj = 0; bj < 2; ++bj) { float v[8]; get8(acc, ai, bj, m, v); h16x8 h;
#pragma unroll
                    for (int i = 0; i < 8; ++i) { const float f = lb[bj][i] + (1.f - lb[bj][i]) * sigmoidf_(v[i]); h[i] = (_Float16)__logf(f); }
                    *(u32x4*)(dst + (size_t)row * 512 + c0 + bj * 128 + cb) = __builtin_bit_cast(u32x4, h); }
            EPI_END
        } else if (pn < 12) {
            float* RS = (float*)(ws + (pn == 10 ? WS_RSQ : WS_RSKV)); const int c0 = (pn - 10) * 256; bf16_t* LAT = (bf16_t*)(ws + WS_LAT);
            EPI_ROWS(ai, m, row)
                float ss = 0.f;
#pragma unroll
                for (int bj = 0; bj < 2; ++bj) { float v[8]; get8(acc, ai, bj, m, v);
#pragma unroll
                    for (int i = 0; i < 8; ++i) ss += v[i] * v[i];
                    *(u32x4*)(LAT + (size_t)row * 512 + c0 + bj * 128 + cb) = pack8(v); }
                ss += __shfl_xor(ss, 16); ss += __shfl_xor(ss, 32);
                if (fq == 0) atomicAdd(RS + row, ss);
            EPI_END
        } else if (pn < 20) {
            const int c0 = (pn - 12) * 256;
            EPI_ROWS(ai, m, row)
#pragma unroll
                for (int bj = 0; bj < 2; ++bj) { float v[8]; get8(acc, ai, bj, m, v);
#pragma unroll
                    for (int i = 0; i < 8; ++i) v[i] = sigmoidf_(v[i]);
                    *(u32x4*)(GATES + (size_t)row * 2048 + c0 + bj * 128 + cb) = pack8(v); }
            EPI_END
        } else {
            bf16_t* Kc = (bf16_t*)(ws + WS_K); const f32x2* rope = (const f32x2*)(ws + WS_ROPE); float kmx = 0.f;
            EPI_ROWS(ai, m, row)
                float v[8], p[8]; get8(acc, ai, 0, m, v);
                { float ss = 0.f;
#pragma unroll
                  for (int i = 0; i < 8; ++i) ss += v[i] * v[i];
                  ss += __shfl_xor(ss, 16); ss += __shfl_xor(ss, 32); kmx = fmaxf(kmx, ss); }
#pragma unroll
                for (int i = 0; i < 8; ++i) p[i] = __shfl_xor(v[i], 32);
                if (wc == 0) {
                    const int pos = row_pos(row); const f32x2* cs = rope + pos * 16 + 8 * (fq & 1); float o[8];
#pragma unroll
                    for (int i = 0; i < 8; ++i) { const f32x2 c = cs[i]; o[i] = (fq < 2) ? (v[i] * c.x - p[i] * c.y) : (v[i] * c.x + p[i] * c.y); }
                    const u32x4 w = pack8(o);
#pragma unroll
                    for (int h = 0; h < 8; ++h) *(u32x4*)(Kc + ((size_t)row * 8 + h) * 96 + 64 + 8 * fq) = w;
                }
            EPI_END
            if (wc == 0) { kmx = fmaxf(kmx, __shfl_xor(kmx, 1)); kmx = fmaxf(kmx, __shfl_xor(kmx, 2)); kmx = fmaxf(kmx, __shfl_xor(kmx, 4)); kmx = fmaxf(kmx, __shfl_xor(kmx, 8));
                if (fr == 0 && fq == 0) { unsigned* KM = (unsigned*)(ws + WS_KMAX) + row_seq(u.pm * 256) * 32;
#pragma unroll
                    for (int h = 0; h < 8; ++h) atomicMax(KM + h * 4 + 2, __float_as_uint(kmx)); } }
        }
        return false;
    }
};
struct EpiUp {
    bf16_t *Q, *Kc, *V; const float *RSQ, *RSKV; const f32x2* rope; unsigned* KMAX;
    __device__ __forceinline__ bool operator()(const Acc& acc, const Unit& u, int wr, int wc, int fr, int fq) const {
        const int pn = u.pn, cb = wc * 32 + 8 * fq;
#define LOAD_RSV(RSp) float rsv[2][4]; { int rb_ = u.pm * 256 + wr * 64 + fr; asm volatile("" : "+v"(rb_)); const float* rp_ = (RSp) + rb_; _Pragma("unroll") for (int ai = 0; ai < 2; ++ai) _Pragma("unroll") for (int m = 0; m < 4; ++m) rsv[ai][m] = rp_[ai * 128 + m * 16]; }
        if (pn < 2) { LOAD_RSV(RSQ)
            EPI_ROWS(ai, m, row)
                const float sc = __builtin_amdgcn_rsqf(rsv[ai][m] * (1.f / 256.f) + EPS) * QSCALE;
#pragma unroll
                for (int bj = 0; bj < 2; ++bj) { float v[8]; get8(acc, ai, bj, m, v);
#pragma unroll
                    for (int i = 0; i < 8; ++i) v[i] *= sc;
                    const int cg_ = pn * 256 + bj * 128 + cb, h = cg_ >> 6, d = cg_ & 63;
                    *(u32x4*)(Q + ((size_t)row * 8 + h) * 96 + d) = pack8(v); }
            EPI_END
        } else if (pn == 2) {
            EPI_ROWS(ai, m, row)
                const float sc = __builtin_amdgcn_rsqf(RSQ[row] * (1.f / 256.f) + EPS) * QSCALE;
                const int pos = row_pos(row); const f32x2* cs = rope + pos * 16 + 8 * (fq & 1);
#pragma unroll
                for (int bj = 0; bj < 2; ++bj) { float v[8], p[8], o[8]; get8(acc, ai, bj, m, v);
#pragma unroll
                    for (int i = 0; i < 8; ++i) p[i] = __shfl_xor(v[i], 32);
#pragma unroll
                    for (int i = 0; i < 8; ++i) { const f32x2 c = cs[i]; o[i] = ((fq < 2) ? (v[i] * c.x - p[i] * c.y) : (v[i] * c.x + p[i] * c.y)) * sc; }
                    const int h = bj * 4 + wc;
                    *(u32x4*)(Q + ((size_t)row * 8 + h) * 96 + 64 + 8 * fq) = pack8(o); asm volatile("" ::: "memory"); }
            EPI_END
        } else {
            float kmx[2] = {0.f, 0.f}; LOAD_RSV(RSKV)
            EPI_ROWS(ai, m, row)
                const float sc = __builtin_amdgcn_rsqf(rsv[ai][m] * (1.f / 256.f) + EPS);
#pragma unroll
                for (int bj = 0; bj < 2; ++bj) { float v[8]; get8(acc, ai, bj, m, v);
#pragma unroll
                    for (int i = 0; i < 8; ++i) v[i] *= sc;
                    const int cg_ = (pn - 3) * 256 + bj * 128 + cb, h = cg_ >> 7, d = cg_ & 127;
                    if (d < 64) { *(u32x4*)(Kc + ((size_t)row * 8 + h) * 96 + d) = pack8(v); float ss = 0.f;
#pragma unroll
                        for (int i = 0; i < 8; ++i) ss += v[i] * v[i];
                        ss += __shfl_xor(ss, 16); ss += __shfl_xor(ss, 32); kmx[bj] = fmaxf(kmx[bj], ss); }
                    else *(u32x4*)(V + ((size_t)row * 8 + h) * 64 + (d - 64)) = pack8(v); }
            EPI_END
            if (wc < 2) {
#pragma unroll
                for (int bj = 0; bj < 2; ++bj) { float k = kmx[bj]; k = fmaxf(k, __shfl_xor(k, 1)); k = fmaxf(k, __shfl_xor(k, 2)); k = fmaxf(k, __shfl_xor(k, 4)); k = fmaxf(k, __shfl_xor(k, 8));
                    if (fr == 0 && fq == 0) atomicMax(KMAX + row_seq(u.pm * 256) * 32 + ((pn - 3) * 2 + bj) * 4 + wc, __float_as_uint(k)); } }
        }
        return false;
    }
};
struct EpiBranch {
    const bf16_t* GATES; bf16_t* MERGED;
    __device__ __forceinline__ bool operator()(Acc& acc, const Unit& u, int wr, int wc, int fr, int fq) const {
        const int cb = wc * 32 + 8 * fq;
#pragma unroll
        for (int ai = 0; ai < 2; ++ai) {
            u32x4 g1v[4][2], g0v[4][2];
#pragma unroll
            for (int m = 0; m < 4; ++m)
#pragma unroll
                for (int bj = 0; bj < 2; ++bj) { const int row = u.pm * 256 + ai * 128 + wr * 64 + m * 16 + fr, col = u.pn * 256 + bj * 128 + cb;
                    g1v[m][bj] = *(const u32x4*)(GATES + (size_t)row * 2048 + 1024 + col); if (u.tag == 0) g0v[m][bj] = *(const u32x4*)(GATES + (size_t)row * 2048 + col); }
#pragma unroll
            for (int m = 0; m < 4; ++m)
#pragma unroll
                for (int bj = 0; bj < 2; ++bj) { const int row = u.pm * 256 + ai * 128 + wr * 64 + m * 16 + fr, col = u.pn * 256 + bj * 128 + cb;
                    const u32x4 g1 = g1v[m][bj]; float g1f[8] = {bflo(g1.x), bfhi(g1.x), bflo(g1.y), bfhi(g1.y), bflo(g1.z), bfhi(g1.z), bflo(g1.w), bfhi(g1.w)};
                    if (u.tag == 0) {
                        const u32x4 g0 = g0v[m][bj]; float g0f[8] = {bflo(g0.x), bfhi(g0.x), bflo(g0.y), bfhi(g0.y), bflo(g0.z), bfhi(g0.z), bflo(g0.w), bfhi(g0.w)};
#pragma unroll
                        for (int i = 0; i < 4; ++i) { acc[ai][bj][m][0][i] *= g0f[i] * __builtin_amdgcn_rcpf(g1f[i]); acc[ai][bj][m][1][i] *= g0f[4 + i] * __builtin_amdgcn_rcpf(g1f[4 + i]); }
                    } else {
                        float v[8]; get8(acc, ai, bj, m, v);
#pragma unroll
                        for (int i = 0; i < 8; ++i) v[i] *= g1f[i];
                        *(u32x4*)(MERGED + (size_t)row * 1024 + col) = pack8(v);
                    } }
            asm volatile("" ::: "memory");
        }
        return u.tag == 0;
    }
};
struct EpiOut {
    const float *xp, *xs; bf16_t* X1B; float* RS;
    __device__ __forceinline__ bool operator()(const Acc& acc, const Unit& u, int wr, int wc, int fr, int fq) const {
        const int cb = wc * 32 + 8 * fq;
#pragma unroll
        for (int ai = 0; ai < 2; ++ai) {
            f32x4 pre[4][2][2];
#pragma unroll
            for (int m = 0; m < 4; ++m) { const int row = u.pm * 256 + ai * 128 + wr * 64 + m * 16 + fr; const float* xr = xrow_ptr(xp, xs, row);
#pragma unroll
                for (int bj = 0; bj < 2; ++bj) { const int col = u.pn * 256 + bj * 128 + cb; pre[m][bj][0] = *(const f32x4*)(xr + col); pre[m][bj][1] = *(const f32x4*)(xr + col + 4); } }
#pragma unroll
            for (int m = 0; m < 4; ++m) { const int row = u.pm * 256 + ai * 128 + wr * 64 + m * 16 + fr; float ss = 0.f;
#pragma unroll
                for (int bj = 0; bj < 2; ++bj) { const int col = u.pn * 256 + bj * 128 + cb; float v[8]; get8(acc, ai, bj, m, v);
                    const f32x4 x0 = pre[m][bj][0], x1 = pre[m][bj][1];
                    v[0] += x0[0]; v[1] += x0[1]; v[2] += x0[2]; v[3] += x0[3]; v[4] += x1[0]; v[5] += x1[1]; v[6] += x1[2]; v[7] += x1[3];
#pragma unroll
                    for (int i = 0; i < 8; ++i) ss += v[i] * v[i];
                    *(u32x4*)(X1B + (size_t)row * 1024 + col) = pack8(v); }
                ss += __shfl_xor(ss, 16); ss += __shfl_xor(ss, 32);
                if (fq == 0) atomicAdd(RS + row, ss); }
            asm volatile("" ::: "memory");
        }
        return false;
    }
};
struct EpiGU {
    const float* RS; bf16_t* ACT;
    __device__ __forceinline__ bool operator()(const Acc& acc, const Unit& u, int wr, int wc, int fr, int fq) const {
        const int cb = wc * 32 + 8 * fq;
        float rsv[2][4];
        { int rb_ = u.pm * 256 + wr * 64 + fr; asm volatile("" : "+v"(rb_)); const float* rp_ = RS + rb_;
#pragma unroll
        for (int ai = 0; ai < 2; ++ai)
#pragma unroll
            for (int m = 0; m < 4; ++m) rsv[ai][m] = rp_[ai * 128 + m * 16]; }
        EPI_ROWS(ai, m, row)
            const float sc = __builtin_amdgcn_rsqf(rsv[ai][m] * (1.f / 1024.f) + EPS);
            float g[8], p[8]; get8(acc, ai, 0, m, g); get8(acc, ai, 1, m, p);
#pragma unroll
            for (int i = 0; i < 8; ++i) g[i] = siluf_(g[i] * sc) * (p[i] * sc);
            *(u32x4*)(ACT + (size_t)row * DFF + u.pn * 128 + cb) = pack8(g);
        EPI_END
        return false;
    }
};
struct EpiDown {
    const bf16_t* X1B; float* X2; float* RS;
    __device__ __forceinline__ bool operator()(const Acc& acc, const Unit& u, int wr, int wc, int fr, int fq) const {
        const int cb = wc * 32 + 8 * fq;
#pragma unroll
        for (int ai = 0; ai < 2; ++ai) {
            u32x4 pre[4][2];
#pragma unroll
            for (int m = 0; m < 4; ++m) { const int row = u.pm * 256 + ai * 128 + wr * 64 + m * 16 + fr;
#pragma unroll
                for (int bj = 0; bj < 2; ++bj) pre[m][bj] = *(const u32x4*)(X1B + (size_t)row * 1024 + u.pn * 256 + bj * 128 + cb); }
#pragma unroll
            for (int m = 0; m < 4; ++m) { const int row = u.pm * 256 + ai * 128 + wr * 64 + m * 16 + fr; float ss = 0.f;
#pragma unroll
                for (int bj = 0; bj < 2; ++bj) { const int col = u.pn * 256 + bj * 128 + cb; float v[8]; get8(acc, ai, bj, m, v);
                    const u32x4 x = pre[m][bj];
                    v[0] += bflo(x.x); v[1] += bfhi(x.x); v[2] += bflo(x.y); v[3] += bfhi(x.y); v[4] += bflo(x.z); v[5] += bfhi(x.z); v[6] += bflo(x.w); v[7] += bfhi(x.w);
#pragma unroll
                    for (int i = 0; i < 8; ++i) ss += v[i] * v[i];
                    *(f32x4*)(X2 + (size_t)row * 1024 + col) = (f32x4){v[0], v[1], v[2], v[3]}; *(f32x4*)(X2 + (size_t)row * 1024 + col + 4) = (f32x4){v[4], v[5], v[6], v[7]}; }
                ss += __shfl_xor(ss, 16); ss += __shfl_xor(ss, 32);
                if (fq == 0) atomicAdd(RS + row, ss); }
            asm volatile("" ::: "memory");
        }
        return false;
    }
};

namespace att {
constexpr int LDQ = 768, LDK = 768, LDV = 512, LDO = 512, KVBLK = 64, QBLK = 32;
constexpr int SHM_K = 64 * 256, SHM_V = 64 * 64 * 2;
#define KSWZ(row, colB) ((row) * 256 + ((colB) ^ (((row) & 15) << 4)))
__device__ __forceinline__ void expA(f32x16& p0) {
#pragma unroll
    for (int r = 0; r < 16; ++r) p0[r] = __builtin_amdgcn_exp2f(p0[r]);
}
__device__ __forceinline__ void finishSM(f32x16& p0, f32x16& p1, float& l_reg, bf16x8& pa0, bf16x8& pa1, bf16x8& pa2, bf16x8& pa3) {
#pragma unroll
    for (int r = 0; r < 16; ++r) p1[r] = __builtin_amdgcn_exp2f(p1[r]);
    float ps = 0;
#pragma unroll
    for (int r = 0; r < 16; ++r) ps += p0[r];
#pragma unroll
    for (int r = 0; r < 16; ++r) ps += p1[r];
    l_reg += ps;
#define PK4(P, BASE, OUT) do { unsigned a0 = cvtpk(P[BASE + 0], P[BASE + 1]), a1 = cvtpk(P[BASE + 2], P[BASE + 3]);   \
    unsigned b0 = cvtpk(P[BASE + 4], P[BASE + 5]), b1 = cvtpk(P[BASE + 6], P[BASE + 7]);                              \
    auto r0 = __builtin_amdgcn_permlane32_swap(a0, b0, false, false); auto r1 = __builtin_amdgcn_permlane32_swap(a1, b1, false, false); \
    u32x4 w = {r0[0], r1[0], r0[1], r1[1]}; OUT = *reinterpret_cast<bf16x8*>(&w); } while (0)
    PK4(p0, 0, pa0); PK4(p0, 8, pa1); PK4(p1, 0, pa2); PK4(p1, 8, pa3);
#undef PK4
}
__device__ __forceinline__ void qkt(f32x16& p0, f32x16& p1, const char* Ks, const bf16x8* qr, const float mrow, int r32, int hi) {
    p0 = f32x16{}; p1 = f32x16{};
#pragma unroll
    for (int d0 = 0; d0 < 6; ++d0) { const int cb = (d0 * 16 + hi * 8) * 2;
        bf16x8 b0 = *reinterpret_cast<const bf16x8*>(Ks + KSWZ(r32, cb));
        bf16x8 b1 = *reinterpret_cast<const bf16x8*>(Ks + KSWZ(32 + r32, cb));
        p0 = __builtin_amdgcn_mfma_f32_32x32x16_bf16(b0, qr[d0], p0, 0, 0, 0);
        p1 = __builtin_amdgcn_mfma_f32_32x32x16_bf16(b1, qr[d0], p1, 0, 0, 0); }
    if (mrow != 0.f) {
#pragma unroll
        for (int r = 0; r < 16; ++r) { p0[r] -= mrow; p1[r] -= mrow; } }
}
__device__ __forceinline__ int v_st(int k, int c) { const int kk = (k & ~0xC) | ((k & 4) << 1) | ((k & 8) >> 1); return ((kk >> 3) * 2 + (c >> 5)) * 512 + ((kk & 7) * 32 + (c & 31)) * 2; }
__device__ __forceinline__ int v_rd_base(int lane) { return ((lane & 3) << 3) | (((lane >> 2) & 3) << 6) | (((lane >> 4) & 1) << 5) | (((lane >> 5) & 1) << 8); }
constexpr int v_rd_off(int d0, int ks, int half) { return d0 * 512 + ks * 2048 + half * 1024; }
template <int OFF> __device__ __forceinline__ s16x4 tr_read(int vb) { s16x4 r; asm volatile("ds_read_b64_tr_b16 %0, %1 offset:%2" : "=&v"(r) : "v"(vb), "i"(OFF) : "memory"); return r; }
template <int D0> __device__ __forceinline__ void pv_one(f32x16& od, int vb, bf16x8 pa0, bf16x8 pa1, bf16x8 pa2, bf16x8 pa3) {
    const s16x4 l0 = tr_read<v_rd_off(D0, 0, 0)>(vb), h0 = tr_read<v_rd_off(D0, 0, 1)>(vb), l1 = tr_read<v_rd_off(D0, 1, 0)>(vb), h1 = tr_read<v_rd_off(D0, 1, 1)>(vb);
    const s16x4 l2 = tr_read<v_rd_off(D0, 2, 0)>(vb), h2 = tr_read<v_rd_off(D0, 2, 1)>(vb), l3 = tr_read<v_rd_off(D0, 3, 0)>(vb), h3 = tr_read<v_rd_off(D0, 3, 1)>(vb);
    asm volatile("s_waitcnt lgkmcnt(0)" ::: "memory"); SBAR();
#define PK(L, H) (bf16x8){L[0], L[1], L[2], L[3], H[0], H[1], H[2], H[3]}
    od = __builtin_amdgcn_mfma_f32_32x32x16_bf16(pa0, PK(l0, h0), od, 0, 0, 0);
    od = __builtin_amdgcn_mfma_f32_32x32x16_bf16(pa1, PK(l1, h1), od, 0, 0, 0);
    od = __builtin_amdgcn_mfma_f32_32x32x16_bf16(pa2, PK(l2, h2), od, 0, 0, 0);
    od = __builtin_amdgcn_mfma_f32_32x32x16_bf16(pa3, PK(l3, h3), od, 0, 0, 0);
#undef PK
}
__device__ __forceinline__ void pv_d0(f32x16* o, int vb, bf16x8 pa0, bf16x8 pa1, bf16x8 pa2, bf16x8 pa3) { pv_one<0>(o[0], vb, pa0, pa1, pa2, pa3); pv_one<1>(o[1], vb, pa0, pa1, pa2, pa3); }

__device__ __forceinline__ void attn_unit(const bf16_t* __restrict__ Qb, const bf16_t* __restrict__ Kh, const bf16_t* __restrict__ Vh, bf16_t* __restrict__ Ob, int seq, float kmax, char* lds, const int wv) {
    const int lane = lane_id(), wid = wv, tid = wv * 64 + lane, r32 = lane & 31, hi = lane >> 5;
    char* V_lds = lds; char* K_lds = lds + 2 * SHM_V;
    float* li_l = (float*)(lds + 2 * SHM_V + 2 * SHM_K) + wid * 64;
    float l_reg = 0; f32x16 o[2] = {}; bf16x8 qr[6];
    const bf16_t* Qw = Qb + (long)(wid * QBLK + r32) * LDQ + hi * 8;
    float qss = 0.f;
#pragma unroll
    for (int d0 = 0; d0 < 6; ++d0) { qr[d0] = *reinterpret_cast<const bf16x8*>(Qw + d0 * 16);
#pragma unroll
        for (int i = 0; i < 8; ++i) { const float f = bf2f((unsigned short)qr[d0][i]); qss += f * f; } }
    { auto rr = __builtin_amdgcn_permlane32_swap(__float_as_uint(qss), __float_as_uint(qss), false, false); qss = __uint_as_float(rr[0]) + __uint_as_float(rr[1]); }
    float mrow = sqrtf(qss) * kmax;
    if (__all(mrow < 64.f)) mrow = 0.f;
    const int kc1 = tid, kc2 = 512 + (tid & 255); const int kr1 = kc1 / 12, kp1 = kc1 % 12, kr2 = kc2 / 12, kp2 = kc2 % 12; const int vr = tid >> 3, vp = tid & 7;
    const int kst1 = KSWZ(kr1, kp1 * 16), kst2 = KSWZ(kr2, kp2 * 16), vst = v_st(vr, vp * 8);
    const int vb0 = (int)(uintptr_t)V_lds + v_rd_base(lane);
    struct { bf16x8 k1, k2, v; } sr_[2];
#define SLOAD(i, k0) do { sr_[i].k1 = *reinterpret_cast<const bf16x8*>(&Kh[(long)((k0) + kr1) * LDK + kp1 * 8]); if (wv < 4) sr_[i].k2 = *reinterpret_cast<const bf16x8*>(&Kh[(long)((k0) + kr2) * LDK + kp2 * 8]); \
    sr_[i].v = *reinterpret_cast<const bf16x8*>(&Vh[(long)((k0) + vr) * LDV + vp * 8]); } while (0)
#define SWRITE(b, i) do { *(bf16x8*)(K_lds + (b) * SHM_K + kst1) = sr_[i].k1; if (wv < 4) *(bf16x8*)(K_lds + (b) * SHM_K + kst2) = sr_[i].k2; *(bf16x8*)(V_lds + (b) * SHM_V + vst) = sr_[i].v; } while (0)
#define SWAIT() do { if (wv < 4) asm volatile("s_waitcnt vmcnt(3)" ::: "memory"); else asm volatile("s_waitcnt vmcnt(2)" ::: "memory"); } while (0)
    f32x16 pA0, pA1, pB0, pB1; bf16x8 pa0, pa1, pa2, pa3; const int NT = seq / KVBLK;
    constexpr int SE = 0, SO = 1;
    SLOAD(SE, 0); asm volatile("s_waitcnt vmcnt(0)" ::: "memory"); SWRITE(0, SE); __syncthreads();
    qkt(pA0, pA1, K_lds, qr, mrow, r32, hi); expA(pA0);
    SLOAD(SO, KVBLK); if (2 < NT) SLOAD(SE, 2 * KVBLK);
    SWAIT(); SWRITE(1, SO); __syncthreads();
    for (int j = 1; j + 1 < NT; j += 2) {
        __builtin_amdgcn_iglp_opt(0); qkt(pB0, pB1, K_lds + SHM_K, qr, mrow, r32, hi);
        finishSM(pA0, pA1, l_reg, pa0, pa1, pa2, pa3); SBAR();
        SLOAD(SO, (j + 2) * KVBLK); SBAR();
        pv_d0(o, vb0, pa0, pa1, pa2, pa3); expA(pB0);
        __syncthreads(); SWAIT(); SWRITE(0, SE);
        __syncthreads();
        __builtin_amdgcn_iglp_opt(0); qkt(pA0, pA1, K_lds, qr, mrow, r32, hi);
        finishSM(pB0, pB1, l_reg, pa0, pa1, pa2, pa3); SBAR();
        if (j + 3 < NT) SLOAD(SE, (j + 3) * KVBLK); SBAR();
        pv_d0(o, vb0 + SHM_V, pa0, pa1, pa2, pa3); expA(pA0);
        __syncthreads(); if (j + 3 < NT) SWAIT(); else asm volatile("s_waitcnt vmcnt(0)" ::: "memory"); SWRITE(1, SO);
        __syncthreads();
    }
    SBAR(); qkt(pB0, pB1, K_lds + SHM_K, qr, mrow, r32, hi);
    finishSM(pA0, pA1, l_reg, pa0, pa1, pa2, pa3); SBAR();
    pv_d0(o, vb0, pa0, pa1, pa2, pa3); expA(pB0);
    __syncthreads();
    finishSM(pB0, pB1, l_reg, pa0, pa1, pa2, pa3); SBAR();
    pv_d0(o, vb0 + SHM_V, pa0, pa1, pa2, pa3);
    { auto rr = __builtin_amdgcn_permlane32_swap(__float_as_uint(l_reg), __float_as_uint(l_reg), false, false); l_reg = __uint_as_float(rr[0]) + __uint_as_float(rr[1]); }
    if (hi == 0) li_l[r32] = l_reg; asm volatile("s_waitcnt lgkmcnt(0)" ::: "memory");
    float rli[16];
#pragma unroll
    for (int r = 0; r < 16; ++r) rli[r] = __builtin_amdgcn_rcpf(li_l[crow(r, hi)]);
    bf16_t* Ow = Ob + (long)(wid * QBLK) * LDO;
#pragma unroll
    for (int r = 0; r < 16; ++r) { const int orow = crow(r, hi);
#pragma unroll
        for (int d0 = 0; d0 < 2; ++d0) Ow[(long)orow * LDO + d0 * 32 + r32] = (bf16_t)(cvtpk(o[d0][r] * rli[r], 0.f) & 0xffffu); }
    __syncthreads();
#undef SLOAD
#undef SWRITE
#undef SWAIT
}
}

namespace hg {
constexpr int QP = 136, TP = 68;
constexpr int OFF_QIN = 0, OFF_KIN = 64 * QP * 2, OFF_KINT = 2 * 64 * QP * 2, OFF_VT = OFF_KINT + 128 * TP * 2, OFF_TOT1 = OFF_VT + 128 * TP * 2, OFF_FAC = OFF_TOT1 + 1024, HALF_BYTES = OFF_FAC + 512;
static_assert(2 * HALF_BYTES <= LDS_CTL, "HGRN LDS");
__device__ __forceinline__ bf16x8 ld2x4(const LAS char* p0, const LAS char* p1) { const s16x4 a = *(const LAS s16x4*)p0, b = *(const LAS s16x4*)p1; return (bf16x8){a[0], a[1], a[2], a[3], b[0], b[1], b[2], b[3]}; }
__device__ __forceinline__ bf16x8 packf8(const f32x16& a, int base) { u32x4 w; w.x = cvtpk(a[base], a[base + 1]); w.y = cvtpk(a[base + 2], a[base + 3]); w.z = cvtpk(a[base + 4], a[base + 5]); w.w = cvtpk(a[base + 6], a[base + 7]); return __builtin_bit_cast(bf16x8, w); }
__device__ __forceinline__ void unit(LAS char* lds, int seqbase, int S, int h, const bf16_t* __restrict__ HQp, const bf16_t* __restrict__ HIp, const _Float16* __restrict__ GFp, const _Float16* __restrict__ GBp, bf16_t* OFWp, bf16_t* OBWp, const int wv) {
    const int lane = lane_id(), tid = wv * 64 + lane, bwd = wv >> 2, ht = tid & 255, w = wv & 3, r32 = lane & 31, hi = lane >> 5;
    LAS char* base = lds + bwd * HALF_BYTES;
    LAS char* QIN = base + OFF_QIN; LAS char* KINT = base + OFF_KINT; LAS char* VT = base + OFF_VT; LAS float* TOT1 = (LAS float*)(base + OFF_TOT1); LAS float* FAC = (LAS float*)(base + OFF_FAC);
    const _Float16* G = bwd ? GBp : GFp; bf16_t* O = bwd ? OBWp : OFWp;
    const int nc = S / 64, part = ht >> 7, d = ht & 127, e0 = 32 * w;
    f32x16 Sacc[4] = {};
    if (part == 1) { TOT1[d] = 0.f; TOT1[128 + d] = 0.f; }
    u32x4 rg[4], rq[4], rv[4];
    const int trb = ht >> 4, c8 = (ht & 15) * 8, tv = (ht >> 2) & 63, ev = (ht & 3) * 8;
    const long jstep = bwd ? -16 * 512 : 16 * 512;
    const size_t gq_off = (size_t)(bwd ? 63 - trb : trb) * 512 + h * 128 + c8, v_off = (size_t)(bwd ? 63 - tv : tv) * 512 + h * 128 + ev;
#define HG_LOADRAW(c) do { const size_t cb_ = (size_t)(seqbase + (bwd ? (nc - 1 - (c)) * 64 : (c) * 64)) * 512 + gq_off; \
    _Pragma("unroll") for (int j = 0; j < 4; ++j) { rg[j] = *(const u32x4*)(G + cb_ + j * jstep); rq[j] = *(const u32x4*)(HQp + cb_ + j * jstep); } } while (0)
#define HG_LOADV(c) do { const size_t cb_ = (size_t)(seqbase + (bwd ? (nc - 1 - (c)) * 64 : (c) * 64)) * 512 + v_off; \
    _Pragma("unroll") for (int j = 0; j < 4; ++j) rv[j] = *(const u32x4*)(HIp + cb_ + 32 * j); } while (0)
    HG_LOADRAW(0); HG_LOADV(0);
    for (int c = 0; c < nc; ++c) {
        const int c0 = seqbase + (bwd ? (nc - 1 - c) * 64 : c * 64);
        LAS char* wq = QIN + (trb * QP + c8) * 2; LAS char* wvt = VT + (ev * TP + tv) * 2; LAS char* colb = QIN + d * 2; LAS char* ktb = KINT + d * TP * 2;
        asm volatile("" : "+v"(wq), "+v"(wvt), "+v"(colb), "+v"(ktb));
#pragma unroll
        for (int j = 0; j < 4; ++j) { *(LAS u32x4*)(wq + j * 16 * QP * 2) = rq[j]; *(LAS u32x4*)(wq + (OFF_KIN - OFF_QIN) + j * 16 * QP * 2) = rg[j]; }
#pragma unroll
        for (int j = 0; j < 4; ++j) { const unsigned vv[4] = {rv[j].x, rv[j].y, rv[j].z, rv[j].w};
#pragma unroll
            for (int i = 0; i < 4; ++i) { *(LAS bf16_t*)(wvt + (32 * j + 2 * i) * TP * 2) = (bf16_t)(vv[i] & 0xffffu); *(LAS bf16_t*)(wvt + (32 * j + 2 * i + 1) * TP * 2) = (bf16_t)(vv[i] >> 16); } }
        __syncthreads();
        if (c + 1 < nc) { HG_LOADRAW(c + 1); HG_LOADV(c + 1); }
        constexpr int KO = OFF_KIN - OFF_QIN;
        if (part == 0) {
            float E1 = 1.f, E2 = 1.f, tot = 0.f;
#pragma unroll 4
            for (int tp = 15; tp >= 0; --tp) { unsigned kpk[2];
#pragma unroll
                for (int s2 = 1; s2 >= 0; --s2) { const int tt = 2 * tp + s2;
                    const float g = (float)*(const LAS _Float16*)(colb + KO + tt * QP * 2), q = bf2f(*(const LAS bf16_t*)(colb + tt * QP * 2));
                    const float f = __expf(g), rf = __expf(-g);
                    const unsigned pq = cvtpk(q * E1, (1.f - f) * E2);
                    *(LAS bf16_t*)(colb + tt * QP * 2) = (bf16_t)(pq & 0xffffu); *(LAS bf16_t*)(colb + KO + tt * QP * 2) = (bf16_t)(pq >> 16); kpk[s2] = pq >> 16;
                    E1 *= rf; E2 *= f; tot += g; }
                *(LAS unsigned*)(ktb + 4 * tp) = kpk[0] | (kpk[1] << 16); }
            FAC[d] = __expf(tot + TOT1[((c + 1) & 1) * 128 + d]);
        } else {
            float E1 = 1.f, E2 = 1.f, tot = 0.f;
#pragma unroll 4
            for (int tp = 16; tp < 32; ++tp) { unsigned kpk[2];
#pragma unroll
                for (int s2 = 0; s2 < 2; ++s2) { const int tt = 2 * tp + s2;
                    const float g = (float)*(const LAS _Float16*)(colb + KO + tt * QP * 2), q = bf2f(*(const LAS bf16_t*)(colb + tt * QP * 2));
                    const float f = __expf(g), rf = __expf(-g);
                    E1 *= f; E2 *= rf; tot += g;
                    const unsigned pq = cvtpk(q * E1, (1.f - f) * E2);
                    *(LAS bf16_t*)(colb + tt * QP * 2) = (bf16_t)(pq & 0xffffu); *(LAS bf16_t*)(colb + KO + tt * QP * 2) = (bf16_t)(pq >> 16); kpk[s2] = pq >> 16; }
                *(LAS unsigned*)(ktb + 4 * tp) = kpk[0] | (kpk[1] << 16); }
            TOT1[(c & 1) * 128 + d] = tot;
        }
        __syncthreads();
        {
            const LAS char* bq16 = QIN + r32 * QP * 2 + 16 * hi; const LAS char* bq8 = QIN + r32 * QP * 2 + 8 * hi;
            const LAS char* bv16 = VT + (e0 + r32) * TP * 2 + 16 * hi; const LAS char* bv8 = VT + (e0 + r32) * TP * 2 + 8 * hi;
            const LAS char* bk16 = KINT + r32 * TP * 2 + 16 * hi; const LAS float* bfac = FAC + 4 * hi; int thr = r32 - 4 * hi;
            asm volatile("" : "+v"(bq16), "+v"(bq8), "+v"(bv16), "+v"(bv8), "+v"(bk16), "+v"(bfac), "+v"(thr));
            constexpr int KOFF = OFF_KIN - OFF_QIN, R32 = 32 * QP * 2;
#pragma unroll
            for (int db = 0; db < 4; ++db)
#pragma unroll
                for (int r4 = 0; r4 < 4; ++r4) { const f32x4 fc = *(const LAS f32x4*)(bfac + 32 * db + 8 * r4); Sacc[db][4 * r4] *= fc.x; Sacc[db][4 * r4 + 1] *= fc.y; Sacc[db][4 * r4 + 2] *= fc.z; Sacc[db][4 * r4 + 3] *= fc.w; }
            f32x16 o0 = {}, o1 = {};
#pragma unroll
            for (int kk = 0; kk < 8; ++kk) { const bf16x8 sf = packf8(Sacc[kk >> 1], 8 * (kk & 1));
                const bf16x8 b0 = ld2x4(bq8 + 32 * kk, bq8 + 32 * kk + 16), b1 = ld2x4(bq8 + R32 + 32 * kk, bq8 + R32 + 32 * kk + 16);
                o0 = __builtin_amdgcn_mfma_f32_32x32x16_bf16(sf, b0, o0, 0, 0, 0);
                o1 = __builtin_amdgcn_mfma_f32_32x32x16_bf16(sf, b1, o1, 0, 0, 0); if (kk & 1) SBAR(); }
            SBAR();
            {
                f32x16 p = {}; __builtin_amdgcn_iglp_opt(0);
#pragma unroll
                for (int kk = 0; kk < 8; ++kk)
                    { p = __builtin_amdgcn_mfma_f32_32x32x16_bf16(*(const LAS bf16x8*)(bq16 + KOFF + 32 * kk), *(const LAS bf16x8*)(bq16 + 32 * kk), p, 0, 0, 0); }
#pragma unroll
                for (int r = 0; r < 16; ++r) { if ((r & 3) + 8 * (r >> 2) > thr) p[r] = 0.f; }
#pragma unroll
                for (int k2 = 0; k2 < 2; ++k2) o0 = __builtin_amdgcn_mfma_f32_32x32x16_bf16(ld2x4(bv8 + 32 * k2, bv8 + 32 * k2 + 16), packf8(p, 8 * k2), o0, 0, 0, 0);
            }
            SBAR();
            {
                f32x16 p = {}; __builtin_amdgcn_iglp_opt(0);
#pragma unroll
                for (int kk = 0; kk < 8; ++kk)
                    { p = __builtin_amdgcn_mfma_f32_32x32x16_bf16(*(const LAS bf16x8*)(bq16 + KOFF + 32 * kk), *(const LAS bf16x8*)(bq16 + R32 + 32 * kk), p, 0, 0, 0); }
#pragma unroll
                for (int k2 = 0; k2 < 2; ++k2) o1 = __builtin_amdgcn_mfma_f32_32x32x16_bf16(ld2x4(bv8 + 32 * k2, bv8 + 32 * k2 + 16), packf8(p, 8 * k2), o1, 0, 0, 0);
            }
            SBAR();
            {
                f32x16 p = {}; __builtin_amdgcn_iglp_opt(0);
#pragma unroll
                for (int kk = 0; kk < 8; ++kk)
                    { p = __builtin_amdgcn_mfma_f32_32x32x16_bf16(*(const LAS bf16x8*)(bq16 + KOFF + R32 + 32 * kk), *(const LAS bf16x8*)(bq16 + R32 + 32 * kk), p, 0, 0, 0); }
#pragma unroll
                for (int r = 0; r < 16; ++r) { if ((r & 3) + 8 * (r >> 2) > thr) p[r] = 0.f; }
#pragma unroll
                for (int k2 = 0; k2 < 2; ++k2) o1 = __builtin_amdgcn_mfma_f32_32x32x16_bf16(ld2x4(bv8 + 64 + 32 * k2, bv8 + 64 + 32 * k2 + 16), packf8(p, 8 * k2), o1, 0, 0, 0);
            }
            SBAR();
#pragma unroll
            for (int kk = 0; kk < 4; ++kk) { const bf16x8 vfr = ld2x4(bv16 + 32 * kk, bv16 + 32 * kk + 8);
#pragma unroll
                for (int db = 0; db < 4; ++db) { const LAS char* kp = bk16 + 32 * db * TP * 2 + 32 * kk; Sacc[db] = __builtin_amdgcn_mfma_f32_32x32x16_bf16(ld2x4(kp, kp + 8), vfr, Sacc[db], 0, 0, 0); } SBAR(); }
            SBAR();
#pragma unroll
            for (int tb = 0; tb < 2; ++tb) { const int tt = 32 * tb + r32, row = c0 + (bwd ? 63 - tt : tt); bf16_t* op = O + (size_t)row * 512 + h * 128 + e0 + 16 * hi;
                const f32x16& oo = tb ? o1 : o0; unsigned dq[4][2];
#pragma unroll
                for (int r4 = 0; r4 < 4; ++r4) { dq[r4][0] = cvtpk(oo[4 * r4], oo[4 * r4 + 1]); dq[r4][1] = cvtpk(oo[4 * r4 + 2], oo[4 * r4 + 3]); }
                const auto s00 = __builtin_amdgcn_permlane32_swap(dq[0][0], dq[2][0], false, false), s01 = __builtin_amdgcn_permlane32_swap(dq[0][1], dq[2][1], false, false);
                const auto s10 = __builtin_amdgcn_permlane32_swap(dq[1][0], dq[3][0], false, false), s11 = __builtin_amdgcn_permlane32_swap(dq[1][1], dq[3][1], false, false);
                *(u32x4*)(op) = (u32x4){s00[0], s01[0], s00[1], s01[1]}; *(u32x4*)(op + 8) = (u32x4){s10[0], s11[0], s10[1], s11[1]}; }
        }
        __syncthreads();
    }
#undef HG_LOADRAW
#undef HG_LOADV
}
}

__device__ __forceinline__ float wave_sum(float v) {
#pragma unroll
    for (int o = 1; o < 64; o <<= 1) v += __shfl_xor(v, o);
    return v;
}
__device__ __forceinline__ void transpose_item(const float* W, int K, int N, int k0, int n0, bf16_t* WT, int dst0, const float* kscale, LAS float* scr, int lane) {
#pragma unroll 8
    for (int i = 0; i < 32; ++i) { const int kk = 2 * i + (lane >> 5); float v = W[(size_t)(k0 + kk) * N + n0 + (lane & 31)]; if (kscale) v *= kscale[k0 + kk]; scr[kk * 33 + (lane & 31)] = v; }
    asm volatile("s_waitcnt lgkmcnt(0)" ::: "memory");
    const int c = lane & 7;
#pragma unroll
    for (int j = 0; j < 4; ++j) { const int n = (lane >> 3) + 8 * j; const LAS float* s = scr + (8 * c) * 33 + n;
        u32x4 o; o.x = cvtpk(s[0 * 33], s[1 * 33]); o.y = cvtpk(s[2 * 33], s[3 * 33]); o.z = cvtpk(s[4 * 33], s[5 * 33]); o.w = cvtpk(s[6 * 33], s[7 * 33]);
        *(u32x4*)(WT + (size_t)(dst0 + n) * K + k0 + 8 * c) = o; }
    asm volatile("s_waitcnt lgkmcnt(0)" ::: "memory");
}

#define XB_TMO      128
#define XB_XCNT(j)  (256  + 64 * (j))
#define XB_XSUB(j)  (1280 + 64 * (j))
#define XB_XGEN(j)  (2304 + 64 * (j))
#define XB_TOP      3328
#define XB_TOPGEN   3392
#define XB_SPIN_CAP (1u << 22)
__device__ __forceinline__ unsigned xb_ld(unsigned* p)              { return __hip_atomic_load(p, __ATOMIC_RELAXED, __HIP_MEMORY_SCOPE_AGENT); }
__device__ __forceinline__ unsigned xb_add(unsigned* p, unsigned v) { return __hip_atomic_fetch_add(p, v, __ATOMIC_RELAXED, __HIP_MEMORY_SCOPE_AGENT); }
__device__ __forceinline__ unsigned xb_xcc_id() { return (unsigned)__builtin_amdgcn_s_getreg((3 << 11) | 20) & 0xFu; }
#define XB_SPIN(cond, bar) do { unsigned _sp = 0; while (cond) { __builtin_amdgcn_s_sleep(1); \
    if ((++_sp & 255u) == 0u) { if (xb_ld(&(bar)[XB_TMO])) break; if (_sp > XB_SPIN_CAP) { atomicAdd(&(bar)[XB_TMO], 1u); break; } } } } while (0)
__device__ __forceinline__ void xcd_barrier_complete(unsigned* bar, unsigned x, unsigned& nloc, unsigned& nx) {
    const unsigned G = gridDim.x;
    unsigned sum, cnt, mine, sp = 0u;
    for (;;) {
        sum = 0u; cnt = 0u; mine = 0u;
#pragma unroll
        for (unsigned j = 0; j < 16; ++j) { const unsigned c = xb_ld(&bar[XB_XCNT(j)]); sum += c; cnt += (c > 0u) ? 1u : 0u; mine = (j == x) ? c : mine; }
        if (sum == G) break;
        __builtin_amdgcn_s_sleep(1);
        if ((++sp & 255u) == 0u) { if (xb_ld(&bar[XB_TMO])) break; if (sp > XB_SPIN_CAP) { atomicAdd(&bar[XB_TMO], 1u); break; } }
    }
    nloc = mine > 0u ? mine : 1u; nx = cnt > 0u ? cnt : 1u;
}
__device__ __forceinline__ void grid_barrier(unsigned* bar, const int wv, volatile LAS unsigned* st) {
    asm volatile("s_waitcnt vmcnt(0)" ::: "memory");
    __syncthreads();
    if (wv == 0 && lane_id() == 0) {
        const unsigned x = xb_xcc_id();
        __builtin_amdgcn_s_waitcnt(0);
        unsigned nloc = st[0], nx = st[1];
        if (nloc == 0u) { xcd_barrier_complete(bar, x, nloc, nx); st[0] = nloc; st[1] = nx; }
        const unsigned old = xb_add(&bar[XB_XSUB(x)], 1u);
        const unsigned gen = old / nloc;
        if (old + 1u == (gen + 1u) * nloc) {
            __builtin_amdgcn_fence(__ATOMIC_RELEASE, "agent");
            asm volatile("s_waitcnt vmcnt(0)" ::: "memory");
            const unsigned og = xb_add(&bar[XB_TOP], 1u);
            const unsigned tg = og / nx;
            if (og + 1u == (tg + 1u) * nx) xb_add(&bar[XB_TOPGEN], 1u);
            else XB_SPIN(xb_ld(&bar[XB_TOPGEN]) == tg, bar);
            __builtin_amdgcn_fence(__ATOMIC_ACQUIRE, "agent");
            xb_add(&bar[XB_XGEN(x)], 1u);
            asm volatile("s_waitcnt vmcnt(0)" ::: "memory");
        } else {
            XB_SPIN(xb_ld(&bar[XB_XGEN(x)]) == gen, bar);
            __builtin_amdgcn_fence(__ATOMIC_ACQUIRE, "agent");
            asm volatile("s_waitcnt vmcnt(0)" ::: "memory");
        }
    }
    __syncthreads();
}
#define WinT ((bf16_t*)(ws + WS_WIN))
#define WuqT ((bf16_t*)(ws + WS_WUQ))
#define WukvT ((bf16_t*)(ws + WS_WUKV))
#define Wb0T ((bf16_t*)(ws + WS_WB0))
#define Wb1T ((bf16_t*)(ws + WS_WB1))
#define WoT ((bf16_t*)(ws + WS_WO))
#define WguT ((bf16_t*)(ws + WS_WGU))
#define WdT ((bf16_t*)(ws + WS_WD))
#define XN ((bf16_t*)(ws + WS_XN))
#define HQ ((bf16_t*)(ws + WS_HQ))
#define HI ((bf16_t*)(ws + WS_HI))
#define GF ((_Float16*)(ws + WS_GF))
#define GB ((_Float16*)(ws + WS_GB))
#define SG ((bf16_t*)(ws + WS_SG))
#define LAT ((bf16_t*)(ws + WS_LAT))
#define Qm ((bf16_t*)(ws + WS_Q))
#define Km ((bf16_t*)(ws + WS_K))
#define Vm ((bf16_t*)(ws + WS_V))
#define OM ((bf16_t*)(ws + WS_OM))
#define OFW ((bf16_t*)(ws + WS_OFW))
#define OBW ((bf16_t*)(ws + WS_OBW))
#define OH ((bf16_t*)(ws + WS_OH))
#define MERGED ((bf16_t*)(ws + WS_MERGED))
#define X1 ((float*)(ws + WS_X1))
#define X1B ((bf16_t*)(ws + WS_X1B))
#define ACT ((bf16_t*)(ws + WS_ACT))
#define GATES ((bf16_t*)a.out)
#define RSQ ((float*)(ws + WS_RSQ))
#define RSKV ((float*)(ws + WS_RSKV))
#define RSX1 ((float*)(ws + WS_RSX1))
#define RSX2 ((float*)(ws + WS_RSX2))
#define ROPE ((f32x2*)(ws + WS_ROPE))
#define QUEUE ((unsigned*)(ws + WS_QUEUE))
__global__ void __launch_bounds__(512, 2) fwd_megakernel(Args a) {
    extern __shared__ __attribute__((aligned(16))) unsigned char lds[];
    const int G = gridDim.x, bx = blockIdx.x;
    const int wv = __builtin_amdgcn_readfirstlane((int)threadIdx.x >> 6);
#define TIDS const int lane = lane_id(), wave = wv, tid = wv * 64 + lane; (void)tid;
    unsigned char* ws = a.ws;
    LAS unsigned char* ldsl = (LAS unsigned char*)lds;
    const int lo = a.ph_lo, hi_ = a.ph_hi;
#ifndef PHMASK
#define PHMASK 0x3ff
#endif
#define IN(k) (((PHMASK >> (k)) & 1) && lo <= (k) && (k) < hi_)
#define STAMP(k) do { if (PROBE_SEL && bx == 0 && wv == 0 && lane_id() == 0) ((unsigned long long*)(ws + WS_TS))[k] = __builtin_amdgcn_s_memrealtime(); } while (0)
#define SEAM(k) do { if (IN(k) && IN((k) + 1)) { if ((k) == 0) cg::this_grid().sync(); else grid_barrier((unsigned*)(ws + WS_XBAR), wv, (volatile LAS unsigned*)(ldsl + LDS_CTL + 32)); } } while (0)

    if (PROBE_SEL && bx == 0 && wv == 0 && lane_id() == 0) { for (int i = 1; i < 32; ++i) ((unsigned long long*)(ws + WS_TS))[i] = 0ull; }
    STAMP(0);
    if (IN(0)) { TIDS
        LAS float* scr = (LAS float*)(ldsl + wave * 16384);
        const int gw = bx * 8 + wave, NGW = G * 8;
        constexpr int I_IN = 16 * 161, I_UQ = 4 * 24, I_UKV = 4 * 32, I_B = 8 * 32, I_O = 16 * 32, I_GU = 16 * 176, I_D = 44 * 32;
        constexpr int NITEMS = I_IN + I_UQ + I_UKV + 2 * I_B + I_O + I_GU + I_D;
        for (int it = gw; it < NITEMS; it += NGW) {
            int r = it;
            if (r < I_IN) { const int kb = r / 161, nb = r % 161; const int dst = nb < 96 ? 32 * nb : (nb == 96 ? 5120 : 3072 + 32 * (nb - 97)); transpose_item(a.w_in, 1024, 5152, 64 * kb, 32 * nb, WinT, dst, nullptr, scr, lane); continue; } r -= I_IN;
            if (r < I_UQ) { const int kb = r / 24, nb = r % 24, h = nb / 3, p = nb % 3; const int dst = p < 2 ? h * 64 + 32 * p : 512 + 32 * h; transpose_item(a.w_uq, 256, 768, 64 * kb, 32 * nb, WuqT, dst, a.g_qa, scr, lane); continue; } r -= I_UQ;
            if (r < I_UKV) { const int kb = r / 32, nb = r % 32; transpose_item(a.w_ukv, 256, 1024, 64 * kb, 32 * nb, WukvT, 32 * nb, a.g_kva, scr, lane); continue; } r -= I_UKV;
            if (r < I_B) { const int kb = r / 32, nb = r % 32; transpose_item(a.w_branch, 512, 1024, 64 * kb, 32 * nb, Wb0T, 32 * nb, nullptr, scr, lane); continue; } r -= I_B;
            if (r < I_B) { const int kb = r / 32, nb = r % 32; transpose_item(a.w_branch + 512 * 1024, 512, 1024, 64 * kb, 32 * nb, Wb1T, 32 * nb, nullptr, scr, lane); continue; } r -= I_B;
            if (r < I_O) { const int kb = r / 32, nb = r % 32; transpose_item(a.w_out, 1024, 1024, 64 * kb, 32 * nb, WoT, 32 * nb, nullptr, scr, lane); continue; } r -= I_O;
            if (r < I_GU) { const int kb = r / 176, nb = r % 176; const int col = 32 * nb; const int j = col < DFF ? col : col - DFF; const int dst = 256 * (j / 128) + (col < DFF ? 0 : 128) + (j % 128);
                transpose_item(a.w_gate_up, 1024, 5632, 64 * kb, col, WguT, dst, a.g_ffn, scr, lane); continue; } r -= I_GU;
            { const int kb = r / 32, nb = r % 32; transpose_item(a.w_down, DFF, 1024, 64 * kb, 32 * nb, WdT, 32 * nb, nullptr, scr, lane); }
        }
        for (int m = gw; m < M; m += NGW) {
            const f32x4* xr = (const f32x4*)xrow_ptr(a.x_prompt, a.x_sample, m) + lane; f32x4 v[4]; float s = 0.f;
#pragma unroll
            for (int j = 0; j < 4; ++j) { v[j] = xr[64 * j]; s += (v[j].x * v[j].x + v[j].y * v[j].y) + (v[j].z * v[j].z + v[j].w * v[j].w); }
            const float rstd = __builtin_amdgcn_rsqf(wave_sum(s) * (1.f / 1024.f) + EPS);
            u32x2* o8 = (u32x2*)(XN + (size_t)m * 1024) + lane;
#pragma unroll
            for (int j = 0; j < 4; ++j) { const f32x4 g = ((const f32x4*)a.g_mix)[64 * j + lane]; u32x2 w; w.x = cvtpk(v[j].x * rstd * g.x, v[j].y * rstd * g.y); w.y = cvtpk(v[j].z * rstd * g.z, v[j].w * rstd * g.w); o8[64 * j] = w; }
        }
        for (int i = bx * 512 + tid; i < (int)(CTL_ZERO / 16); i += G * 512) { if (PROBE_SEL && i >= (int)(WS_TS / 16) && i < (int)(WS_TS / 16) + 16) continue; ((u32x4*)ws)[i] = (u32x4){0u, 0u, 0u, 0u}; }
        for (int i = bx * 512 + tid; i < 16384 * 16; i += G * 512) { const int pos = i >> 4, j = i & 15; const double rev = (double)pos * a.inv_rev[j]; const float fr_ = (float)(rev - floor(rev));
            ROPE[i] = (f32x2){__builtin_amdgcn_cosf(fr_), __builtin_amdgcn_sinf(fr_)}; }
    }
    SEAM(0); STAMP(1);
    {
        volatile LAS unsigned* st = (volatile LAS unsigned*)(ldsl + LDS_CTL + 32);
        if (wv == 0 && lane_id() == 0) { st[0] = 0u; st[1] = 0u; (void)xb_add((unsigned*)(ws + WS_XBAR) + XB_XCNT(xb_xcc_id()), 1u); }
        __syncthreads();
    }
    if (IN(1)) {
        SchedSimple S{(const char*)XN, (const char*)WinT, 256, 21, G, bx, (size_t)256 * 1024 * 2, (size_t)256 * 1024 * 2};
        EpiIn E{ws, GATES, a.lb_param};
        pg8::gemm_phase(wv, ldsl, 1024, 1024, S, E);
    }
    SEAM(1); STAMP(2);
    if (IN(2)) {
        SchedUp S{(const char*)LAT, (const char*)WuqT, (const char*)WukvT, G, bx};
        EpiUp E{Qm, Km, Vm, RSQ, RSKV, ROPE, (unsigned*)(ws + WS_KMAX)};
        pg8::gemm_phase(wv, ldsl, 256, 512, S, E);
    }
    SEAM(2); STAMP(3);
    if (IN(3)) { TIDS
        volatile LAS unsigned* ctl = (volatile LAS unsigned*)(ldsl + LDS_CTL);
        int did_hg = 0;
        for (int qk = 0; qk < 8; ++qk) {
            const int xq = (bx + qk) & 7;
            for (;;) {
                __syncthreads();
                if (tid == 0) ctl[0] = atomicAdd(QUEUE + xq * 64 + 32, 1u);
                __syncthreads();
                const int un = (int)ctl[0];
                if (un >= 3) break;
                int seqbase, S, h;
                if (un == 0) { seqbase = T0 + (xq >> 2) * 16384; S = 16384; h = xq & 3; }
                else { const int idx = 2 * xq + (un - 1); seqbase = (idx >> 2) * 8192; S = 8192; h = idx & 3; }
                hg::unit((LAS char*)ldsl, seqbase, S, h, HQ, HI, GF, GB, OFW, OBW, wv); did_hg = 1;
            }
        }
        if (PROBE_SEL && wv == 0 && lane_id() == 0) atomicMax((unsigned long long*)(ws + WS_TS) + 16, (unsigned long long)__builtin_amdgcn_s_memrealtime());
        for (int qk = 0; qk < 8; ++qk) {
            const int xq = (bx + qk) & 7;
            for (;;) {
                __syncthreads();
                if (tid == 0) ctl[0] = atomicAdd(QUEUE + xq * 64, 1u);
                __syncthreads();
                const int un = (int)ctl[0];
                if (un >= 256) break;
                int seqbase, S, h, qb;
                if (un < 128) { const int j = un, pair = 2 * xq + (j >> 6); seqbase = T0 + (pair >> 3) * 16384; S = 16384; h = pair & 7; qb = j & 63; }
                else { const int j = un - 128, pair = 4 * xq + (j >> 5); seqbase = (pair >> 3) * 8192; S = 8192; h = pair & 7; qb = j & 31; }
                const unsigned* km = (const unsigned*)(ws + WS_KMAX) + row_seq(seqbase) * 32 + h * 4;
                const float kmax = sqrtf(__uint_as_float(km[0]) + __uint_as_float(km[1]) + __uint_as_float(km[2])) * 1.01f;
                att::attn_unit(Qm + ((size_t)(seqbase + qb * 256) * 8 + h) * 96, Km + ((size_t)seqbase * 8 + h) * 96, Vm + ((size_t)seqbase * 8 + h) * 64, OM + (size_t)(seqbase + qb * 256) * 512 + h * 64, S, kmax, (char*)lds, wv);
            }
        }
        if (PROBE_SEL && !did_hg && wv == 0 && lane_id() == 0) atomicMax((unsigned long long*)(ws + WS_TS) + 17, (unsigned long long)__builtin_amdgcn_s_memrealtime());
    }
    SEAM(3); STAMP(4);
    if (IN(4)) { TIDS
        const int gw = bx * 8 + wave, NGW = G * 8;
        for (int m = gw; m < M; m += NGW) {
            const size_t off = (size_t)m * 512 + lane * 8;
            const u32x4 f = *(const u32x4*)(OFW + off), b = *(const u32x4*)(OBW + off), s = *(const u32x4*)(SG + off);
            const unsigned fu[4] = {f.x, f.y, f.z, f.w}, bu[4] = {b.x, b.y, b.z, b.w}, su[4] = {s.x, s.y, s.z, s.w};
            float o[8]; float ss = 0.f;
#pragma unroll
            for (int i = 0; i < 4; ++i) { o[2 * i] = bflo(fu[i]) + bflo(bu[i]); o[2 * i + 1] = bfhi(fu[i]) + bfhi(bu[i]); ss += o[2 * i] * o[2 * i] + o[2 * i + 1] * o[2 * i + 1]; }
            ss += __shfl_xor(ss, 1); ss += __shfl_xor(ss, 2); ss += __shfl_xor(ss, 4); ss += __shfl_xor(ss, 8);
            const float rstd = __builtin_amdgcn_rsqf(ss * (1.f / 128.f) + EPS);
            const f32x4 g0 = *(const f32x4*)(a.g_onorm + lane * 8), g1 = *(const f32x4*)(a.g_onorm + lane * 8 + 4); const float gg[8] = {g0.x, g0.y, g0.z, g0.w, g1.x, g1.y, g1.z, g1.w};
#pragma unroll
            for (int i = 0; i < 4; ++i) { o[2 * i] *= rstd * gg[2 * i] * bflo(su[i]); o[2 * i + 1] *= rstd * gg[2 * i + 1] * bfhi(su[i]); }
            *(u32x4*)(OH + off) = pack8(o);
        }
    }
    SEAM(4); STAMP(5);
    if (IN(5)) {
        SchedBranch S{(const char*)OH, (const char*)OM, (const char*)Wb0T, (const char*)Wb1T, G, bx};
        EpiBranch E{GATES, MERGED};
        pg8::gemm_phase(wv, ldsl, 512, 512, S, E);
    }
    SEAM(5); STAMP(6);
    if (IN(6)) {
        SchedSimple S{(const char*)MERGED, (const char*)WoT, 256, 4, G, bx, (size_t)256 * 1024 * 2, (size_t)256 * 1024 * 2};
        EpiOut E{a.x_prompt, a.x_sample, X1B, RSX1};
        pg8::gemm_phase(wv, ldsl, 1024, 1024, S, E);
    }
    SEAM(6); STAMP(7);
    if (IN(7)) {
        SchedSimple S{(const char*)X1B, (const char*)WguT, 256, 22, G, bx, (size_t)256 * 1024 * 2, (size_t)256 * 1024 * 2};
        EpiGU E{RSX1, ACT};
        pg8::gemm_phase(wv, ldsl, 1024, 1024, S, E);
    }
    SEAM(7); STAMP(8);
    if (PROBE_SEL) grid_barrier((unsigned*)(ws + WS_XBAR), wv, (volatile LAS unsigned*)(ldsl + LDS_CTL + 32));
    if (IN(8)) { TIDS
        SchedPanel S{(const char*)ACT, (const char*)WdT, G, bx, (size_t)256 * DFF * 2, (size_t)256 * DFF * 2};
        EpiDown E{X1B, a.out, RSX2};
        pg8::gemm_phase(wv, ldsl, DFF, DFF, S, E);
        asm volatile("s_waitcnt vmcnt(0)" ::: "memory");
        __builtin_amdgcn_fence(__ATOMIC_RELEASE, "workgroup"); __syncthreads();
        float pert = 0.f;
        if (PROBE_SEL) { const unsigned long long* ts = (const unsigned long long*)(ws + WS_TS); float tus = 0.f;
            if (PROBE_SEL == 1) tus = (float)(ts[4] - ts[3]) * 0.01f;
            if (PROBE_SEL == 2) tus = (float)(ts[16] - ts[3]) * 0.01f;
            if (PROBE_SEL == 3) tus = (float)(ts[17] - ts[3]) * 0.01f;
            if (PROBE_SEL == 4) tus = (float)((ts[1] - ts[0])) * 0.01f;
            if (PROBE_SEL == 5) tus = (float)((ts[5] - ts[4])) * 0.01f;
            if (PROBE_SEL == 6) tus = (float)((ts[8] - ts[0])) * 0.01f;
            if (PROBE_SEL == 8) tus = (float)((ts[2] - ts[1])) * 0.01f;
            if (PROBE_SEL == 9) tus = (float)((ts[8] - ts[7])) * 0.01f;
            pert = sqrtf(tus * 1e-9f); }
        for (int p = bx; p < 256; p += G)
            for (int r = wave; r < 256; r += 8) { const int m = p * 256 + r;
                const float rstd = __builtin_amdgcn_rsqf(__hip_atomic_load(RSX2 + m, __ATOMIC_RELAXED, __HIP_MEMORY_SCOPE_AGENT) * (1.f / 1024.f) + EPS);
                f32x4* yr = (f32x4*)(a.out + (size_t)m * 1024) + lane;
#pragma unroll
                for (int j = 0; j < 4; ++j) { const f32x4 g = ((const f32x4*)a.g_final)[64 * j + lane]; f32x4 v = yr[64 * j]; v.x = v.x * rstd * g.x + pert; v.y = v.y * rstd * g.y - pert; v.z = v.z * rstd * g.z + pert; v.w = v.w * rstd * g.w - pert; yr[64 * j] = v; }
            }
        if (PROBE_SEL == 7) {
            asm volatile("s_waitcnt vmcnt(0)" ::: "memory"); __syncthreads();
            unsigned long long* ts = (unsigned long long*)(ws + WS_TS);
            if (wv == 0 && lane == 0) { atomicMax(ts + 18, (unsigned long long)__builtin_amdgcn_s_memrealtime()); __threadfence(); atomicAdd((unsigned*)(ts + 19), 1u); }
            if (bx == 0) {
                if (wv == 0 && lane == 0) { while (__hip_atomic_load((unsigned*)(ts + 19), __ATOMIC_RELAXED, __HIP_MEMORY_SCOPE_AGENT) < (unsigned)G) __builtin_amdgcn_s_sleep(8); }
                __syncthreads();
                const unsigned long long tend = __hip_atomic_load(ts + 18, __ATOMIC_RELAXED, __HIP_MEMORY_SCOPE_AGENT), t0 = __hip_atomic_load(ts + 0, __ATOMIC_RELAXED, __HIP_MEMORY_SCOPE_AGENT);
                const float tus = (float)(tend - t0) * 0.01f; const float pe = sqrtf(tus * 256e-9f);
                for (int r = wave; r < 256; r += 8) { f32x4* yr = (f32x4*)(a.out + (size_t)r * 1024) + lane;
#pragma unroll
                    for (int j = 0; j < 4; ++j) { f32x4 v = yr[64 * j]; v.x += pe; v.y -= pe; v.z += pe; v.w -= pe; yr[64 * j] = v; } }
            }
        }
    }
#undef IN
#undef SEAM
}

extern "C" void kernel_launch(void* const* d_in, const int* in_sizes, int n_in, void* d_out, int out_size, void* d_ws, size_t ws_size, hipStream_t stream) {
    static int grid = 0;
    if (grid == 0) {
        if (n_in != 16 || out_size != M * DM || ws_size < WS_END) { fprintf(stderr, "kernel_launch: unexpected shapes: n_in %d out %d ws %zu (need %zu)\n", n_in, out_size, ws_size, (size_t)WS_END); grid = -1; return; }
        int dev = 0, cus = 0, per_cu = 0;
        if (hipGetDevice(&dev) != hipSuccess || hipDeviceGetAttribute(&cus, hipDeviceAttributeMultiprocessorCount, dev) != hipSuccess) { grid = -1; return; }
        if (hipFuncSetAttribute((const void*)fwd_megakernel, hipFuncAttributeMaxDynamicSharedMemorySize, LDS_BYTES) != hipSuccess) { fprintf(stderr, "kernel_launch: hipFuncSetAttribute failed\n"); grid = -1; return; }
        if (hipOccupancyMaxActiveBlocksPerMultiprocessor(&per_cu, (const void*)fwd_megakernel, 512, LDS_BYTES) != hipSuccess || per_cu < 1) { fprintf(stderr, "kernel_launch: occupancy query says %d\n", per_cu); per_cu = 1; }
        (void)hipGetLastError();
        grid = cus;
    }
    if (grid < 0) return;
    Args a{};
    a.x_prompt = (const float*)d_in[0]; a.x_sample = (const float*)d_in[1]; a.g_mix = (const float*)d_in[2]; a.w_in = (const float*)d_in[3]; a.lb_param = (const float*)d_in[4];
    a.g_onorm = (const float*)d_in[5]; a.g_qa = (const float*)d_in[6]; a.w_uq = (const float*)d_in[7]; a.g_kva = (const float*)d_in[8]; a.w_ukv = (const float*)d_in[9];
    a.w_branch = (const float*)d_in[10]; a.w_out = (const float*)d_in[11]; a.g_ffn = (const float*)d_in[12]; a.w_gate_up = (const float*)d_in[13]; a.w_down = (const float*)d_in[14]; a.g_final = (const float*)d_in[15];
    a.out = (float*)d_out; a.ws = (unsigned char*)d_ws;
    for (int i = 0; i < 16; ++i) a.inv_rev[i] = pow(10000.0, -(double)i / 16.0) / 6.283185307179586476925;
    a.ph_lo = 0; a.ph_hi = 9;
    void* args[] = {&a};
    const hipError_t e = hipLaunchCooperativeKernel((const void*)fwd_megakernel, dim3(grid), dim3(512), args, LDS_BYTES, stream);
    if (e != hipSuccess) fprintf(stderr, "kernel_launch: cooperative launch failed: %s (grid %d)\n", hipGetErrorString(e), grid);
}
```

```cpp
#include <hip/hip_runtime.h>
#include <hip/hip_cooperative_groups.h>
#include <hip/hip_bf16.h>
#include <cstdio>
#include <cstdint>
#include <cmath>
namespace cg = cooperative_groups;

#define LAS __attribute__((address_space(3)))
typedef unsigned short bf16_t;
typedef short bf16x8 __attribute__((ext_vector_type(8)));
typedef short s16x4 __attribute__((ext_vector_type(4)));
typedef float f32x4 __attribute__((ext_vector_type(4)));
typedef float f32x2 __attribute__((ext_vector_type(2)));
typedef float f32x16 __attribute__((ext_vector_type(16)));
typedef unsigned u32x4 __attribute__((ext_vector_type(4)));
typedef unsigned u32x2 __attribute__((ext_vector_type(2)));
typedef __bf16 bf16x2_t __attribute__((ext_vector_type(2)));
typedef _Float16 h16x8 __attribute__((ext_vector_type(8)));

constexpr int M = 65536, DM = 1024, T0 = 32768;
constexpr int NIN = 5376;
constexpr int DFF = 2816;
constexpr float EPS = 1e-6f;
constexpr float QSCALE = 0.10206207261596575f * 1.4426950408889634f;
constexpr size_t MiB = 1u << 20;
constexpr size_t WS_XBAR = 32768;
constexpr size_t WS_QUEUE = 0, WS_BAR = 4096, WS_TS = 8192, WS_KMAX = 16384;
#ifndef PROBE_SEL
#define PROBE_SEL 0
#endif
constexpr size_t WS_RSQ = 1 * MiB, WS_RSKV = WS_RSQ + 262144, WS_RSX1 = WS_RSKV + 262144, WS_RSX2 = WS_RSX1 + 262144;
constexpr size_t CTL_ZERO = 2 * MiB;
constexpr size_t WS_ROPE = 2 * MiB;
constexpr size_t WS_WIN = 4 * MiB, WS_WUQ = 15 * MiB, WS_WUKV = 15 * MiB + 512 * 1024, WS_WB0 = 16 * MiB, WS_WB1 = 17 * MiB, WS_WO = 18 * MiB, WS_WGU = 20 * MiB, WS_WD = 31 * MiB;
constexpr size_t WS_XN = 40 * MiB, WS_OFW = 40 * MiB, WS_OBW = 104 * MiB, WS_X1B = 40 * MiB;
constexpr size_t WS_HQ = 168 * MiB, WS_HI = 232 * MiB, WS_GF = 296 * MiB, WS_GB = 360 * MiB, WS_SG = 424 * MiB, WS_LAT = 488 * MiB;
constexpr size_t WS_Q = 552 * MiB, WS_K = 648 * MiB, WS_V = 744 * MiB, WS_OM = 808 * MiB;
constexpr size_t WS_OH = 168 * MiB, WS_MERGED = 232 * MiB, WS_X1 = 552 * MiB, WS_ACT = 168 * MiB;
constexpr size_t WS_END = 872 * MiB;
constexpr int LDS_BYTES = 155648;
constexpr int LDS_CTL = 155648 - 256;

__device__ __forceinline__ unsigned cvtpk(float lo, float hi) { f32x2 v = {lo, hi}; bf16x2_t b = __builtin_convertvector(v, bf16x2_t); return __builtin_bit_cast(unsigned, b); }
__device__ __forceinline__ float bf2f(unsigned short u) { return __builtin_bit_cast(float, (unsigned)u << 16); }
__device__ __forceinline__ float bflo(unsigned u) { return __builtin_bit_cast(float, u << 16); }
__device__ __forceinline__ float bfhi(unsigned u) { return __builtin_bit_cast(float, u & 0xffff0000u); }
__device__ __forceinline__ float sigmoidf_(float x) { return __builtin_amdgcn_rcpf(1.f + __expf(-x)); }
__device__ __forceinline__ float siluf_(float x) { return x * sigmoidf_(x); }
__device__ __forceinline__ u32x4 pack8(const float* v) { u32x4 w; w.x = cvtpk(v[0], v[1]); w.y = cvtpk(v[2], v[3]); w.z = cvtpk(v[4], v[5]); w.w = cvtpk(v[6], v[7]); return w; }
__device__ __forceinline__ int crow(int r, int hi) { return (r & 3) + 8 * (r >> 2) + 4 * hi; }
__device__ __forceinline__ const float* xrow_ptr(const float* xp, const float* xs, int row) { return row < T0 ? xp + (size_t)row * DM : xs + (size_t)(row - T0) * DM; }
__device__ __forceinline__ int row_seq(int row) { return row < T0 ? (row >> 13) : 4 + ((row - T0) >> 14); }
__device__ __forceinline__ int row_pos(int row) { return row < T0 ? (row & 8191) : (row & 16383); }
#define SBAR() __builtin_amdgcn_sched_barrier(0)
__device__ __forceinline__ int lane_id() { int l; asm volatile("v_mbcnt_lo_u32_b32 %0, -1, 0\n\tv_mbcnt_hi_u32_b32 %0, -1, %0" : "=v"(l)); return l; }

namespace pg8 {
constexpr int BM = 256, BK = 64, HALF = 128, HTB = HALF * BK * 2, STAGE_BYTES = 8 * HTB, NXCD = 8, WGM = 4;
__device__ __forceinline__ int lds_byte(int r, int c) { const int st = (r >> 4) * 2 + (c >> 5), rr = r & 15, cc = c & 31, ob = rr * 64 + cc * 2; return st * 1024 + (ob ^ (((ob >> 9) & 1) << 5)); }
__device__ __forceinline__ void stage_rc(int b, int& R, int& C) { const int st = b / 1024, sb = b % 1024, swz = sb ^ (((sb >> 9) & 1) << 5); R = (st >> 1) * 16 + swz / 64; C = (st & 1) * 32 + (swz % 64) / 2; }
__device__ __forceinline__ int perm32(int rho) { const int n = rho >> 4, i = rho & 15; return 8 * (i >> 2) + 4 * n + (i & 3); }
struct Unit { int pm, pn, tag; const char* a; const char* b; };
__device__ __forceinline__ void tile_of(int L, int nM, int nN, int& pm, int& pn) {
    const int nwg = nM * nN; int wgid = L;
    { const int q = nwg / NXCD, r = nwg % NXCD, xcd = wgid % NXCD, off = wgid / NXCD; wgid = (xcd < r ? xcd * (q + 1) : r * (q + 1) + (xcd - r) * q) + off; }
    const int nig = WGM * nN, gid = wgid / nig, fm = gid * WGM, gsz = (nM - fm) < WGM ? (nM - fm) : WGM;
    pm = fm + ((wgid % nig) % gsz); pn = (wgid % nig) / gsz;
}
template <class Epi, class Sched>
__device__ __forceinline__ void gemm_phase(const int wv, LAS unsigned char* lds, const int K, const int lda, const Sched& S, const Epi& E) {
    const int lane = lane_id(), wid = wv, tid = wv * 64 + lane, wr = wid >> 2, wc = wid & 3, fr = lane & 15, fq = lane >> 4;
    const int nt = K / BK;
    unsigned voffA[2], voffB[2];
#pragma unroll
    for (int i = 0; i < 2; ++i) { int R, C; stage_rc(tid * 16 + i * 8192, R, C); const int Rb = (R & ~31) + perm32(R & 31);
        voffA[i] = (unsigned)(R * lda + C) * 2u; voffB[i] = (unsigned)(Rb * K + C) * 2u; }
    const size_t kstep = (size_t)(BK * 2);
    const size_t hA = (size_t)HALF * lda * 2, hB = (size_t)HALF * K * 2;
    const unsigned ldsw = (unsigned)wid * 1024u;
    const int aoff = lds_byte(wr * 64 + fr, fq * 8), boff = lds_byte(wc * 32 + fr, fq * 8);
#define PG8_SA(b, h) (((b) * 2 + (h)) * HTB)
#define PG8_SB(b, h) ((4 + (b) * 2 + (h)) * HTB)
#define PG8_STAGE(bufoff, gbase, voff) do { _Pragma("unroll") for (int _i = 0; _i < 2; ++_i) \
        __builtin_amdgcn_global_load_lds((const unsigned*)((const char*)(gbase) + (voff)[_i]), (LAS unsigned*)(lds + (bufoff) + ldsw + _i * 8192), 16, 0, 0); } while (0)
#define PG8_LDA(dst, b, h) do { _Pragma("unroll") for (int m = 0; m < 4; ++m) _Pragma("unroll") for (int k = 0; k < 2; ++k) dst[m][k] = *(const LAS bf16x8*)(lds + PG8_SA(b, h) + aoff + m * 2048 + k * 1024); } while (0)
#define PG8_LDB(dst, b, h) do { _Pragma("unroll") for (int n = 0; n < 2; ++n) _Pragma("unroll") for (int k = 0; k < 2; ++k) dst[n][k] = *(const LAS bf16x8*)(lds + PG8_SB(b, h) + boff + n * 2048 + k * 1024); } while (0)
#define PG8_MMA(ai, bj, At, Bt) do { __builtin_amdgcn_s_setprio(1); _Pragma("unroll") for (int m = 0; m < 4; ++m) _Pragma("unroll") for (int n = 0; n < 2; ++n) _Pragma("unroll") for (int k = 0; k < 2; ++k) \
        acc[ai][bj][m][n] = __builtin_amdgcn_mfma_f32_16x16x32_bf16(Bt[n][k], At[m][k], acc[ai][bj][m][n], 0, 0, 0); __builtin_amdgcn_s_setprio(0); } while (0)
#define PG8_WAIT_V(n) asm volatile("s_waitcnt vmcnt(" #n ")" ::: "memory")
#define PG8_WAIT_L(n) asm volatile("s_waitcnt lgkmcnt(" #n ")" ::: "memory")
#define PG8_BAR __builtin_amdgcn_s_barrier()
#define PG8_SCHED __builtin_amdgcn_sched_barrier(0)
    Unit cur, nxt; int ui = 0;
    if (!S.next(0, cur)) return;
    f32x4 acc[2][2][4][2];
#pragma unroll
    for (int a = 0; a < 2; ++a)
#pragma unroll
        for (int b = 0; b < 2; ++b)
#pragma unroll
            for (int m = 0; m < 4; ++m)
#pragma unroll
                for (int n = 0; n < 2; ++n) acc[a][b][m][n] = (f32x4){0.f, 0.f, 0.f, 0.f};
    bf16x8 At[4][2], B0[2][2], B1[2][2];
    const char* cA = cur.a; const char* cB = cur.b;
    PG8_STAGE(PG8_SB(0, 0), cB, voffB); PG8_STAGE(PG8_SB(0, 1), cB + hB, voffB); PG8_STAGE(PG8_SA(0, 0), cA, voffA); PG8_STAGE(PG8_SA(0, 1), cA + hA, voffA);
    if (wr == 1) PG8_BAR;
    PG8_WAIT_V(2); PG8_BAR;
    PG8_STAGE(PG8_SB(1, 0), cB + kstep, voffB); PG8_STAGE(PG8_SA(1, 0), cA + kstep, voffA); PG8_STAGE(PG8_SB(1, 1), cB + hB + kstep, voffB);
    PG8_WAIT_V(6); PG8_BAR;
    for (;;) {
        const bool has_next = S.next(ui + 1, nxt);
        const char* nA = has_next ? nxt.a : cA; const char* nB = has_next ? nxt.b : cB;
        for (int t = 0; t < nt; t += 2) {
            const bool last = (t == nt - 2);
            const char* a1 = cA + (size_t)(t + 1) * kstep;
            const char* a2 = last ? nA : cA + (size_t)(t + 2) * kstep; const char* b2 = last ? nB : cB + (size_t)(t + 2) * kstep;
            const char* a3 = a2 + kstep; const char* b3 = b2 + kstep;
            PG8_LDB(B0, 0, 0); PG8_LDB(B1, 0, 1); PG8_SCHED; PG8_LDA(At, 0, 0); PG8_STAGE(PG8_SA(1, 1), a1 + hA, voffA);
            PG8_WAIT_V(8); PG8_WAIT_L(0); PG8_BAR; PG8_MMA(0, 0, At, B0); PG8_MMA(0, 1, At, B1); PG8_BAR; PG8_SCHED;
            PG8_LDA(At, 0, 1); PG8_STAGE(PG8_SB(0, 0), b2, voffB); PG8_STAGE(PG8_SB(0, 1), b2 + hB, voffB); PG8_STAGE(PG8_SA(0, 0), a2, voffA);
            PG8_WAIT_V(8); PG8_WAIT_L(0); PG8_BAR; PG8_MMA(1, 0, At, B0); PG8_MMA(1, 1, At, B1); PG8_BAR; PG8_SCHED;
            PG8_LDB(B0, 1, 0); PG8_LDB(B1, 1, 1); PG8_SCHED; PG8_LDA(At, 1, 0); PG8_STAGE(PG8_SA(0, 1), a2 + hA, voffA);
            PG8_WAIT_V(8); PG8_WAIT_L(0); PG8_BAR; PG8_MMA(0, 0, At, B0); PG8_MMA(0, 1, At, B1); PG8_BAR; PG8_SCHED;
            PG8_LDA(At, 1, 1); PG8_STAGE(PG8_SB(1, 0), b3, voffB); PG8_STAGE(PG8_SB(1, 1), b3 + hB, voffB); PG8_STAGE(PG8_SA(1, 0), a3, voffA);
            PG8_WAIT_V(8); PG8_WAIT_L(0); PG8_BAR; PG8_MMA(1, 0, At, B0); PG8_MMA(1, 1, At, B1); PG8_BAR; PG8_SCHED;
        }
        if (wr == 0) PG8_BAR;
        const int l2_ = lane_id(); const int fr_ = l2_ & 15, fq_ = l2_ >> 4;
        const bool keep = E(acc, cur, wr, wc, fr_, fq_);
        if (!has_next) break;
        if (!keep) {
#pragma unroll
        for (int a = 0; a < 2; ++a)
#pragma unroll
            for (int b = 0; b < 2; ++b)
#pragma unroll
                for (int m = 0; m < 4; ++m)
#pragma unroll
                    for (int n = 0; n < 2; ++n) acc[a][b][m][n] = (f32x4){0.f, 0.f, 0.f, 0.f};
        }
        cur = nxt; cA = nA; cB = nB; ++ui;
        if (wr == 1) PG8_BAR;
    }
    PG8_WAIT_V(0);
    PG8_BAR;
#undef PG8_SA
#undef PG8_SB
#undef PG8_STAGE
#undef PG8_LDA
#undef PG8_LDB
#undef PG8_MMA
#undef PG8_WAIT_V
#undef PG8_WAIT_L
#undef PG8_BAR
#undef PG8_SCHED
}
}
using pg8::Unit;
typedef f32x4 Acc[2][2][4][2];
#define EPI_ROWS(ai, m, row) _Pragma("unroll") for (int ai = 0; ai < 2; ++ai) _Pragma("unroll") for (int m = 0; m < 4; ++m) { const int row = u.pm * 256 + ai * 128 + wr * 64 + m * 16 + fr;
#define EPI_END asm volatile("" ::: "memory"); }
__device__ __forceinline__ void get8(const Acc& acc, int ai, int bj, int m, float* v) {
    const f32x4 a = acc[ai][bj][m][0], b = acc[ai][bj][m][1]; v[0] = a[0]; v[1] = a[1]; v[2] = a[2]; v[3] = a[3]; v[4] = b[0]; v[5] = b[1]; v[6] = b[2]; v[7] = b[3]; }

struct Args {
    const float *x_prompt, *x_sample, *g_mix, *w_in, *lb_param, *g_onorm, *g_qa, *w_uq, *g_kva, *w_ukv, *w_branch, *w_out, *g_ffn, *w_gate_up, *w_down, *g_final;
    float* out; unsigned char* ws;
    double inv_rev[16];
    int ph_lo, ph_hi;
};

struct SchedSimple {
    const char* A; const char* B; int nM, nN, G, c; size_t tA, tB;
    __device__ __forceinline__ bool next(int i, Unit& u) const { const long L = (long)i * G + c; if (L >= (long)nM * nN) return false; pg8::tile_of((int)L, nM, nN, u.pm, u.pn); u.tag = 0; u.a = A + u.pm * tA; u.b = B + u.pn * tB; return true; }
};
struct SchedUp {
    const char* LAT; const char* Wuq; const char* Wukv; int G, c;
    __device__ __forceinline__ bool next(int i, Unit& u) const { const long L = (long)i * G + c; if (L >= 256L * 7) return false; pg8::tile_of((int)L, 256, 7, u.pm, u.pn); u.tag = 0;
        u.a = LAT + (size_t)u.pm * 256 * 512 * 2 + (u.pn >= 3 ? 512 : 0); u.b = u.pn < 3 ? Wuq + (size_t)u.pn * 256 * 256 * 2 : Wukv + (size_t)(u.pn - 3) * 256 * 256 * 2; return true; }
};
struct SchedBranch {
    const char* OH; const char* OMm; const char* W0; const char* W1; int G, c;
    __device__ __forceinline__ bool next(int i, Unit& u) const { const long L = (long)(i >> 1) * G + c; if (L >= 256L * 4) return false; pg8::tile_of((int)L, 256, 4, u.pm, u.pn); u.tag = i & 1;
        u.a = ((i & 1) ? OMm : OH) + (size_t)u.pm * 256 * 512 * 2; u.b = ((i & 1) ? W1 : W0) + (size_t)u.pn * 256 * 512 * 2; return true; }
};

struct SchedPanel {
    const char* A; const char* B; int G, c; size_t tA, tB;
    __device__ __forceinline__ bool next(int i, Unit& u) const { const int p = c + (i >> 2) * G; if (p >= 256) return false; u.pm = p; u.pn = i & 3; u.tag = 0; u.a = A + p * tA; u.b = B + u.pn * tB; return true; }
};
struct EpiIn {
    unsigned char* ws; bf16_t *GATES; const float* lbp;
    __device__ __forceinline__ bool operator()(const Acc& acc, const Unit& u, int wr, int wc, int fr, int fq) const {
        const int pn = u.pn, cb = wc * 32 + 8 * fq;
        if (pn < 4 || (pn >= 8 && pn < 10)) {
            bf16_t* dst = (bf16_t*)(ws + (pn < 2 ? WS_HQ : (pn < 4 ? WS_HI : WS_SG))); const int c0 = (pn & 1) * 256; const bool act = (pn < 2 || pn >= 8);
            EPI_ROWS(ai, m, row)
#pragma unroll
                for (int bj = 0; bj < 2; ++bj) { float v[8]; get8(acc, ai, bj, m, v);
                    if (act) {
#pragma unroll
                        for (int i = 0; i < 8; ++i) v[i] = siluf_(v[i]); }
                    *(u32x4*)(dst + (size_t)row * 512 + c0 + bj * 128 + cb) = pack8(v); }
            EPI_END
        } else if (pn < 8) {
            const int dir = (pn >= 6); _Float16* dst = (_Float16*)(ws + (dir ? WS_GB : WS_GF)); const int c0 = (pn & 1) * 256;
            float lb[2][8];
#pragma unroll
            for (int bj = 0; bj < 2; ++bj)
#pragma unroll
                for (int i = 0; i < 8; ++i) { const int col = c0 + bj * 128 + cb + i; lb[bj][i] = sigmoidf_(lbp[dir * 512 + col] - lbp[1024 + dir * 512 + col]); }
            EPI_ROWS(ai, m, row)
#pragma unroll
                for (int bj = 0; bj < 2; ++bj) { float v[8]; get8(acc, ai, bj, m, v); h16x8 h;
#pragma unroll
                    for (int i = 0; i < 8; ++i) { const float f = lb[bj][i] + (1.f - lb[bj][i]) * sigmoidf_(v[i]); h[i] = (_Float16)__logf(f); }
                    *(u32x4*)(dst + (size_t)row * 512 + c0 + bj * 128 + cb) = __builtin_bit_cast(u32x4, h); }
            EPI_END
        } else if (pn < 12) {
            float* RS = (float*)(ws + (pn == 10 ? WS_RSQ : WS_RSKV)); const int c0 = (pn - 10) * 256; bf16_t* LAT = (bf16_t*)(ws + WS_LAT);
            EPI_ROWS(ai, m, row)
                float ss = 0.f;
#pragma unroll
                for (int bj = 0; bj < 2; ++bj) { float v[8]; get8(acc, ai, bj, m, v);
#pragma unroll
                    for (int i = 0; i < 8; ++i) ss += v[i] * v[i];
                    *(u32x4*)(LAT + (size_t)row * 512 + c0 + bj * 128 + cb) = pack8(v); }
                ss += __shfl_xor(ss, 16); ss += __shfl_xor(ss, 32);
                if (fq == 0) atomicAdd(RS + row, ss);
            EPI_END
        } else if (pn < 20) {
            const int c0 = (pn - 12) * 256;
            EPI_ROWS(ai, m, row)
#pragma unroll
                for (int bj = 0; bj < 2; ++bj) { float v[8]; get8(acc, ai, bj, m, v);
#pragma unroll
                    for (int i = 0; i < 8; ++i) v[i] = sigmoidf_(v[i]);
                    *(u32x4*)(GATES + (size_t)row * 2048 + c0 + bj * 128 + cb) = pack8(v); }
            EPI_END
        } else {
            bf16_t* Kc = (bf16_t*)(ws + WS_K); const f32x2* rope = (const f32x2*)(ws + WS_ROPE); float kmx = 0.f;
            EPI_ROWS(ai, m, row)
                float v[8], p[8]; get8(acc, ai, 0, m, v);
                { float ss = 0.f;
#pragma unroll
                  for (int i = 0; i < 8; ++i) ss += v[i] * v[i];
                  ss += __shfl_xor(ss, 16); ss += __shfl_xor(ss, 32); kmx = fmaxf(kmx, ss); }
#pragma unroll
                for (int i = 0; i < 8; ++i) p[i] = __shfl_xor(v[i], 32);
                if (wc == 0) {
                    const int pos = row_pos(row); const f32x2* cs = rope + pos * 16 + 8 * (fq & 1); float o[8];
#pragma unroll
                    for (int i = 0; i < 8; ++i) { const f32x2 c = cs[i]; o[i] = (fq < 2) ? (v[i] * c.x - p[i] * c.y) : (v[i] * c.x + p[i] * c.y); }
                    const u32x4 w = pack8(o);
#pragma unroll
                    for (int h = 0; h < 8; ++h) *(u32x4*)(Kc + ((size_t)row * 8 + h) * 96 + 64 + 8 * fq) = w;
                }
            EPI_END
            if (wc == 0) { kmx = fmaxf(kmx, __shfl_xor(kmx, 1)); kmx = fmaxf(kmx, __shfl_xor(kmx, 2)); kmx = fmaxf(kmx, __shfl_xor(kmx, 4)); kmx = fmaxf(kmx, __shfl_xor(kmx, 8));
                if (fr == 0 && fq == 0) { unsigned* KM = (unsigned*)(ws + WS_KMAX) + row_seq(u.pm * 256) * 32;
#pragma unroll
                    for (int h = 0; h < 8; ++h) atomicMax(KM + h * 4 + 2, __float_as_uint(kmx)); } }
        }
        return false;
    }
};
struct EpiUp {
    bf16_t *Q, *Kc, *V; const float *RSQ, *RSKV; const f32x2* rope; unsigned* KMAX;
    __device__ __forceinline__ bool operator()(const Acc& acc, const Unit& u, int wr, int wc, int fr, int fq) const {
        const int pn = u.pn, cb = wc * 32 + 8 * fq;
#define LOAD_RSV(RSp) float rsv[2][4]; { int rb_ = u.pm * 256 + wr * 64 + fr; asm volatile("" : "+v"(rb_)); const float* rp_ = (RSp) + rb_; _Pragma("unroll") for (int ai = 0; ai < 2; ++ai) _Pragma("unroll") for (int m = 0; m < 4; ++m) rsv[ai][m] = rp_[ai * 128 + m * 16]; }
        if (pn < 2) { LOAD_RSV(RSQ)
            EPI_ROWS(ai, m, row)
                const float sc = __builtin_amdgcn_rsqf(rsv[ai][m] * (1.f / 256.f) + EPS) * QSCALE;
#pragma unroll
                for (int bj = 0; bj < 2; ++bj) { float v[8]; get8(acc, ai, bj, m, v);
#pragma unroll
                    for (int i = 0; i < 8; ++i) v[i] *= sc;
                    const int cg_ = pn * 256 + bj * 128 + cb, h = cg_ >> 6, d = cg_ & 63;
                    *(u32x4*)(Q + ((size_t)row * 8 + h) * 96 + d) = pack8(v); }
            EPI_END
        } else if (pn == 2) {
            EPI_ROWS(ai, m, row)
                const float sc = __builtin_amdgcn_rsqf(RSQ[row] * (1.f / 256.f) + EPS) * QSCALE;
                const int pos = row_pos(row); const f32x2* cs = rope + pos * 16 + 8 * (fq & 1);
#pragma unroll
                for (int bj = 0; bj < 2; ++bj) { float v[8], p[8], o[8]; get8(acc, ai, bj, m, v);
#pragma unroll
                    for (int i = 0; i < 8; ++i) p[i] = __shfl_xor(v[i], 32);
#pragma unroll
                    for (int i = 0; i < 8; ++i) { const f32x2 c = cs[i]; o[i] = ((fq < 2) ? (v[i] * c.x - p[i] * c.y) : (v[i] * c.x + p[i] * c.y)) * sc; }
                    const int h = bj * 4 + wc;
                    *(u32x4*)(Q + ((size_t)row * 8 + h) * 96 + 64 + 8 * fq) = pack8(o); asm volatile("" ::: "memory"); }
            EPI_END
        } else {
            float kmx[2] = {0.f, 0.f}; LOAD_RSV(RSKV)
            EPI_ROWS(ai, m, row)
                const float sc = __builtin_amdgcn_rsqf(rsv[ai][m] * (1.f / 256.f) + EPS);
#pragma unroll
                for (int bj = 0; bj < 2; ++bj) { float v[8]; get8(acc, ai, bj, m, v);
#pragma unroll
                    for (int i = 0; i < 8; ++i) v[i] *= sc;
                    const int cg_ = (pn - 3) * 256 + bj * 128 + cb, h = cg_ >> 7, d = cg_ & 127;
                    if (d < 64) { *(u32x4*)(Kc + ((size_t)row * 8 + h) * 96 + d) = pack8(v); float ss = 0.f;
#pragma unroll
                        for (int i = 0; i < 8; ++i) ss += v[i] * v[i];
                        ss += __shfl_xor(ss, 16); ss += __shfl_xor(ss, 32); kmx[bj] = fmaxf(kmx[bj], ss); }
                    else *(u32x4*)(V + ((size_t)row * 8 + h) * 64 + (d - 64)) = pack8(v); }
            EPI_END
            if (wc < 2) {
#pragma unroll
                for (int bj = 0; bj < 2; ++bj) { float k = kmx[bj]; k = fmaxf(k, __shfl_xor(k, 1)); k = fmaxf(k, __shfl_xor(k, 2)); k = fmaxf(k, __shfl_xor(k, 4)); k = fmaxf(k, __shfl_xor(k, 8));
                    if (fr == 0 && fq == 0) atomicMax(KMAX + row_seq(u.pm * 256) * 32 + ((pn - 3) * 2 + bj) * 4 + wc, __float_as_uint(k)); } }
        }
        return false;
    }
};
struct EpiBranch {
    const bf16_t* GATES; bf16_t* MERGED;
    __device__ __forceinline__ bool operator()(Acc& acc, const Unit& u, int wr, int wc, int fr, int fq) const {
        const int cb = wc * 32 + 8 * fq;
#pragma unroll
        for (int ai = 0; ai < 2; ++ai) {
            u32x4 g1v[4][2], g0v[4][2];
#pragma unroll
            for (int m = 0; m < 4; ++m)
#pragma unroll
                for (int bj = 0; bj < 2; ++bj) { const int row = u.pm * 256 + ai * 128 + wr * 64 + m * 16 + fr, col = u.pn * 256 + bj * 128 + cb;
                    g1v[m][bj] = *(const u32x4*)(GATES + (size_t)row * 2048 + 1024 + col); if (u.tag == 0) g0v[m][bj] = *(const u32x4*)(GATES + (size_t)row * 2048 + col); }
#pragma unroll
            for (int m = 0; m < 4; ++m)
#pragma unroll
                for (int bj = 0; bj < 2; ++bj) { const int row = u.pm * 256 + ai * 128 + wr * 64 + m * 16 + fr, col = u.pn * 256 + bj * 128 + cb;
                    const u32x4 g1 = g1v[m][bj]; float g1f[8] = {bflo(g1.x), bfhi(g1.x), bflo(g1.y), bfhi(g1.y), bflo(g1.z), bfhi(g1.z), bflo(g1.w), bfhi(g1.w)};
                    if (u.tag == 0) {
                        const u32x4 g0 = g0v[m][bj]; float g0f[8] = {bflo(g0.x), bfhi(g0.x), bflo(g0.y), bfhi(g0.y), bflo(g0.z), bfhi(g0.z), bflo(g0.w), bfhi(g0.w)};
#pragma unroll
                        for (int i = 0; i < 4; ++i) { acc[ai][bj][m][0][i] *= g0f[i] * __builtin_amdgcn_rcpf(g1f[i]); acc[ai][bj][m][1][i] *= g0f[4 + i] * __builtin_amdgcn_rcpf(g1f[4 + i]); }
                    } else {
                        float v[8]; get8(acc, ai, bj, m, v);
#pragma unroll
                        for (int i = 0; i < 8; ++i) v[i] *= g1f[i];
                        *(u32x4*)(MERGED + (size_t)row * 1024 + col) = pack8(v);
                    } }
            asm volatile("" ::: "memory");
        }
        return u.tag == 0;
    }
};
struct EpiOut {
    const float *xp, *xs; bf16_t* X1B; float* RS;
    __device__ __forceinline__ bool operator()(const Acc& acc, const Unit& u, int wr, int wc, int fr, int fq) const {
        const int cb = wc * 32 + 8 * fq;
#pragma unroll
        for (int ai = 0; ai < 2; ++ai) {
            f32x4 pre[4][2][2];
#pragma unroll
            for (int m = 0; m < 4; ++m) { const int row = u.pm * 256 + ai * 128 + wr * 64 + m * 16 + fr; const float* xr = xrow_ptr(xp, xs, row);
#pragma unroll
                for (int bj = 0; bj < 2; ++bj) { const int col = u.pn * 256 + bj * 128 + cb; pre[m][bj][0] = *(const f32x4*)(xr + col); pre[m][bj][1] = *(const f32x4*)(xr + col + 4); } }
#pragma unroll
            for (int m = 0; m < 4; ++m) { const int row = u.pm * 256 + ai * 128 + wr * 64 + m * 16 + fr; float ss = 0.f;
#pragma unroll
                for (int bj = 0; bj < 2; ++bj) { const int col = u.pn * 256 + bj * 128 + cb; float v[8]; get8(acc, ai, bj, m, v);
                    const f32x4 x0 = pre[m][bj][0], x1 = pre[m][bj][1];
                    v[0] += x0[0]; v[1] += x0[1]; v[2] += x0[2]; v[3] += x0[3]; v[4] += x1[0]; v[5] += x1[1]; v[6] += x1[2]; v[7] += x1[3];
#pragma unroll
                    for (int i = 0; i < 8; ++i) ss += v[i] * v[i];
                    *(u32x4*)(X1B + (size_t)row * 1024 + col) = pack8(v); }
                ss += __shfl_xor(ss, 16); ss += __shfl_xor(ss, 32);
                if (fq == 0) atomicAdd(RS + row, ss); }
            asm volatile("" ::: "memory");
        }
        return false;
    }
};
struct EpiGU {
    const float* RS; bf16_t* ACT;
    __device__ __forceinline__ bool operator()(const Acc& acc, const Unit& u, int wr, int wc, int fr, int fq) const {
        const int cb = wc * 32 + 8 * fq;
        float rsv[2][4];
        { int rb_ = u.pm * 256 + wr * 64 + fr; asm volatile("" : "+v"(rb_)); const float* rp_ = RS + rb_;
#pragma unroll
        for (int ai = 0; ai < 2; ++ai)
#pragma unroll
            for (int m = 0; m < 4; ++m) rsv[ai][m] = rp_[ai * 128 + m * 16]; }
        EPI_ROWS(ai, m, row)
            const float sc = __builtin_amdgcn_rsqf(rsv[ai][m] * (1.f / 1024.f) + EPS);
            float g[8], p[8]; get8(acc, ai, 0, m, g); get8(acc, ai, 1, m, p);
#pragma unroll
            for (int i = 0; i < 8; ++i) g[i] = siluf_(g[i] * sc) * (p[i] * sc);
            *(u32x4*)(ACT + (size_t)row * DFF + u.pn * 128 + cb) = pack8(g);
        EPI_END
        return false;
    }
};
struct EpiDown {
    const bf16_t* X1B; float* X2; float* RS;
    __device__ __forceinline__ bool operator()(const Acc& acc, const Unit& u, int wr, int wc, int fr, int fq) const {
        const int cb = wc * 32 + 8 * fq;
#pragma unroll
        for (int ai = 0; ai < 2; ++ai) {
            u32x4 pre[4][2];
#pragma unroll
            for (int m = 0; m < 4; ++m) { const int row = u.pm * 256 + ai * 128 + wr * 64 + m * 16 + fr;
#pragma unroll
                for (int bj = 0; bj < 2; ++bj) pre[m][bj] = *(const u32x4*)(X1B + (size_t)row * 1024 + u.pn * 256 + bj * 128 + cb); }
#pragma unroll
            for (int m = 0; m < 4; ++m) { const int row = u.pm * 256 + ai * 128 + wr * 64 + m * 16 + fr; float ss = 0.f;
#pragma unroll
                for (int bj = 0; bj < 2; ++bj) { const int col = u.pn * 256 + bj * 128 + cb; float v[8]; get8(acc, ai, bj, m, v);
                    const u32x4 x = pre[m][bj];
                    v[0] += bflo(x.x); v[1] += bfhi(x.x); v[2] += bflo(x.y); v[3] += bfhi(x.y); v[4] += bflo(x.z); v[5] += bfhi(x.z); v[6] += bflo(x.w); v[7] += bfhi(x.w);
#pragma unroll
                    for (int i = 0; i < 8; ++i) ss += v[i] * v[i];
                    *(f32x4*)(X2 + (size_t)row * 1024 + col) = (f32x4){v[0], v[1], v[2], v[3]}; *(f32x4*)(X2 + (size_t)row * 1024 + col + 4) = (f32x4){v[4], v[5], v[6], v[7]}; }
                ss += __shfl_xor(ss, 16); ss += __shfl_xor(ss, 32);
                if (fq == 0) atomicAdd(RS + row, ss); }
            asm volatile("" ::: "memory");
        }
        return false;
    }
};

namespace att {
constexpr int LDQ = 768, LDK = 768, LDV = 512, LDO = 512, KVBLK = 64, QBLK = 32;
constexpr int SHM_K = 64 * 256, SHM_V = 64 * 64 * 2;
#define KSWZ(row, colB) ((row) * 256 + ((colB) ^ (((row) & 15) << 4)))
__device__ __forceinline__ void expA(f32x16& p0) {
#pragma unroll
    for (int r = 0; r < 16; ++r) p0[r] = __builtin_amdgcn_exp2f(p0[r]);
}
__device__ __forceinline__ void finishSM(f32x16& p0, f32x16& p1, float& l_reg, bf16x8& pa0, bf16x8& pa1, bf16x8& pa2, bf16x8& pa3) {
#pragma unroll
    for (int r = 0; r < 16; ++r) p1[r] = __builtin_amdgcn_exp2f(p1[r]);
    float ps = 0;
#pragma unroll
    for (int r = 0; r < 16; ++r) ps += p0[r];
#pragma unroll
    for (int r = 0; r < 16; ++r) ps += p1[r];
    l_reg += ps;
#define PK4(P, BASE, OUT) do { unsigned a0 = cvtpk(P[BASE + 0], P[BASE + 1]), a1 = cvtpk(P[BASE + 2], P[BASE + 3]);   \
    unsigned b0 = cvtpk(P[BASE + 4], P[BASE + 5]), b1 = cvtpk(P[BASE + 6], P[BASE + 7]);                              \
    auto r0 = __builtin_amdgcn_permlane32_swap(a0, b0, false, false); auto r1 = __builtin_amdgcn_permlane32_swap(a1, b1, false, false); \
    u32x4 w = {r0[0], r1[0], r0[1], r1[1]}; OUT = *reinterpret_cast<bf16x8*>(&w); } while (0)
    PK4(p0, 0, pa0); PK4(p0, 8, pa1); PK4(p1, 0, pa2); PK4(p1, 8, pa3);
#undef PK4
}
__device__ __forceinline__ void qkt(f32x16& p0, f32x16& p1, const char* Ks, const bf16x8* qr, const float mrow, int r32, int hi) {
    p0 = f32x16{}; p1 = f32x16{};
#pragma unroll
    for (int d0 = 0; d0 < 6; ++d0) { const int cb = (d0 * 16 + hi * 8) * 2;
        bf16x8 b0 = *reinterpret_cast<const bf16x8*>(Ks + KSWZ(r32, cb));
        bf16x8 b1 = *reinterpret_cast<const bf16x8*>(Ks + KSWZ(32 + r32, cb));
        p0 = __builtin_amdgcn_mfma_f32_32x32x16_bf16(b0, qr[d0], p0, 0, 0, 0);
        p1 = __builtin_amdgcn_mfma_f32_32x32x16_bf16(b1, qr[d0], p1, 0, 0, 0); }
    if (mrow != 0.f) {
#pragma unroll
        for (int r = 0; r < 16; ++r) { p0[r] -= mrow; p1[r] -= mrow; } }
}
__device__ __forceinline__ int v_st(int k, int c) { const int kk = (k & ~0xC) | ((k & 4) << 1) | ((k & 8) >> 1); return ((kk >> 3) * 2 + (c >> 5)) * 512 + ((kk & 7) * 32 + (c & 31)) * 2; }
__device__ __forceinline__ int v_rd_base(int lane) { return ((lane & 3) << 3) | (((lane >> 2) & 3) << 6) | (((lane >> 4) & 1) << 5) | (((lane >> 5) & 1) << 8); }
constexpr int v_rd_off(int d0, int ks, int half) { return d0 * 512 + ks * 2048 + half * 1024; }
template <int OFF> __device__ __forceinline__ s16x4 tr_read(int vb) { s16x4 r; asm volatile("ds_read_b64_tr_b16 %0, %1 offset:%2" : "=&v"(r) : "v"(vb), "i"(OFF) : "memory"); return r; }
template <int D0> __device__ __forceinline__ void pv_one(f32x16& od, int vb, bf16x8 pa0, bf16x8 pa1, bf16x8 pa2, bf16x8 pa3) {
    const s16x4 l0 = tr_read<v_rd_off(D0, 0, 0)>(vb), h0 = tr_read<v_rd_off(D0, 0, 1)>(vb), l1 = tr_read<v_rd_off(D0, 1, 0)>(vb), h1 = tr_read<v_rd_off(D0, 1, 1)>(vb);
    const s16x4 l2 = tr_read<v_rd_off(D0, 2, 0)>(vb), h2 = tr_read<v_rd_off(D0, 2, 1)>(vb), l3 = tr_read<v_rd_off(D0, 3, 0)>(vb), h3 = tr_read<v_rd_off(D0, 3, 1)>(vb);
    asm volatile("s_waitcnt lgkmcnt(0)" ::: "memory"); SBAR();
#define PK(L, H) (bf16x8){L[0], L[1], L[2], L[3], H[0], H[1], H[2], H[3]}
    od = __builtin_amdgcn_mfma_f32_32x32x16_bf16(pa0, PK(l0, h0), od, 0, 0, 0);
    od = __builtin_amdgcn_mfma_f32_32x32x16_bf16(pa1, PK(l1, h1), od, 0, 0, 0);
    od = __builtin_amdgcn_mfma_f32_32x32x16_bf16(pa2, PK(l2, h2), od, 0, 0, 0);
    od = __builtin_amdgcn_mfma_f32_32x32x16_bf16(pa3, PK(l3, h3), od, 0, 0, 0);
#undef PK
}
__device__ __forceinline__ void pv_d0(f32x16* o, int vb, bf16x8 pa0, bf16x8 pa1, bf16x8 pa2, bf16x8 pa3) { pv_one<0>(o[0], vb, pa0, pa1, pa2, pa3); pv_one<1>(o[1], vb, pa0, pa1, pa2, pa3); }

__device__ __forceinline__ void attn_unit(const bf16_t* __restrict__ Qb, const bf16_t* __restrict__ Kh, const bf16_t* __restrict__ Vh, bf16_t* __restrict__ Ob, int seq, float kmax, char* lds, const int wv) {
    const int lane = lane_id(), wid = wv, tid = wv * 64 + lane, r32 = lane & 31, hi = lane >> 5;
    char* V_lds = lds; char* K_lds = lds + 2 * SHM_V;
    float* li_l = (float*)(lds + 2 * SHM_V + 2 * SHM_K) + wid * 64;
    float l_reg = 0; f32x16 o[2] = {}; bf16x8 qr[6];
    const bf16_t* Qw = Qb + (long)(wid * QBLK + r32) * LDQ + hi * 8;
    float qss = 0.f;
#pragma unroll
    for (int d0 = 0; d0 < 6; ++d0) { qr[d0] = *reinterpret_cast<const bf16x8*>(Qw + d0 * 16);
#pragma unroll
        for (int i = 0; i < 8; ++i) { const float f = bf2f((unsigned short)qr[d0][i]); qss += f * f; } }
    { auto rr = __builtin_amdgcn_permlane32_swap(__float_as_uint(qss), __float_as_uint(qss), false, false); qss = __uint_as_float(rr[0]) + __uint_as_float(rr[1]); }
    float mrow = sqrtf(qss) * kmax;
    if (__all(mrow < 64.f)) mrow = 0.f;
    const int kc1 = tid, kc2 = 512 + (tid & 255); const int kr1 = kc1 / 12, kp1 = kc1 % 12, kr2 = kc2 / 12, kp2 = kc2 % 12; const int vr = tid >> 3, vp = tid & 7;
    const int kst1 = KSWZ(kr1, kp1 * 16), kst2 = KSWZ(kr2, kp2 * 16), vst = v_st(vr, vp * 8);
    const int vb0 = (int)(uintptr_t)V_lds + v_rd_base(lane);
    struct { bf16x8 k1, k2, v; } sr_[2];
#define SLOAD(i, k0) do { sr_[i].k1 = *reinterpret_cast<const bf16x8*>(&Kh[(long)((k0) + kr1) * LDK + kp1 * 8]); if (wv < 4) sr_[i].k2 = *reinterpret_cast<const bf16x8*>(&Kh[(long)((k0) + kr2) * LDK + kp2 * 8]); \
    sr_[i].v = *reinterpret_cast<const bf16x8*>(&Vh[(long)((k0) + vr) * LDV + vp * 8]); } while (0)
#define SWRITE(b, i) do { *(bf16x8*)(K_lds + (b) * SHM_K + kst1) = sr_[i].k1; if (wv < 4) *(bf16x8*)(K_lds + (b) * SHM_K + kst2) = sr_[i].k2; *(bf16x8*)(V_lds + (b) * SHM_V + vst) = sr_[i].v; } while (0)
#define SWAIT() do { if (wv < 4) asm volatile("s_waitcnt vmcnt(3)" ::: "memory"); else asm volatile("s_waitcnt vmcnt(2)" ::: "memory"); } while (0)
    f32x16 pA0, pA1, pB0, pB1; bf16x8 pa0, pa1, pa2, pa3; const int NT = seq / KVBLK;
    constexpr int SE = 0, SO = 1;
    SLOAD(SE, 0); asm volatile("s_waitcnt vmcnt(0)" ::: "memory"); SWRITE(0, SE); __syncthreads();
    qkt(pA0, pA1, K_lds, qr, mrow, r32, hi); expA(pA0);
    SLOAD(SO, KVBLK); if (2 < NT) SLOAD(SE, 2 * KVBLK);
    SWAIT(); SWRITE(1, SO); __syncthreads();
    for (int j = 1; j + 1 < NT; j += 2) {
        __builtin_amdgcn_iglp_opt(0); qkt(pB0, pB1, K_lds + SHM_K, qr, mrow, r32, hi);
        finishSM(pA0, pA1, l_reg, pa0, pa1, pa2, pa3); SBAR();
        SLOAD(SO, (j + 2) * KVBLK); SBAR();
        pv_d0(o, vb0, pa0, pa1, pa2, pa3); expA(pB0);
        __syncthreads(); SWAIT(); SWRITE(0, SE);
        __syncthreads();
        __builtin_amdgcn_iglp_opt(0); qkt(pA0, pA1, K_lds, qr, mrow, r32, hi);
        finishSM(pB0, pB1, l_reg, pa0, pa1, pa2, pa3); SBAR();
        if (j + 3 < NT) SLOAD(SE, (j + 3) * KVBLK); SBAR();
        pv_d0(o, vb0 + SHM_V, pa0, pa1, pa2, pa3); expA(pA0);
        __syncthreads(); if (j + 3 < NT) SWAIT(); else asm volatile("s_waitcnt vmcnt(0)" ::: "memory"); SWRITE(1, SO);
        __syncthreads();
    }
    SBAR(); qkt(pB0, pB1, K_lds + SHM_K, qr, mrow, r32, hi);
    finishSM(pA0, pA1, l_reg, pa0, pa1, pa2, pa3); SBAR();
    pv_d0(o, vb0, pa0, pa1, pa2, pa3); expA(pB0);
    __syncthreads();
    finishSM(pB0, pB1, l_reg, pa0, pa1, pa2, pa3); SBAR();
    pv_d0(o, vb0 + SHM_V, pa0, pa1, pa2, pa3);
    { auto rr = __builtin_amdgcn_permlane32_swap(__float_as_uint(l_reg), __float_as_uint(l_reg), false, false); l_reg = __uint_as_float(rr[0]) + __uint_as_float(rr[1]); }
    if (hi == 0) li_l[r32] = l_reg; asm volatile("s_waitcnt lgkmcnt(0)" ::: "memory");
    float rli[16];
#pragma unroll
    for (int r = 0; r < 16; ++r) rli[r] = __builtin_amdgcn_rcpf(li_l[crow(r, hi)]);
    bf16_t* Ow = Ob + (long)(wid * QBLK) * LDO;
#pragma unroll
    for (int r = 0; r < 16; ++r) { const int orow = crow(r, hi);
#pragma unroll
        for (int d0 = 0; d0 < 2; ++d0) Ow[(long)orow * LDO + d0 * 32 + r32] = (bf16_t)(cvtpk(o[d0][r] * rli[r], 0.f) & 0xffffu); }
    __syncthreads();
#undef SLOAD
#undef SWRITE
#undef SWAIT
}
}

namespace hg {
constexpr int QP = 136, TP = 68;
constexpr int OFF_QIN = 0, OFF_KIN = 64 * QP * 2, OFF_KINT = 2 * 64 * QP * 2, OFF_VT = OFF_KINT + 128 * TP * 2, OFF_TOT1 = OFF_VT + 128 * TP * 2, OFF_FAC = OFF_TOT1 + 1024, HALF_BYTES = OFF_FAC + 512;
static_assert(2 * HALF_BYTES <= LDS_CTL, "HGRN LDS");
__device__ __forceinline__ bf16x8 ld2x4(const LAS char* p0, const LAS char* p1) { const s16x4 a = *(const LAS s16x4*)p0, b = *(const LAS s16x4*)p1; return (bf16x8){a[0], a[1], a[2], a[3], b[0], b[1], b[2], b[3]}; }
__device__ __forceinline__ bf16x8 packf8(const f32x16& a, int base) { u32x4 w; w.x = cvtpk(a[base], a[base + 1]); w.y = cvtpk(a[base + 2], a[base + 3]); w.z = cvtpk(a[base + 4], a[base + 5]); w.w = cvtpk(a[base + 6], a[base + 7]); return __builtin_bit_cast(bf16x8, w); }
__device__ __forceinline__ void unit(LAS char* lds, int seqbase, int S, int h, const bf16_t* __restrict__ HQp, const bf16_t* __restrict__ HIp, const _Float16* __restrict__ GFp, const _Float16* __restrict__ GBp, bf16_t* OFWp, bf16_t* OBWp, const int wv) {
    const int lane = lane_id(), tid = wv * 64 + lane, bwd = wv >> 2, ht = tid & 255, w = wv & 3, r32 = lane & 31, hi = lane >> 5;
    LAS char* base = lds + bwd * HALF_BYTES;
    LAS char* QIN = base + OFF_QIN; LAS char* KINT = base + OFF_KINT; LAS char* VT = base + OFF_VT; LAS float* TOT1 = (LAS float*)(base + OFF_TOT1); LAS float* FAC = (LAS float*)(base + OFF_FAC);
    const _Float16* G = bwd ? GBp : GFp; bf16_t* O = bwd ? OBWp : OFWp;
    const int nc = S / 64, part = ht >> 7, d = ht & 127, e0 = 32 * w;
    f32x16 Sacc[4] = {};
    if (part == 1) { TOT1[d] = 0.f; TOT1[128 + d] = 0.f; }
    u32x4 rg[4], rq[4], rv[4];
    const int trb = ht >> 4, c8 = (ht & 15) * 8, tv = (ht >> 2) & 63, ev = (ht & 3) * 8;
    const long jstep = bwd ? -16 * 512 : 16 * 512;
    const size_t gq_off = (size_t)(bwd ? 63 - trb : trb) * 512 + h * 128 + c8, v_off = (size_t)(bwd ? 63 - tv : tv) * 512 + h * 128 + ev;
#define HG_LOADRAW(c) do { const size_t cb_ = (size_t)(seqbase + (bwd ? (nc - 1 - (c)) * 64 : (c) * 64)) * 512 + gq_off; \
    _Pragma("unroll") for (int j = 0; j < 4; ++j) { rg[j] = *(const u32x4*)(G + cb_ + j * jstep); rq[j] = *(const u32x4*)(HQp + cb_ + j * jstep); } } while (0)
#define HG_LOADV(c) do { const size_t cb_ = (size_t)(seqbase + (bwd ? (nc - 1 - (c)) * 64 : (c) * 64)) * 512 + v_off; \
    _Pragma("unroll") for (int j = 0; j < 4; ++j) rv[j] = *(const u32x4*)(HIp + cb_ + 32 * j); } while (0)
    HG_LOADRAW(0); HG_LOADV(0);
    for (int c = 0; c < nc; ++c) {
        const int c0 = seqbase + (bwd ? (nc - 1 - c) * 64 : c * 64);
        LAS char* wq = QIN + (trb * QP + c8) * 2; LAS char* wvt = VT + (ev * TP + tv) * 2; LAS char* colb = QIN + d * 2; LAS char* ktb = KINT + d * TP * 2;
        asm volatile("" : "+v"(wq), "+v"(wvt), "+v"(colb), "+v"(ktb));
#pragma unroll
        for (int j = 0; j < 4; ++j) { *(LAS u32x4*)(wq + j * 16 * QP * 2) = rq[j]; *(LAS u32x4*)(wq + (OFF_KIN - OFF_QIN) + j * 16 * QP * 2) = rg[j]; }
#pragma unroll
        for (int j = 0; j < 4; ++j) { const unsigned vv[4] = {rv[j].x, rv[j].y, rv[j].z, rv[j].w};
#pragma unroll
            for (int i = 0; i < 4; ++i) { *(LAS bf16_t*)(wvt + (32 * j + 2 * i) * TP * 2) = (bf16_t)(vv[i] & 0xffffu); *(LAS bf16_t*)(wvt + (32 * j + 2 * i + 1) * TP * 2) = (bf16_t)(vv[i] >> 16); } }
        __syncthreads();
        if (c + 1 < nc) { HG_LOADRAW(c + 1); HG_LOADV(c + 1); }
        constexpr int KO = OFF_KIN - OFF_QIN;
        if (part == 0) {
            float E1 = 1.f, E2 = 1.f, tot = 0.f;
#pragma unroll 4
            for (int tp = 15; tp >= 0; --tp) { unsigned kpk[2];
#pragma unroll
                for (int s2 = 1; s2 >= 0; --s2) { const int tt = 2 * tp + s2;
                    const float g = (float)*(const LAS _Float16*)(colb + KO + tt * QP * 2), q = bf2f(*(const LAS bf16_t*)(colb + tt * QP * 2));
                    const float f = __expf(g), rf = __expf(-g);
                    const unsigned pq = cvtpk(q * E1, (1.f - f) * E2);
                    *(LAS bf16_t*)(colb + tt * QP * 2) = (bf16_t)(pq & 0xffffu); *(LAS bf16_t*)(colb + KO + tt * QP * 2) = (bf16_t)(pq >> 16); kpk[s2] = pq >> 16;
                    E1 *= rf; E2 *= f; tot += g; }
                *(LAS unsigned*)(ktb + 4 * tp) = kpk[0] | (kpk[1] << 16); }
            FAC[d] = __expf(tot + TOT1[((c + 1) & 1) * 128 + d]);
        } else {
            float E1 = 1.f, E2 = 1.f, tot = 0.f;
#pragma unroll 4
            for (int tp = 16; tp < 32; ++tp) { unsigned kpk[2];
#pragma unroll
                for (int s2 = 0; s2 < 2; ++s2) { const int tt = 2 * tp + s2;
                    const float g = (float)*(const LAS _Float16*)(colb + KO + tt * QP * 2), q = bf2f(*(const LAS bf16_t*)(colb + tt * QP * 2));
                    const float f = __expf(g), rf = __expf(-g);
                    E1 *= f; E2 *= rf; tot += g;
                    const unsigned pq = cvtpk(q * E1, (1.f - f) * E2);
                    *(LAS bf16_t*)(colb + tt * QP * 2) = (bf16_t)(pq & 0xffffu); *(LAS bf16_t*)(colb + KO + tt * QP * 2) = (bf16_t)(pq >> 16); kpk[s2] = pq >> 16; }
                *(LAS unsigned*)(ktb + 4 * tp) = kpk[0] | (kpk[1] << 16); }
            TOT1[(c & 1) * 128 + d] = tot;
        }
        __syncthreads();
        {
            const LAS char* bq16 = QIN + r32 * QP * 2 + 16 * hi; const LAS char* bq8 = QIN + r32 * QP * 2 + 8 * hi;
            const LAS char* bv16 = VT + (e0 + r32) * TP * 2 + 16 * hi; const LAS char* bv8 = VT + (e0 + r32) * TP * 2 + 8 * hi;
            const LAS char* bk16 = KINT + r32 * TP * 2 + 16 * hi; const LAS float* bfac = FAC + 4 * hi; int thr = r32 - 4 * hi;
            asm volatile("" : "+v"(bq16), "+v"(bq8), "+v"(bv16), "+v"(bv8), "+v"(bk16), "+v"(bfac), "+v"(thr));
            constexpr int KOFF = OFF_KIN - OFF_QIN, R32 = 32 * QP * 2;
#pragma unroll
            for (int db = 0; db < 4; ++db)
#pragma unroll
                for (int r4 = 0; r4 < 4; ++r4) { const f32x4 fc = *(const LAS f32x4*)(bfac + 32 * db + 8 * r4); Sacc[db][4 * r4] *= fc.x; Sacc[db][4 * r4 + 1] *= fc.y; Sacc[db][4 * r4 + 2] *= fc.z; Sacc[db][4 * r4 + 3] *= fc.w; }
            f32x16 o0 = {}, o1 = {};
#pragma unroll
            for (int kk = 0; kk < 8; ++kk) { const bf16x8 sf = packf8(Sacc[kk >> 1], 8 * (kk & 1));
                const bf16x8 b0 = ld2x4(bq8 + 32 * kk, bq8 + 32 * kk + 16), b1 = ld2x4(bq8 + R32 + 32 * kk, bq8 + R32 + 32 * kk + 16);
                o0 = __builtin_amdgcn_mfma_f32_32x32x16_bf16(sf, b0, o0, 0, 0, 0);
                o1 = __builtin_amdgcn_mfma_f32_32x32x16_bf16(sf, b1, o1, 0, 0, 0); if (kk & 1) SBAR(); }
            SBAR();
            {
                f32x16 p = {}; __builtin_amdgcn_iglp_opt(1);
#pragma unroll
                for (int kk = 0; kk < 8; ++kk)
                    { p = __builtin_amdgcn_mfma_f32_32x32x16_bf16(*(const LAS bf16x8*)(bq16 + KOFF + 32 * kk), *(const LAS bf16x8*)(bq16 + 32 * kk), p, 0, 0, 0); }
#pragma unroll
                for (int r = 0; r < 16; ++r) { if ((r & 3) + 8 * (r >> 2) > thr) p[r] = 0.f; }
#pragma unroll
                for (int k2 = 0; k2 < 2; ++k2) o0 = __builtin_amdgcn_mfma_f32_32x32x16_bf16(ld2x4(bv8 + 32 * k2, bv8 + 32 * k2 + 16), packf8(p, 8 * k2), o0, 0, 0, 0);
            }
            SBAR();
            {
                f32x16 p = {}; __builtin_amdgcn_iglp_opt(1);
#pragma unroll
                for (int kk = 0; kk < 8; ++kk)
                    { p = __builtin_amdgcn_mfma_f32_32x32x16_bf16(*(const LAS bf16x8*)(bq16 + KOFF + 32 * kk), *(const LAS bf16x8*)(bq16 + R32 + 32 * kk), p, 0, 0, 0); }
#pragma unroll
                for (int k2 = 0; k2 < 2; ++k2) o1 = __builtin_amdgcn_mfma_f32_32x32x16_bf16(ld2x4(bv8 + 32 * k2, bv8 + 32 * k2 + 16), packf8(p, 8 * k2), o1, 0, 0, 0);
            }
            SBAR();
            {
                f32x16 p = {}; __builtin_amdgcn_iglp_opt(1);
#pragma unroll
                for (int kk = 0; kk < 8; ++kk)
                    { p = __builtin_amdgcn_mfma_f32_32x32x16_bf16(*(const LAS bf16x8*)(bq16 + KOFF + R32 + 32 * kk), *(const LAS bf16x8*)(bq16 + R32 + 32 * kk), p, 0, 0, 0); }
#pragma unroll
                for (int r = 0; r < 16; ++r) { if ((r & 3) + 8 * (r >> 2) > thr) p[r] = 0.f; }
#pragma unroll
                for (int k2 = 0; k2 < 2; ++k2) o1 = __builtin_amdgcn_mfma_f32_32x32x16_bf16(ld2x4(bv8 + 64 + 32 * k2, bv8 + 64 + 32 * k2 + 16), packf8(p, 8 * k2), o1, 0, 0, 0);
            }
            SBAR();
#pragma unroll
            for (int kk = 0; kk < 4; ++kk) { const bf16x8 vfr = ld2x4(bv16 + 32 * kk, bv16 + 32 * kk + 8);
#pragma unroll
                for (int db = 0; db < 4; ++db) { const LAS char* kp = bk16 + 32 * db * TP * 2 + 32 * kk; Sacc[db] = __builtin_amdgcn_mfma_f32_32x32x16_bf16(ld2x4(kp, kp + 8), vfr, Sacc[db], 0, 0, 0); } SBAR(); }
            SBAR();
#pragma unroll
            for (int tb = 0; tb < 2; ++tb) { const int tt = 32 * tb + r32, row = c0 + (bwd ? 63 - tt : tt); bf16_t* op = O + (size_t)row * 512 + h * 128 + e0 + 16 * hi;
                const f32x16& oo = tb ? o1 : o0; unsigned dq[4][2];
#pragma unroll
                for (int r4 = 0; r4 < 4; ++r4) { dq[r4][0] = cvtpk(oo[4 * r4], oo[4 * r4 + 1]); dq[r4][1] = cvtpk(oo[4 * r4 + 2], oo[4 * r4 + 3]); }
                const auto s00 = __builtin_amdgcn_permlane32_swap(dq[0][0], dq[2][0], false, false), s01 = __builtin_amdgcn_permlane32_swap(dq[0][1], dq[2][1], false, false);
                const auto s10 = __builtin_amdgcn_permlane32_swap(dq[1][0], dq[3][0], false, false), s11 = __builtin_amdgcn_permlane32_swap(dq[1][1], dq[3][1], false, false);
                *(u32x4*)(op) = (u32x4){s00[0], s01[0], s00[1], s01[1]}; *(u32x4*)(op + 8) = (u32x4){s10[0], s11[0], s10[1], s11[1]}; }
        }
        __syncthreads();
    }
#undef HG_LOADRAW
#undef HG_LOADV
}
}

__device__ __forceinline__ float wave_sum(float v) {
#pragma unroll
    for (int o = 1; o < 64; o <<= 1) v += __shfl_xor(v, o);
    return v;
}
__device__ __forceinline__ void transpose_item(const float* W, int K, int N, int k0, int n0, bf16_t* WT, int dst0, const float* kscale, LAS float* scr, int lane) {
#pragma unroll 8
    for (int i = 0; i < 32; ++i) { const int kk = 2 * i + (lane >> 5); float v = W[(size_t)(k0 + kk) * N + n0 + (lane & 31)]; if (kscale) v *= kscale[k0 + kk]; scr[kk * 33 + (lane & 31)] = v; }
    asm volatile("s_waitcnt lgkmcnt(0)" ::: "memory");
    const int c = lane & 7;
#pragma unroll
    for (int j = 0; j < 4; ++j) { const int n = (lane >> 3) + 8 * j; const LAS float* s = scr + (8 * c) * 33 + n;
        u32x4 o; o.x = cvtpk(s[0 * 33], s[1 * 33]); o.y = cvtpk(s[2 * 33], s[3 * 33]); o.z = cvtpk(s[4 * 33], s[5 * 33]); o.w = cvtpk(s[6 * 33], s[7 * 33]);
        *(u32x4*)(WT + (size_t)(dst0 + n) * K + k0 + 8 * c) = o; }
    asm volatile("s_waitcnt lgkmcnt(0)" ::: "memory");
}

#define XB_TMO      128
#define XB_XCNT(j)  (256  + 64 * (j))
#define XB_XSUB(j)  (1280 + 64 * (j))
#define XB_XGEN(j)  (2304 + 64 * (j))
#define XB_TOP      3328
#define XB_TOPGEN   3392
#define XB_SPIN_CAP (1u << 22)
__device__ __forceinline__ unsigned xb_ld(unsigned* p)              { return __hip_atomic_load(p, __ATOMIC_RELAXED, __HIP_MEMORY_SCOPE_AGENT); }
__device__ __forceinline__ unsigned xb_add(unsigned* p, unsigned v) { return __hip_atomic_fetch_add(p, v, __ATOMIC_RELAXED, __HIP_MEMORY_SCOPE_AGENT); }
__device__ __forceinline__ unsigned xb_xcc_id() { return (unsigned)__builtin_amdgcn_s_getreg((3 << 11) | 20) & 0xFu; }
#define XB_SPIN(cond, bar) do { unsigned _sp = 0; while (cond) { __builtin_amdgcn_s_sleep(1); \
    if ((++_sp & 255u) == 0u) { if (xb_ld(&(bar)[XB_TMO])) break; if (_sp > XB_SPIN_CAP) { atomicAdd(&(bar)[XB_TMO], 1u); break; } } } } while (0)
__device__ __forceinline__ void xcd_barrier_complete(unsigned* bar, unsigned x, unsigned& nloc, unsigned& nx) {
    const unsigned G = gridDim.x;
    unsigned sum, cnt, mine, sp = 0u;
    for (;;) {
        sum = 0u; cnt = 0u; mine = 0u;
#pragma unroll
        for (unsigned j = 0; j < 16; ++j) { const unsigned c = xb_ld(&bar[XB_XCNT(j)]); sum += c; cnt += (c > 0u) ? 1u : 0u; mine = (j == x) ? c : mine; }
        if (sum == G) break;
        __builtin_amdgcn_s_sleep(1);
        if ((++sp & 255u) == 0u) { if (xb_ld(&bar[XB_TMO])) break; if (sp > XB_SPIN_CAP) { atomicAdd(&bar[XB_TMO], 1u); break; } }
    }
    nloc = mine > 0u ? mine : 1u; nx = cnt > 0u ? cnt : 1u;
}
__device__ __forceinline__ void grid_barrier(unsigned* bar, const int wv, volatile LAS unsigned* st) {
    asm volatile("s_waitcnt vmcnt(0)" ::: "memory");
    __syncthreads();
    if (wv == 0 && lane_id() == 0) {
        const unsigned x = xb_xcc_id();
        __builtin_amdgcn_s_waitcnt(0);
        unsigned nloc = st[0], nx = st[1];
        if (nloc == 0u) { xcd_barrier_complete(bar, x, nloc, nx); st[0] = nloc; st[1] = nx; }
        const unsigned old = xb_add(&bar[XB_XSUB(x)], 1u);
        const unsigned gen = old / nloc;
        if (old + 1u == (gen + 1u) * nloc) {
            __builtin_amdgcn_fence(__ATOMIC_RELEASE, "agent");
            asm volatile("s_waitcnt vmcnt(0)" ::: "memory");
            const unsigned og = xb_add(&bar[XB_TOP], 1u);
            const unsigned tg = og / nx;
            if (og + 1u == (tg + 1u) * nx) xb_add(&bar[XB_TOPGEN], 1u);
            else XB_SPIN(xb_ld(&bar[XB_TOPGEN]) == tg, bar);
            __builtin_amdgcn_fence(__ATOMIC_ACQUIRE, "agent");
            xb_add(&bar[XB_XGEN(x)], 1u);
            asm volatile("s_waitcnt vmcnt(0)" ::: "memory");
        } else {
            XB_SPIN(xb_ld(&bar[XB_XGEN(x)]) == gen, bar);
            __builtin_amdgcn_fence(__ATOMIC_ACQUIRE, "agent");
            asm volatile("s_waitcnt vmcnt(0)" ::: "memory");
        }
    }
    __syncthreads();
}
#define WinT ((bf16_t*)(ws + WS_WIN))
#define WuqT ((bf16_t*)(ws + WS_WUQ))
#define WukvT ((bf16_t*)(ws + WS_WUKV))
#define Wb0T ((bf16_t*)(ws + WS_WB0))
#define Wb1T ((bf16_t*)(ws + WS_WB1))
#define WoT ((bf16_t*)(ws + WS_WO))
#define WguT ((bf16_t*)(ws + WS_WGU))
#define WdT ((bf16_t*)(ws + WS_WD))
#define XN ((bf16_t*)(ws + WS_XN))
#define HQ ((bf16_t*)(ws + WS_HQ))
#define HI ((bf16_t*)(ws + WS_HI))
#define GF ((_Float16*)(ws + WS_GF))
#define GB ((_Float16*)(ws + WS_GB))
#define SG ((bf16_t*)(ws + WS_SG))
#define LAT ((bf16_t*)(ws + WS_LAT))
#define Qm ((bf16_t*)(ws + WS_Q))
#define Km ((bf16_t*)(ws + WS_K))
#define Vm ((bf16_t*)(ws + WS_V))
#define OM ((bf16_t*)(ws + WS_OM))
#define OFW ((bf16_t*)(ws + WS_OFW))
#define OBW ((bf16_t*)(ws + WS_OBW))
#define OH ((bf16_t*)(ws + WS_OH))
#define MERGED ((bf16_t*)(ws + WS_MERGED))
#define X1 ((float*)(ws + WS_X1))
#define X1B ((bf16_t*)(ws + WS_X1B))
#define ACT ((bf16_t*)(ws + WS_ACT))
#define GATES ((bf16_t*)a.out)
#define RSQ ((float*)(ws + WS_RSQ))
#define RSKV ((float*)(ws + WS_RSKV))
#define RSX1 ((float*)(ws + WS_RSX1))
#define RSX2 ((float*)(ws + WS_RSX2))
#define ROPE ((f32x2*)(ws + WS_ROPE))
#define QUEUE ((unsigned*)(ws + WS_QUEUE))
__global__ void __launch_bounds__(512, 2) fwd_megakernel(Args a) {
    extern __shared__ __attribute__((aligned(16))) unsigned char lds[];
    const int G = gridDim.x, bx = blockIdx.x;
    const int wv = __builtin_amdgcn_readfirstlane((int)threadIdx.x >> 6);
#define TIDS const int lane = lane_id(), wave = wv, tid = wv * 64 + lane; (void)tid;
    unsigned char* ws = a.ws;
    LAS unsigned char* ldsl = (LAS unsigned char*)lds;
    const int lo = a.ph_lo, hi_ = a.ph_hi;
#ifndef PHMASK
#define PHMASK 0x3ff
#endif
#define IN(k) (((PHMASK >> (k)) & 1) && lo <= (k) && (k) < hi_)
#define STAMP(k) do { if (PROBE_SEL && bx == 0 && wv == 0 && lane_id() == 0) ((unsigned long long*)(ws + WS_TS))[k] = __builtin_amdgcn_s_memrealtime(); } while (0)
#define SEAM(k) do { if (IN(k) && IN((k) + 1)) { if ((k) == 0) cg::this_grid().sync(); else grid_barrier((unsigned*)(ws + WS_XBAR), wv, (volatile LAS unsigned*)(ldsl + LDS_CTL + 32)); } } while (0)

    if (PROBE_SEL && bx == 0 && wv == 0 && lane_id() == 0) { for (int i = 1; i < 32; ++i) ((unsigned long long*)(ws + WS_TS))[i] = 0ull; }
    STAMP(0);
    if (IN(0)) { TIDS
        LAS float* scr = (LAS float*)(ldsl + wave * 16384);
        const int gw = bx * 8 + wave, NGW = G * 8;
        constexpr int I_IN = 16 * 161, I_UQ = 4 * 24, I_UKV = 4 * 32, I_B = 8 * 32, I_O = 16 * 32, I_GU = 16 * 176, I_D = 44 * 32;
        constexpr int NITEMS = I_IN + I_UQ + I_UKV + 2 * I_B + I_O + I_GU + I_D;
        for (int it = gw; it < NITEMS; it += NGW) {
            int r = it;
            if (r < I_IN) { const int kb = r / 161, nb = r % 161; const int dst = nb < 96 ? 32 * nb : (nb == 96 ? 5120 : 3072 + 32 * (nb - 97)); transpose_item(a.w_in, 1024, 5152, 64 * kb, 32 * nb, WinT, dst, nullptr, scr, lane); continue; } r -= I_IN;
            if (r < I_UQ) { const int kb = r / 24, nb = r % 24, h = nb / 3, p = nb % 3; const int dst = p < 2 ? h * 64 + 32 * p : 512 + 32 * h; transpose_item(a.w_uq, 256, 768, 64 * kb, 32 * nb, WuqT, dst, a.g_qa, scr, lane); continue; } r -= I_UQ;
            if (r < I_UKV) { const int kb = r / 32, nb = r % 32; transpose_item(a.w_ukv, 256, 1024, 64 * kb, 32 * nb, WukvT, 32 * nb, a.g_kva, scr, lane); continue; } r -= I_UKV;
            if (r < I_B) { const int kb = r / 32, nb = r % 32; transpose_item(a.w_branch, 512, 1024, 64 * kb, 32 * nb, Wb0T, 32 * nb, nullptr, scr, lane); continue; } r -= I_B;
            if (r < I_B) { const int kb = r / 32, nb = r % 32; transpose_item(a.w_branch + 512 * 1024, 512, 1024, 64 * kb, 32 * nb, Wb1T, 32 * nb, nullptr, scr, lane); continue; } r -= I_B;
            if (r < I_O) { const int kb = r / 32, nb = r % 32; transpose_item(a.w_out, 1024, 1024, 64 * kb, 32 * nb, WoT, 32 * nb, nullptr, scr, lane); continue; } r -= I_O;
            if (r < I_GU) { const int kb = r / 176, nb = r % 176; const int col = 32 * nb; const int j = col < DFF ? col : col - DFF; const int dst = 256 * (j / 128) + (col < DFF ? 0 : 128) + (j % 128);
                transpose_item(a.w_gate_up, 1024, 5632, 64 * kb, col, WguT, dst, a.g_ffn, scr, lane); continue; } r -= I_GU;
            { const int kb = r / 32, nb = r % 32; transpose_item(a.w_down, DFF, 1024, 64 * kb, 32 * nb, WdT, 32 * nb, nullptr, scr, lane); }
        }
        for (int m = gw; m < M; m += NGW) {
            const f32x4* xr = (const f32x4*)xrow_ptr(a.x_prompt, a.x_sample, m) + lane; f32x4 v[4]; float s = 0.f;
#pragma unroll
            for (int j = 0; j < 4; ++j) { v[j] = xr[64 * j]; s += (v[j].x * v[j].x + v[j].y * v[j].y) + (v[j].z * v[j].z + v[j].w * v[j].w); }
            const float rstd = __builtin_amdgcn_rsqf(wave_sum(s) * (1.f / 1024.f) + EPS);
            u32x2* o8 = (u32x2*)(XN + (size_t)m * 1024) + lane;
#pragma unroll
            for (int j = 0; j < 4; ++j) { const f32x4 g = ((const f32x4*)a.g_mix)[64 * j + lane]; u32x2 w; w.x = cvtpk(v[j].x * rstd * g.x, v[j].y * rstd * g.y); w.y = cvtpk(v[j].z * rstd * g.z, v[j].w * rstd * g.w); o8[64 * j] = w; }
        }
        for (int i = bx * 512 + tid; i < (int)(CTL_ZERO / 16); i += G * 512) { if (PROBE_SEL && i >= (int)(WS_TS / 16) && i < (int)(WS_TS / 16) + 16) continue; ((u32x4*)ws)[i] = (u32x4){0u, 0u, 0u, 0u}; }
        for (int i = bx * 512 + tid; i < 16384 * 16; i += G * 512) { const int pos = i >> 4, j = i & 15; const double rev = (double)pos * a.inv_rev[j]; const float fr_ = (float)(rev - floor(rev));
            ROPE[i] = (f32x2){__builtin_amdgcn_cosf(fr_), __builtin_amdgcn_sinf(fr_)}; }
    }
    SEAM(0); STAMP(1);
    {
        volatile LAS unsigned* st = (volatile LAS unsigned*)(ldsl + LDS_CTL + 32);
        if (wv == 0 && lane_id() == 0) { st[0] = 0u; st[1] = 0u; (void)xb_add((unsigned*)(ws + WS_XBAR) + XB_XCNT(xb_xcc_id()), 1u); }
        __syncthreads();
    }
    if (IN(1)) {
        SchedSimple S{(const char*)XN, (const char*)WinT, 256, 21, G, bx, (size_t)256 * 1024 * 2, (size_t)256 * 1024 * 2};
        EpiIn E{ws, GATES, a.lb_param};
        pg8::gemm_phase(wv, ldsl, 1024, 1024, S, E);
    }
    SEAM(1); STAMP(2);
    if (IN(2)) {
        SchedUp S{(const char*)LAT, (const char*)WuqT, (const char*)WukvT, G, bx};
        EpiUp E{Qm, Km, Vm, RSQ, RSKV, ROPE, (unsigned*)(ws + WS_KMAX)};
        pg8::gemm_phase(wv, ldsl, 256, 512, S, E);
    }
    SEAM(2); STAMP(3);
    if (IN(3)) { TIDS
        volatile LAS unsigned* ctl = (volatile LAS unsigned*)(ldsl + LDS_CTL);
        int did_hg = 0;
        for (int qk = 0; qk < 8; ++qk) {
            const int xq = (bx + qk) & 7;
            for (;;) {
                __syncthreads();
                if (tid == 0) ctl[0] = atomicAdd(QUEUE + xq * 64 + 32, 1u);
                __syncthreads();
                const int un = (int)ctl[0];
                if (un >= 3) break;
                int seqbase, S, h;
                if (un == 0) { seqbase = T0 + (xq >> 2) * 16384; S = 16384; h = xq & 3; }
                else { const int idx = 2 * xq + (un - 1); seqbase = (idx >> 2) * 8192; S = 8192; h = idx & 3; }
                hg::unit((LAS char*)ldsl, seqbase, S, h, HQ, HI, GF, GB, OFW, OBW, wv); did_hg = 1;
            }
        }
        if (PROBE_SEL && wv == 0 && lane_id() == 0) atomicMax((unsigned long long*)(ws + WS_TS) + 16, (unsigned long long)__builtin_amdgcn_s_memrealtime());
        for (int qk = 0; qk < 8; ++qk) {
            const int xq = (bx + qk) & 7;
            for (;;) {
                __syncthreads();
                if (tid == 0) ctl[0] = atomicAdd(QUEUE + xq * 64, 1u);
                __syncthreads();
                const int un = (int)ctl[0];
                if (un >= 256) break;
                int seqbase, S, h, qb;
                if (un < 128) { const int j = un, pair = 2 * xq + (j >> 6); seqbase = T0 + (pair >> 3) * 16384; S = 16384; h = pair & 7; qb = j & 63; }
                else { const int j = un - 128, pair = 4 * xq + (j >> 5); seqbase = (pair >> 3) * 8192; S = 8192; h = pair & 7; qb = j & 31; }
                const unsigned* km = (const unsigned*)(ws + WS_KMAX) + row_seq(seqbase) * 32 + h * 4;
                const float kmax = sqrtf(__uint_as_float(km[0]) + __uint_as_float(km[1]) + __uint_as_float(km[2])) * 1.01f;
                att::attn_unit(Qm + ((size_t)(seqbase + qb * 256) * 8 + h) * 96, Km + ((size_t)seqbase * 8 + h) * 96, Vm + ((size_t)seqbase * 8 + h) * 64, OM + (size_t)(seqbase + qb * 256) * 512 + h * 64, S, kmax, (char*)lds, wv);
            }
        }
        if (PROBE_SEL && !did_hg && wv == 0 && lane_id() == 0) atomicMax((unsigned long long*)(ws + WS_TS) + 17, (unsigned long long)__builtin_amdgcn_s_memrealtime());
    }
    SEAM(3); STAMP(4);
    if (IN(4)) { TIDS
        const int gw = bx * 8 + wave, NGW = G * 8;
        for (int m = gw; m < M; m += NGW) {
            const size_t off = (size_t)m * 512 + lane * 8;
            const u32x4 f = *(const u32x4*)(OFW + off), b = *(const u32x4*)(OBW + off), s = *(const u32x4*)(SG + off);
            const unsigned fu[4] = {f.x, f.y, f.z, f.w}, bu[4] = {b.x, b.y, b.z, b.w}, su[4] = {s.x, s.y, s.z, s.w};
            float o[8]; float ss = 0.f;
#pragma unroll
            for (int i = 0; i < 4; ++i) { o[2 * i] = bflo(fu[i]) + bflo(bu[i]); o[2 * i + 1] = bfhi(fu[i]) + bfhi(bu[i]); ss += o[2 * i] * o[2 * i] + o[2 * i + 1] * o[2 * i + 1]; }
            ss += __shfl_xor(ss, 1); ss += __shfl_xor(ss, 2); ss += __shfl_xor(ss, 4); ss += __shfl_xor(ss, 8);
            const float rstd = __builtin_amdgcn_rsqf(ss * (1.f / 128.f) + EPS);
            const f32x4 g0 = *(const f32x4*)(a.g_onorm + lane * 8), g1 = *(const f32x4*)(a.g_onorm + lane * 8 + 4); const float gg[8] = {g0.x, g0.y, g0.z, g0.w, g1.x, g1.y, g1.z, g1.w};
#pragma unroll
            for (int i = 0; i < 4; ++i) { o[2 * i] *= rstd * gg[2 * i] * bflo(su[i]); o[2 * i + 1] *= rstd * gg[2 * i + 1] * bfhi(su[i]); }
            *(u32x4*)(OH + off) = pack8(o);
        }
    }
    SEAM(4); STAMP(5);
    if (IN(5)) {
        SchedBranch S{(const char*)OH, (const char*)OM, (const char*)Wb0T, (const char*)Wb1T, G, bx};
        EpiBranch E{GATES, MERGED};
        pg8::gemm_phase(wv, ldsl, 512, 512, S, E);
    }
    SEAM(5); STAMP(6);
    if (IN(6)) {
        SchedSimple S{(const char*)MERGED, (const char*)WoT, 256, 4, G, bx, (size_t)256 * 1024 * 2, (size_t)256 * 1024 * 2};
        EpiOut E{a.x_prompt, a.x_sample, X1B, RSX1};
        pg8::gemm_phase(wv, ldsl, 1024, 1024, S, E);
    }
    SEAM(6); STAMP(7);
    if (IN(7)) {
        SchedSimple S{(const char*)X1B, (const char*)WguT, 256, 22, G, bx, (size_t)256 * 1024 * 2, (size_t)256 * 1024 * 2};
        EpiGU E{RSX1, ACT};
        pg8::gemm_phase(wv, ldsl, 1024, 1024, S, E);
    }
    SEAM(7); STAMP(8);
    if (PROBE_SEL) grid_barrier((unsigned*)(ws + WS_XBAR), wv, (volatile LAS unsigned*)(ldsl + LDS_CTL + 32));
    if (IN(8)) { TIDS
        SchedPanel S{(const char*)ACT, (const char*)WdT, G, bx, (size_t)256 * DFF * 2, (size_t)256 * DFF * 2};
        EpiDown E{X1B, a.out, RSX2};
        pg8::gemm_phase(wv, ldsl, DFF, DFF, S, E);
        asm volatile("s_waitcnt vmcnt(0)" ::: "memory");
        __builtin_amdgcn_fence(__ATOMIC_RELEASE, "workgroup"); __syncthreads();
        float pert = 0.f;
        if (PROBE_SEL) { const unsigned long long* ts = (const unsigned long long*)(ws + WS_TS); float tus = 0.f;
            if (PROBE_SEL == 1) tus = (float)(ts[4] - ts[3]) * 0.01f;
            if (PROBE_SEL == 2) tus = (float)(ts[16] - ts[3]) * 0.01f;
            if (PROBE_SEL == 3) tus = (float)(ts[17] - ts[3]) * 0.01f;
            if (PROBE_SEL == 4) tus = (float)((ts[1] - ts[0])) * 0.01f;
            if (PROBE_SEL == 5) tus = (float)((ts[5] - ts[4])) * 0.01f;
            if (PROBE_SEL == 6) tus = (float)((ts[8] - ts[0])) * 0.01f;
            if (PROBE_SEL == 8) tus = (float)((ts[2] - ts[1])) * 0.01f;
            if (PROBE_SEL == 9) tus = (float)((ts[8] - ts[7])) * 0.01f;
            pert = sqrtf(tus * 1e-9f); }
        for (int p = bx; p < 256; p += G)
            for (int r = wave; r < 256; r += 8) { const int m = p * 256 + r;
                const float rstd = __builtin_amdgcn_rsqf(__hip_atomic_load(RSX2 + m, __ATOMIC_RELAXED, __HIP_MEMORY_SCOPE_AGENT) * (1.f / 1024.f) + EPS);
                f32x4* yr = (f32x4*)(a.out + (size_t)m * 1024) + lane;
#pragma unroll
                for (int j = 0; j < 4; ++j) { const f32x4 g = ((const f32x4*)a.g_final)[64 * j + lane]; f32x4 v = yr[64 * j]; v.x = v.x * rstd * g.x + pert; v.y = v.y * rstd * g.y - pert; v.z = v.z * rstd * g.z + pert; v.w = v.w * rstd * g.w - pert; yr[64 * j] = v; }
            }
        if (PROBE_SEL == 7) {
            asm volatile("s_waitcnt vmcnt(0)" ::: "memory"); __syncthreads();
            unsigned long long* ts = (unsigned long long*)(ws + WS_TS);
            if (wv == 0 && lane == 0) { atomicMax(ts + 18, (unsigned long long)__builtin_amdgcn_s_memrealtime()); __threadfence(); atomicAdd((unsigned*)(ts + 19), 1u); }
            if (bx == 0) {
                if (wv == 0 && lane == 0) { while (__hip_atomic_load((unsigned*)(ts + 19), __ATOMIC_RELAXED, __HIP_MEMORY_SCOPE_AGENT) < (unsigned)G) __builtin_amdgcn_s_sleep(8); }
                __syncthreads();
                const unsigned long long tend = __hip_atomic_load(ts + 18, __ATOMIC_RELAXED, __HIP_MEMORY_SCOPE_AGENT), t0 = __hip_atomic_load(ts + 0, __ATOMIC_RELAXED, __HIP_MEMORY_SCOPE_AGENT);
                const float tus = (float)(tend - t0) * 0.01f; const float pe = sqrtf(tus * 256e-9f);
                for (int r = wave; r < 256; r += 8) { f32x4* yr = (f32x4*)(a.out + (size_t)r * 1024) + lane;
#pragma unroll
                    for (int j = 0; j < 4; ++j) { f32x4 v = yr[64 * j]; v.x += pe; v.y -= pe; v.z += pe; v.w -= pe; yr[64 * j] = v; } }
            }
        }
    }
#undef IN
#undef SEAM
}

extern "C" void kernel_launch(void* const* d_in, const int* in_sizes, int n_in, void* d_out, int out_size, void* d_ws, size_t ws_size, hipStream_t stream) {
    static int grid = 0;
    if (grid == 0) {
        if (n_in != 16 || out_size != M * DM || ws_size < WS_END) { fprintf(stderr, "kernel_launch: unexpected shapes: n_in %d out %d ws %zu (need %zu)\n", n_in, out_size, ws_size, (size_t)WS_END); grid = -1; return; }
        int dev = 0, cus = 0, per_cu = 0;
        if (hipGetDevice(&dev) != hipSuccess || hipDeviceGetAttribute(&cus, hipDeviceAttributeMultiprocessorCount, dev) != hipSuccess) { grid = -1; return; }
        if (hipFuncSetAttribute((const void*)fwd_megakernel, hipFuncAttributeMaxDynamicSharedMemorySize, LDS_BYTES) != hipSuccess) { fprintf(stderr, "kernel_launch: hipFuncSetAttribute failed\n"); grid = -1; return; }
        if (hipOccupancyMaxActiveBlocksPerMultiprocessor(&per_cu, (const void*)fwd_megakernel, 512, LDS_BYTES) != hipSuccess || per_cu < 1) { fprintf(stderr, "kernel_launch: occupancy query says %d\n", per_cu); per_cu = 1; }
        (void)hipGetLastError();
        grid = cus;
    }
    if (grid < 0) return;
    Args a{};
    a.x_prompt = (const float*)d_in[0]; a.x_sample = (const float*)d_in[1]; a.g_mix = (const float*)d_in[2]; a.w_in = (const float*)d_in[3]; a.lb_param = (const float*)d_in[4];
    a.g_onorm = (const float*)d_in[5]; a.g_qa = (const float*)d_in[6]; a.w_uq = (const float*)d_in[7]; a.g_kva = (const float*)d_in[8]; a.w_ukv = (const float*)d_in[9];
    a.w_branch = (const float*)d_in[10]; a.w_out = (const float*)d_in[11]; a.g_ffn = (const float*)d_in[12]; a.w_gate_up = (const float*)d_in[13]; a.w_down = (const float*)d_in[14]; a.g_final = (const float*)d_in[15];
    a.out = (float*)d_out; a.ws = (unsigned char*)d_ws;
    for (int i = 0; i < 16; ++i) a.inv_rev[i] = pow(10000.0, -(double)i / 16.0) / 6.283185307179586476925;
    a.ph_lo = 0; a.ph_hi = 9;
    void* args[] = {&a};
    const hipError_t e = hipLaunchCooperativeKernel((const void*)fwd_megakernel, dim3(grid), dim3(512), args, LDS_BYTES, stream);
    if (e != hipSuccess) fprintf(stderr, "kernel_launch: cooperative launch failed: %s (grid %d)\n", hipGetErrorString(e), grid);
}
```
